# Optimizing an MI355X kernel written in HIP

```python
import jax, jax.numpy as jnp
from jax import lax
import numpy as np

D_MODEL = 2048
BATCH = 2
SEQ = 16384
DEPTH = 2

N_MIXERS = 2
MIX_WIDTH = D_MODEL
TOK_WIDTH = MIX_WIDTH // 2
N_POOL_GROUPS = 4
POOL_GROUP_DIM = TOK_WIDTH // N_POOL_GROUPS
POOL_WINDOWS = (2, 4, 8, 16)
SGU_CHUNK = 128
N_SGU_GROUPS = 4
SGU_GROUP_DIM = TOK_WIDTH // N_SGU_GROUPS
N_MEM = 256
N_XA_HEADS = 4
XA_WIDTH = MIX_WIDTH - TOK_WIDTH
XA_HEAD_DIM = XA_WIDTH // N_XA_HEADS
N_GROUPS = 4
EXPERTS_PER_GROUP = 8
N_EXPERTS = N_GROUPS * EXPERTS_PER_GROUP
TOP_K_IN_GROUP = 2
D_EXPERT = D_MODEL // 2
MOE_BLOCK = 256
EPS = 1e-6

kernel_name = 'hybrid_pool_sgu_memxattn_hmoe'


def rms_norm(x, g):
    xf = x.astype(jnp.float32)
    y = xf * lax.rsqrt(jnp.mean(xf * xf, axis=-1, keepdims=True) + EPS)
    return (y * g.astype(jnp.float32)).astype(x.dtype)


def causal_window_mean(p, window):
    S = p.shape[1]
    cs = jnp.cumsum(p, axis=1)
    lag = jnp.pad(cs, ((0, 0), (window, 0), (0, 0)))[:, :S]
    count = jnp.minimum(jnp.arange(1, S + 1), window).astype(jnp.float32)
    return (cs - lag) / count[None, :, None]


def memory_cross_attention(q, mem_n, w_kv):
    B, S, _ = q.shape
    M = mem_n.shape[1]
    k, v = jnp.split(mem_n @ w_kv, 2, axis=-1)
    qh = q.reshape(B, S, N_XA_HEADS, XA_HEAD_DIM)
    kh = k.reshape(B, M, N_XA_HEADS, XA_HEAD_DIM)
    vh = v.reshape(B, M, N_XA_HEADS, XA_HEAD_DIM)
    s = jnp.einsum('bshd,bmhd->bhsm', qh, kh).astype(jnp.float32) * (XA_HEAD_DIM ** -0.5)
    p = jax.nn.softmax(s, axis=-1).astype(vh.dtype)
    return jnp.einsum('bhsm,bmhd->bshd', p, vh).reshape(B, S, XA_WIDTH)


def pool_layer(h, mem_n, w_in, w_grp, scale, w_kv, w_out):
    B, S, _ = h.shape
    proj = h @ w_in
    p, q = proj[..., :TOK_WIDTH], proj[..., TOK_WIDTH:]
    pf = p.astype(jnp.float32).reshape(B, S, N_POOL_GROUPS, POOL_GROUP_DIM)
    pooled = jnp.stack([causal_window_mean(pf[:, :, g], POOL_WINDOWS[g]) for g in range(N_POOL_GROUPS)], axis=2) - pf
    mixed = jnp.einsum('bsgc,gcd->bsgd', pooled.astype(h.dtype), w_grp).reshape(B, S, TOK_WIDTH) * scale
    attn = memory_cross_attention(q, mem_n, w_kv)
    return jnp.concatenate([mixed, attn], axis=-1) @ w_out


def sgu_layer(h, mem_n, w_in, norm_g, w_s, b_s, w_kv, w_out):
    B, S, _ = h.shape
    proj = h @ w_in
    u, v = jnp.split(jax.nn.gelu(proj[..., :2 * TOK_WIDTH]), 2, axis=-1)
    q = proj[..., 2 * TOK_WIDTH:]
    v = rms_norm(v, norm_g).reshape(B, S // SGU_CHUNK, SGU_CHUNK, N_SGU_GROUPS, SGU_GROUP_DIM)
    causal = jnp.tril(jnp.ones((SGU_CHUNK, SGU_CHUNK), dtype=bool))
    w_causal = jnp.where(causal[None], w_s, jnp.zeros_like(w_s))
    spatial = jnp.einsum('gts,bnsgc->bntgc', w_causal, v) + b_s.T[None, None, :, :, None]
    mixed = u * spatial.reshape(B, S, TOK_WIDTH)
    attn = memory_cross_attention(q, mem_n, w_kv)
    return jnp.concatenate([mixed, attn], axis=-1) @ w_out


def hierarchical_moe(h, w_group, b_group, w_expert, b_expert, w_gu, w_down):
    B, S, D = h.shape
    T = B * S
    ht = h.reshape(T, D)
    g_logits = (ht @ w_group).astype(jnp.float32) + b_group.astype(jnp.float32)
    g_prob = jax.nn.softmax(g_logits, axis=-1)
    g_idx = jnp.argmax(g_logits, axis=-1).astype(jnp.int32)
    p_g = jnp.take_along_axis(g_prob, g_idx[:, None], axis=1)[:, 0]
    e_logits = (ht @ w_expert).astype(jnp.float32) + b_expert.astype(jnp.float32)
    cols = g_idx[:, None] * EXPERTS_PER_GROUP + jnp.arange(EXPERTS_PER_GROUP, dtype=jnp.int32)[None]
    e_prob = jax.nn.softmax(jnp.take_along_axis(e_logits, cols, axis=1), axis=-1)
    top_p, top_i = lax.top_k(e_prob, TOP_K_IN_GROUP)
    top_p = top_p / jnp.sum(top_p, axis=-1, keepdims=True)
    gate = (p_g[:, None] * top_p).astype(h.dtype)
    expert_id = g_idx[:, None] * EXPERTS_PER_GROUP + top_i.astype(jnp.int32)
    A = T * TOP_K_IN_GROUP
    e_flat = expert_id.reshape(A)
    w_flat = gate.reshape(A)
    tok_flat = jnp.arange(A, dtype=jnp.int32) // TOP_K_IN_GROUP
    order = jnp.argsort(e_flat)
    sorted_e = e_flat[order]
    counts = jnp.zeros((N_EXPERTS,), jnp.int32).at[e_flat].add(1)
    starts = jnp.cumsum(counts) - counts
    padded = (counts + MOE_BLOCK - 1) // MOE_BLOCK * MOE_BLOCK
    pends = jnp.cumsum(padded)
    pstarts = pends - padded
    dest = pstarts[sorted_e] + (jnp.arange(A, dtype=jnp.int32) - starts[sorted_e])
    P = (A + N_EXPERTS * (MOE_BLOCK - 1) + MOE_BLOCK - 1) // MOE_BLOCK * MOE_BLOCK
    n_blocks = P // MOE_BLOCK
    buf_tok = jnp.full((P,), T, jnp.int32).at[dest].set(tok_flat[order])
    buf_w = jnp.zeros((P,), h.dtype).at[dest].set(w_flat[order])
    blk_e = jnp.minimum(jnp.searchsorted(pends, jnp.arange(n_blocks, dtype=jnp.int32) * MOE_BLOCK, side='right'), N_EXPERTS - 1).astype(jnp.int32)
    h_pad = jnp.concatenate([ht, jnp.zeros((1, D), ht.dtype)], axis=0)

    def expert_block(args):
        idx, e = args
        xb = h_pad[idx]
        g, u = jnp.split(xb @ w_gu[e], 2, axis=-1)
        return (jax.nn.silu(g) * u) @ w_down[e]

    out = lax.map(expert_block, (buf_tok.reshape(n_blocks, MOE_BLOCK), blk_e)).reshape(P, D)
    y = jnp.zeros((T + 1, D), h.dtype).at[buf_tok].add(out * buf_w[:, None])[:T]
    return y.reshape(B, S, D)


def setup_inputs(seed: int = 0) -> dict:
    key = jax.random.key(seed)
    ks = jax.random.split(key, 32)
    n_pool = (DEPTH + 1) // 2
    n_sgu = DEPTH // 2

    def nrm(k, shape, scale):
        return jax.random.normal(k, shape, jnp.float32) * scale

    return {
        'x': nrm(ks[0], (BATCH, SEQ, D_MODEL), 1.0),
        'mem': nrm(ks[1], (BATCH, N_MEM, D_MODEL), 1.0),
        'norm_mix_g': 1.0 + nrm(ks[2], (DEPTH, D_MODEL), 0.05),
        'norm_mem_g': 1.0 + nrm(ks[3], (DEPTH, D_MODEL), 0.05),
        'norm_ffn_g': 1.0 + nrm(ks[4], (DEPTH, D_MODEL), 0.05),
        'pool_w_in': nrm(ks[5], (n_pool, D_MODEL, TOK_WIDTH + XA_WIDTH), D_MODEL ** -0.5),
        'pool_w_grp': nrm(ks[6], (n_pool, N_POOL_GROUPS, POOL_GROUP_DIM, POOL_GROUP_DIM), POOL_GROUP_DIM ** -0.5),
        'pool_scale': 1.0 + nrm(ks[7], (n_pool, TOK_WIDTH), 0.1),
        'pool_w_out': nrm(ks[8], (n_pool, MIX_WIDTH, D_MODEL), MIX_WIDTH ** -0.5),
        'sgu_w_in': nrm(ks[9], (n_sgu, D_MODEL, 2 * TOK_WIDTH + XA_WIDTH), D_MODEL ** -0.5),
        'sgu_norm_g': 1.0 + nrm(ks[10], (n_sgu, TOK_WIDTH), 0.05),
        'sgu_w_s': nrm(ks[11], (n_sgu, N_SGU_GROUPS, SGU_CHUNK, SGU_CHUNK), SGU_CHUNK ** -0.5),
        'sgu_b_s': 1.0 + nrm(ks[12], (n_sgu, N_SGU_GROUPS, SGU_CHUNK), 0.1),
        'sgu_w_out': nrm(ks[13], (n_sgu, MIX_WIDTH, D_MODEL), MIX_WIDTH ** -0.5),
        'xa_w_kv': nrm(ks[14], (DEPTH, D_MODEL, 2 * XA_WIDTH), D_MODEL ** -0.5),
        'moe_w_group': nrm(ks[15], (DEPTH, D_MODEL, N_GROUPS), D_MODEL ** -0.5),
        'moe_b_group': nrm(ks[16], (DEPTH, N_GROUPS), 0.01),
        'moe_w_expert': nrm(ks[17], (DEPTH, D_MODEL, N_EXPERTS), D_MODEL ** -0.5),
        'moe_b_expert': nrm(ks[18], (DEPTH, N_EXPERTS), 0.01),
        'moe_w_gu': nrm(ks[19], (DEPTH, N_EXPERTS, D_MODEL, 2 * D_EXPERT), D_MODEL ** -0.5),
        'moe_w_down': nrm(ks[20], (DEPTH, N_EXPERTS, D_EXPERT, D_MODEL), D_EXPERT ** -0.5),
        'final_norm_g': 1.0 + nrm(ks[21], (D_MODEL,), 0.05),
    }


def reference(x, mem, norm_mix_g, norm_mem_g, norm_ffn_g, pool_w_in, pool_w_grp, pool_scale, pool_w_out,
              sgu_w_in, sgu_norm_g, sgu_w_s, sgu_b_s, sgu_w_out, xa_w_kv, moe_w_group, moe_b_group,
              moe_w_expert, moe_b_expert, moe_w_gu, moe_w_down, final_norm_g):
    for i in range(DEPTH):
        h = rms_norm(x, norm_mix_g[i])
        mem_n = rms_norm(mem, norm_mem_g[i])
        j = i // N_MIXERS
        if i % N_MIXERS == 0:
            x = x + pool_layer(h, mem_n, pool_w_in[j], pool_w_grp[j], pool_scale[j], xa_w_kv[i], pool_w_out[j])
        else:
            x = x + sgu_layer(h, mem_n, sgu_w_in[j], sgu_norm_g[j], sgu_w_s[j], sgu_b_s[j], xa_w_kv[i], sgu_w_out[j])
        h = rms_norm(x, norm_ffn_g[i])
        x = x + hierarchical_moe(h, moe_w_group[i], moe_b_group[i], moe_w_expert[i], moe_b_expert[i], moe_w_gu[i], moe_w_down[i])
    return rms_norm(x, final_norm_g)
```

```cpp
#include <hip/hip_runtime.h>
#include <cstdio>
#include <cstdint>

#ifndef MK_PER_PHASE
#define MK_PER_PHASE 0
#endif

#define GAS __attribute__((address_space(1)))
#define LAS __attribute__((address_space(3)))
typedef unsigned short bf16_t;
typedef short bf16x8 __attribute__((ext_vector_type(8)));
typedef float f32x4 __attribute__((ext_vector_type(4)));
typedef float f32x2 __attribute__((ext_vector_type(2)));
typedef unsigned u32x4 __attribute__((ext_vector_type(4)));
typedef unsigned u32x2 __attribute__((ext_vector_type(2)));
typedef int i32x4 __attribute__((ext_vector_type(4)));
typedef int i32x8 __attribute__((ext_vector_type(8)));

constexpr int T = 32768, SEQ = 16384, D = 2048, NMEM = 256, NEXP = 32, DEXP = 1024;
constexpr float EPS = 1e-6f;
constexpr int NWAVES = 8;
constexpr int NPHASE = 24;
constexpr float GU_WS = 64.f, DN_WS = 32.f, HID_S = 8.f, Y_S = 16.f, WQ_S = 64.f, WIN_S = 64.f, MX_S = 8.f, WO_S = 128.f, P_S = 256.f, VW_S = 4.f, F_S = P_S * VW_S;

constexpr size_t MiB = 1u << 20;
constexpr size_t WS_CTL = 0, CTL_ZERO_BYTES = 1 * MiB;
constexpr size_t WS_RSTD = 1 * MiB;
constexpr size_t RSTD_STRIDE = 320 * 1024;
constexpr size_t WS_PART1 = 2 * MiB;
constexpr size_t WS_PART2 = 10 * MiB;
constexpr size_t WS_SSQV = 14 * MiB;
constexpr size_t WS_LOGITS = 16 * MiB;
constexpr size_t WS_LIST = 32 * MiB;
constexpr size_t WS_GATEW = 40 * MiB;
constexpr size_t WS_KMAT = 48 * MiB;
constexpr size_t WS_VT = 50 * MiB;
constexpr size_t WS_MEMN = 52 * MiB;
constexpr size_t WS_WIN0 = 56 * MiB;
constexpr size_t WS_WIN1 = 64 * MiB;
constexpr size_t WS_WOUT = 76 * MiB;
constexpr size_t WS_WKV = 92 * MiB;
constexpr size_t WS_GRP = 108 * MiB;
constexpr size_t WS_W2 = 109 * MiB;
constexpr size_t WS_CNT = 108 * MiB + 512 * 1024;
constexpr size_t WS_TOKREC = 109 * MiB + 512 * 1024;
constexpr size_t WS_RT = 110 * MiB;
constexpr size_t WS_GUT = 112 * MiB;
constexpr size_t WS_DOWNT = 624 * MiB;
constexpr size_t WS_XB = 880 * MiB;
constexpr size_t WS_PROJ = 1010 * MiB;
constexpr size_t WS_POOLED = 1202 * MiB;
constexpr size_t WS_PBUF = 1266 * MiB;
constexpr size_t WS_CONCAT = 1330 * MiB;
constexpr size_t WS_HIDDEN = 1458 * MiB;
constexpr size_t WS_XB8 = 1618 * MiB;
constexpr size_t WS_BTO = 1684 * MiB;
constexpr size_t WS_GRPW = 1716 * MiB;
constexpr size_t WS_WQN = 1718 * MiB;
constexpr size_t WS_WINQ = 1734 * MiB;
constexpr size_t WS_END = 1750 * MiB;
constexpr int CW_BAR = 4096;
constexpr int CW_CONVQ = 2048;
constexpr int EARLY_PLAIN_MIN_G = 176;
constexpr int CW_CURSOR = 16384;

constexpr int RING_BYTES = 131072;
constexpr int SCR_OFF = RING_BYTES;
constexpr int SCR_IDX = 8192, SCR_TAB = 20480, SCR_BYTES = 22528;
constexpr int MISC_OFF = SCR_OFF + SCR_BYTES;
constexpr int LDS_BYTES = MISC_OFF + 128;
constexpr int MAX_MOE_UNITS = 12;

#define RLX_AGENT __ATOMIC_RELAXED, __HIP_MEMORY_SCOPE_AGENT
#define LDS_WAIT() asm volatile("s_waitcnt lgkmcnt(0)" ::: "memory")
#define VM_WAIT() asm volatile("s_waitcnt vmcnt(0)" ::: "memory")
__device__ __forceinline__ int rfl(int v) { return __builtin_amdgcn_readfirstlane(v); }
__device__ __forceinline__ unsigned f2bf(float f) { unsigned u = __builtin_bit_cast(unsigned, f); return (u + 0x7fffu + ((u >> 16) & 1u)) >> 16; }
__device__ __forceinline__ unsigned pk2(float lo, float hi) { return f2bf(lo) | (f2bf(hi) << 16); }
__device__ __forceinline__ unsigned cvt_pk_bf16(float lo, float hi) { unsigned r; asm volatile("v_cvt_pk_bf16_f32 %0, %1, %2" : "=v"(r) : "v"(lo), "v"(hi)); return r; }
__device__ __forceinline__ unsigned pk4_fp8(float a, float b, float c, float d) {
    a = __builtin_amdgcn_fmed3f(a, -448.f, 448.f); b = __builtin_amdgcn_fmed3f(b, -448.f, 448.f); c = __builtin_amdgcn_fmed3f(c, -448.f, 448.f); d = __builtin_amdgcn_fmed3f(d, -448.f, 448.f);
    int w = 0; w = __builtin_amdgcn_cvt_pk_fp8_f32(a, b, w, false); w = __builtin_amdgcn_cvt_pk_fp8_f32(c, d, w, true); return (unsigned)w; }
typedef float f32x2v __attribute__((ext_vector_type(2)));
__device__ __forceinline__ void fp8x8_to_f32(const u32x2 w, float (&o)[8]) { const f32x2v a = __builtin_amdgcn_cvt_pk_f32_fp8((int)w.x, false), b = __builtin_amdgcn_cvt_pk_f32_fp8((int)w.x, true), c = __builtin_amdgcn_cvt_pk_f32_fp8((int)w.y, false), d = __builtin_amdgcn_cvt_pk_f32_fp8((int)w.y, true);
    o[0] = a.x; o[1] = a.y; o[2] = b.x; o[3] = b.y; o[4] = c.x; o[5] = c.y; o[6] = d.x; o[7] = d.y; }
__device__ __forceinline__ float bflo(unsigned w) { return __uint_as_float(w << 16); }
__device__ __forceinline__ float bfhi(unsigned w) { return __uint_as_float(w & 0xffff0000u); }
__device__ __forceinline__ float wave_sum(float v) {
#pragma unroll
    for (int o = 1; o < 64; o <<= 1) v += __shfl_xor(v, o);
    return v;
}
__device__ __forceinline__ float gelu_tanh(float x) {
    const float e = __builtin_amdgcn_exp2f(x * (-2.302208198f - 0.1029432396f * x * x));
    return x * __builtin_amdgcn_rcpf(1.0f + e);
}
__device__ __forceinline__ float silu_f(float x) { return x * __builtin_amdgcn_rcpf(1.0f + __builtin_amdgcn_exp2f(-1.442695041f * x)); }

#define XB_TMO      128
#define XB_XCNT(j)  (256  + 64 * (j))
#define XB_XSUB(j)  (1280 + 64 * (j))
#define XB_XGEN(j)  (2304 + 64 * (j))
#define XB_TOP      3328
#define XB_TOPGEN   3392
#define XCD_BAR_WORDS 3456
#define XB_SPIN_CAP (1u << 20)

__device__ __forceinline__ unsigned xb_ld(unsigned* p)              { return __hip_atomic_load(p, __ATOMIC_RELAXED, __HIP_MEMORY_SCOPE_AGENT); }
__device__ __forceinline__ unsigned xb_add(unsigned* p, unsigned v) { return __hip_atomic_fetch_add(p, v, __ATOMIC_RELAXED, __HIP_MEMORY_SCOPE_AGENT); }
__device__ __forceinline__ unsigned xb_xcc_id() { return (unsigned)__builtin_amdgcn_s_getreg((3 << 11) | 20) & 0xFu; }
#define XB_SPIN(cond, bar) do { unsigned _sp = 0; while (cond) { __builtin_amdgcn_s_sleep(1); \
    if ((++_sp & 255u) == 0u) { if (xb_ld(&(bar)[XB_TMO])) break; if (_sp > XB_SPIN_CAP) { atomicAdd(&(bar)[XB_TMO], 1u); break; } } } } while (0)

struct XcdBarrier { unsigned* bar; unsigned x; volatile LAS unsigned* st; };
__device__ __forceinline__ XcdBarrier xcd_barrier_post(unsigned* bar, volatile LAS unsigned* st) {
    XcdBarrier b; b.bar = bar; b.x = xb_xcc_id(); b.st = st;
    if (threadIdx.x == 0) (void)xb_add(&bar[XB_XCNT(b.x)], 1u);
    return b;
}
__device__ __forceinline__ void xcd_barrier_complete(unsigned* bar, unsigned x, unsigned& nloc, unsigned& nx) {
    const unsigned G = gridDim.x * gridDim.y * gridDim.z;
    unsigned sum, cnt, mine, sp = 0u;
    for (;;) {
        sum = 0u; cnt = 0u; mine = 0u;
#pragma unroll
        for (unsigned j = 0; j < 16; ++j) { const unsigned c = xb_ld(&bar[XB_XCNT(j)]); sum += c; cnt += (c > 0u) ? 1u : 0u; mine = (j == x) ? c : mine; }
        if (sum == G) break;
        __builtin_amdgcn_s_sleep(1);
        if ((++sp & 255u) == 0u) { if (xb_ld(&bar[XB_TMO])) break; if (sp > XB_SPIN_CAP) { atomicAdd(&bar[XB_TMO], 1u); break; } }
    }
    nloc = mine > 0u ? mine : 1u; nx = cnt > 0u ? cnt : 1u;
}
__device__ __forceinline__ void xcd_barrier(const XcdBarrier& b) {
    asm volatile("s_waitcnt vmcnt(0)" ::: "memory");
    __syncthreads();
    if (threadIdx.x == 0) {
        unsigned* bar = b.bar;
        __builtin_amdgcn_s_waitcnt(0);
        unsigned nloc = b.st[0], nx = b.st[1];
        if (nloc == 0u) { xcd_barrier_complete(bar, b.x, nloc, nx); b.st[0] = nloc; b.st[1] = nx; }
        const unsigned old = xb_add(&bar[XB_XSUB(b.x)], 1u);
        const unsigned gen = old / nloc;
        if (old + 1u == (gen + 1u) * nloc) {
            __builtin_amdgcn_fence(__ATOMIC_RELEASE, "agent");
            asm volatile("s_waitcnt vmcnt(0)" ::: "memory");
            const unsigned og = xb_add(&bar[XB_TOP], 1u);
            const unsigned tg = og / nx;
            if (og + 1u == (tg + 1u) * nx) xb_add(&bar[XB_TOPGEN], 1u);
            else XB_SPIN(xb_ld(&bar[XB_TOPGEN]) == tg, bar);
            __builtin_amdgcn_fence(__ATOMIC_ACQUIRE, "agent");
            xb_add(&bar[XB_XGEN(b.x)], 1u);
            asm volatile("s_waitcnt vmcnt(0)" ::: "memory");
        } else {
            XB_SPIN(xb_ld(&bar[XB_XGEN(b.x)]) == gen, bar);
            __builtin_amdgcn_fence(__ATOMIC_ACQUIRE, "agent");
            asm volatile("s_waitcnt vmcnt(0)" ::: "memory");
        }
    }
    __syncthreads();
}

namespace pg8 {
constexpr int BM = 256, BK = 64, HALF = 128, HTB = HALF * BK * 2, NXCD = 8, WGM = 4;
__device__ __forceinline__ int lds_byte(int r, int c) { const int st = (r >> 4) * 2 + (c >> 5), rr = r & 15, cc = c & 31, ob = rr * 64 + cc * 2; return st * 1024 + (ob ^ (((ob >> 9) & 1) << 5)); }
__device__ __forceinline__ void stage_rc(int b, int& R, int& C) { const int st = b / 1024, sb = b % 1024, swz = sb ^ (((sb >> 9) & 1) << 5); R = (st >> 1) * 16 + swz / 64; C = (st & 1) * 32 + (swz % 64) / 2; }
__device__ __forceinline__ int perm32(int rho) { const int n = rho >> 4, i = rho & 15; return 8 * (i >> 2) + 4 * n + (i & 3); }

struct Unit { const char* A; const char* B; char* C; int pm, pn, aux, nvalid; };

__device__ __forceinline__ bool grid_order(int i, int G, int c, int nM, int nN, int& pm, int& pn) {
    const int nwg = nM * nN; const long L = (long)i * G + c; if (L >= nwg) return false;
    int wgid = (int)L; { const int q = nwg / NXCD, r = nwg % NXCD, xcd = wgid % NXCD, off = wgid / NXCD; wgid = (xcd < r ? xcd * (q + 1) : r * (q + 1) + (xcd - r) * q) + off; }
    const int nig = WGM * nN, gid = wgid / nig, fm = gid * WGM, gsz = (nM - fm) < WGM ? (nM - fm) : WGM;
    pm = fm + ((wgid % nig) % gsz); pn = (wgid % nig) / gsz; return true;
}
struct SchedGrid {
    int nM, nN, G, c; const char* A0; size_t a_pm, a_pn; const char* B0; size_t b_bt, b_pn; char* C0; size_t c_pm, c_pn;
    __device__ __forceinline__ bool next(int i, Unit& u) const {
        int pm, pn; if (!grid_order(i, G, c, nM, nN, pm, pn)) return false;
        u.pm = pm; u.pn = pn; u.aux = 0; u.nvalid = 256;
        u.A = A0 + (size_t)pm * a_pm + (size_t)pn * a_pn; u.B = B0 + (size_t)(pm >> 6) * b_bt + (size_t)pn * b_pn; u.C = C0 + (size_t)pm * c_pm + (size_t)pn * c_pn; return true;
    }
    __device__ __forceinline__ int row(int, int) const { return 0; }
};

template <bool F8> struct FragSel { struct A { i32x4 v[4][2]; }; struct B { i32x4 v[2][2]; }; };
template <> struct FragSel<true> { struct A { i32x8 v[4]; }; struct B { i32x8 v[2]; }; };
template <class Epi, class Sched, bool GATHER, bool FP8 = false, bool HALFSKIP = false, bool EPI2 = false, int MIXSW = 0>
__device__ __forceinline__ void gemm_phase(LAS unsigned char* lds, LAS unsigned char* scr, const int K, const unsigned lda2, const unsigned ldb2, const size_t hstepB, const Sched& S, const Epi& E) {
    const int tid = threadIdx.x, wid = __builtin_amdgcn_readfirstlane(tid >> 6), lane = tid & 63, wr = wid >> 2, wc = wid & 3, fr = lane & 15, fq = lane >> 4;
    const int nt = K / BK;
    unsigned voffB[2], vAc[2][2], vAn[2][2]; int Rr[2], Cc[2];
#pragma unroll
    for (int i = 0; i < 2; ++i) { int R, C; stage_rc(tid * 16 + i * 8192, R, C); const int Rb = (R & ~31) + perm32(R & 31); Rr[i] = R; Cc[i] = C;
        voffB[i] = (unsigned)Rb * ldb2 + (unsigned)C * 2u; vAc[0][i] = (unsigned)R * lda2 + (unsigned)C * 2u; vAc[1][i] = vAc[0][i]; vAn[0][i] = vAc[0][i]; vAn[1][i] = vAc[0][i]; }
    const size_t kstep = (size_t)(BK * 2);
    const size_t hstepA = GATHER ? (size_t)0 : (size_t)HALF * lda2;
    const unsigned ldsw = (unsigned)wid * 1024u;
    const int aoff = lds_byte(wr * 64 + fr, fq * 8), boff = lds_byte(wc * 32 + fr, fq * 8);
#define PG8_SA(b, h) (((b) * 2 + (h)) * HTB)
#define PG8_SB(b, h) ((4 + (b) * 2 + (h)) * HTB)
#define PG8_STG(bufoff, gptr, v0, v1) do { \
        __builtin_amdgcn_global_load_lds((const unsigned*)((const char*)(gptr) + (v0)), (LAS unsigned*)(lds + (bufoff) + ldsw), 16, 0, 0); \
        __builtin_amdgcn_global_load_lds((const unsigned*)((const char*)(gptr) + (v1)), (LAS unsigned*)(lds + (bufoff) + ldsw + 8192), 16, 0, 0); } while (0)
#define PG8_STG_B(b, h, bp) PG8_STG(PG8_SB(b, h), (bp) + (h) * hstepB, voffB[0], voffB[1])
#define PG8_STG_A(b, h, ap, nx) do { if constexpr (GATHER) { const unsigned _o0 = (nx) ? vAn[h][0] : vAc[h][0], _o1 = (nx) ? vAn[h][1] : vAc[h][1]; PG8_STG(PG8_SA(b, h), (ap), _o0, _o1); } \
        else { PG8_STG(PG8_SA(b, h), (ap) + (h) * hstepA, vAc[0][0], vAc[0][1]); } } while (0)
#define PG8_LDA(KIND, b, h) do { _Pragma("unroll") for (int m = 0; m < 4; ++m) { const i32x4 _l0 = *(const LAS i32x4*)(lds + PG8_SA(b, h) + aoff + m * 2048), _l1 = *(const LAS i32x4*)(lds + PG8_SA(b, h) + aoff + m * 2048 + 1024); \
        if constexpr (KIND) AtQ.v[m] = __builtin_shufflevector(_l0, _l1, 0, 1, 2, 3, 4, 5, 6, 7); else { AtH.v[m][0] = _l0; AtH.v[m][1] = _l1; } } } while (0)
#define PG8_LDB(KIND, W, b, h) do { _Pragma("unroll") for (int n = 0; n < 2; ++n) { const i32x4 _l0 = *(const LAS i32x4*)(lds + PG8_SB(b, h) + boff + n * 2048), _l1 = *(const LAS i32x4*)(lds + PG8_SB(b, h) + boff + n * 2048 + 1024); \
        if constexpr (KIND) B##W##Q.v[n] = __builtin_shufflevector(_l0, _l1, 0, 1, 2, 3, 4, 5, 6, 7); else { B##W##H.v[n][0] = _l0; B##W##H.v[n][1] = _l1; } } } while (0)
#define PG8_MMA(KIND, ai, bj, W) do { __builtin_amdgcn_s_setprio(1); _Pragma("unroll") for (int m = 0; m < 4; ++m) _Pragma("unroll") for (int n = 0; n < 2; ++n) { \
        if constexpr (KIND) asm volatile("v_mfma_scale_f32_16x16x128_f8f6f4 %0, %1, %2, %0, %3, %3 op_sel_hi:[0,0,0]" : "+v"(acc[ai][bj][m][n]) : "v"(B##W##Q.v[n]), "v"(AtQ.v[m]), "v"(scl1)); \
        else { _Pragma("unroll") for (int k = 0; k < 2; ++k) acc[ai][bj][m][n] = __builtin_amdgcn_mfma_f32_16x16x32_bf16(__builtin_bit_cast(bf16x8, B##W##H.v[n][k]), __builtin_bit_cast(bf16x8, AtH.v[m][k]), acc[ai][bj][m][n], 0, 0, 0); } } \
        __builtin_amdgcn_s_setprio(0); } while (0)
#define PG8_WAIT_V(n) asm volatile("s_waitcnt vmcnt(" #n ")" ::: "memory")
#define PG8_WAIT_L(n) asm volatile("s_waitcnt lgkmcnt(" #n ")" ::: "memory")
#define PG8_BAR __builtin_amdgcn_s_barrier()
#define PG8_SCHED __builtin_amdgcn_sched_barrier(0)
    Unit cur, nxt; int ui = 0;
    if (!S.next(0, cur)) return;
    int scl1 = 0x7f7f7f7f; asm volatile("" : "+v"(scl1));
    if constexpr (GATHER) {
#pragma unroll
        for (int h = 0; h < 2; ++h)
#pragma unroll
            for (int i = 0; i < 2; ++i) vAc[h][i] = (unsigned)S.row(0, Rr[i] + HALF * h) * lda2 + (unsigned)Cc[i] * 2u;
    }
    f32x4 acc[2][2][4][2];
#pragma unroll
    for (int a = 0; a < 2; ++a)
#pragma unroll
        for (int b = 0; b < 2; ++b)
#pragma unroll
            for (int m = 0; m < 4; ++m)
#pragma unroll
                for (int n = 0; n < 2; ++n) acc[a][b][m][n] = (f32x4){0.f, 0.f, 0.f, 0.f};
    typename FragSel<false>::A AtH; typename FragSel<false>::B B0H, B1H; typename FragSel<true>::A AtQ; typename FragSel<true>::B B0Q, B1Q;
    const char* cA = cur.A; const char* cB = cur.B;
    PG8_STG_B(0, 0, cB); PG8_STG_B(0, 1, cB); PG8_STG_A(0, 0, cA, false); PG8_STG_A(0, 1, cA, false);
    if (wr == 1) PG8_BAR;
    PG8_WAIT_V(2); PG8_BAR;
    PG8_STG_B(1, 0, cB + kstep); PG8_STG_A(1, 0, cA + kstep, false); PG8_STG_B(1, 1, cB + kstep);
    PG8_WAIT_V(6); PG8_BAR;
    for (;;) {
        const bool has_next = S.next(ui + 1, nxt);
        const char* nA = has_next ? nxt.A : cA; const char* nB = has_next ? nxt.B : cB;
        if constexpr (GATHER) {
#pragma unroll
            for (int h = 0; h < 2; ++h)
#pragma unroll
                for (int i = 0; i < 2; ++i) vAn[h][i] = has_next ? (unsigned)S.row(ui + 1, Rr[i] + HALF * h) * lda2 + (unsigned)Cc[i] * 2u : vAc[h][i];
        }
#define PG8_KLOOP(KIND, MMA1, TBEG, TEND, FINAL) _Pragma("unroll 1") for (int t = (TBEG); t < (TEND); t += 2) { \
            const bool last = (FINAL) && (t == nt - 2); \
            const char* a1 = cA + (size_t)(t + 1) * kstep; \
            const char* a2 = last ? nA : cA + (size_t)(t + 2) * kstep; const char* b2 = last ? nB : cB + (size_t)(t + 2) * kstep; \
            const char* a3 = a2 + kstep; const char* b3 = b2 + kstep; \
              \
            PG8_LDB(KIND, 0, 0, 0); PG8_LDB(KIND, 1, 0, 1); PG8_SCHED; PG8_LDA(KIND, 0, 0); PG8_STG_A(1, 1, a1, false); \
            PG8_WAIT_V(8); PG8_WAIT_L(0); PG8_BAR; PG8_MMA(KIND, 0, 0, 0); PG8_MMA(KIND, 0, 1, 1); PG8_BAR; PG8_SCHED; \
              \
            PG8_LDA(KIND, 0, 1); PG8_STG_B(0, 0, b2); PG8_STG_B(0, 1, b2); PG8_STG_A(0, 0, a2, last); \
            PG8_WAIT_V(8); PG8_WAIT_L(0); PG8_BAR; if (MMA1) { PG8_MMA(KIND, 1, 0, 0); PG8_MMA(KIND, 1, 1, 1); } PG8_BAR; PG8_SCHED; \
              \
            PG8_LDB(KIND, 0, 1, 0); PG8_LDB(KIND, 1, 1, 1); PG8_SCHED; PG8_LDA(KIND, 1, 0); PG8_STG_A(0, 1, a2, last); \
            PG8_WAIT_V(8); PG8_WAIT_L(0); PG8_BAR; PG8_MMA(KIND, 0, 0, 0); PG8_MMA(KIND, 0, 1, 1); PG8_BAR; PG8_SCHED; \
              \
            PG8_LDA(KIND, 1, 1); PG8_STG_B(1, 0, b3); PG8_STG_B(1, 1, b3); PG8_STG_A(1, 0, a3, last); \
            PG8_WAIT_V(8); PG8_WAIT_L(0); PG8_BAR; if (MMA1) { PG8_MMA(KIND, 1, 0, 0); PG8_MMA(KIND, 1, 1, 1); } PG8_BAR; PG8_SCHED; \
        }
#define PG8_KLOOPS(KIND, TBEG, TEND, FINAL) do { if (HALFSKIP && cur.nvalid <= 128) { PG8_KLOOP(KIND, false, TBEG, TEND, FINAL) } else { PG8_KLOOP(KIND, true, TBEG, TEND, FINAL) } } while (0)
        if constexpr (MIXSW > 0) { PG8_KLOOPS(0, 0, MIXSW, false); PG8_KLOOPS(1, MIXSW, nt, true); }
        else if constexpr (FP8) { PG8_KLOOPS(1, 0, nt, true); }
        else { PG8_KLOOPS(0, 0, nt, true); }
        if constexpr (FP8 || MIXSW > 0) asm volatile("s_nop 15\n\ts_nop 15" ::: "memory");
        if (wr == 0) PG8_BAR;
        E(acc, cur, ui, wr, wc, fr, fq, scr);
        if constexpr (EPI2) { asm volatile("" ::: "memory"); E(acc, cur, ui, wr, wc, fr, fq, scr); }
        if (!has_next) break;
#pragma unroll
        for (int a = 0; a < 2; ++a)
#pragma unroll
            for (int b = 0; b < 2; ++b)
#pragma unroll
                for (int m = 0; m < 4; ++m)
#pragma unroll
                    for (int n = 0; n < 2; ++n) acc[a][b][m][n] = (f32x4){0.f, 0.f, 0.f, 0.f};
        cur = nxt; cA = nA; cB = nB; ++ui;
        if constexpr (GATHER) {
#pragma unroll
            for (int h = 0; h < 2; ++h)
#pragma unroll
                for (int i = 0; i < 2; ++i) vAc[h][i] = vAn[h][i];
        }
        if (wr == 1) PG8_BAR;
    }
    PG8_WAIT_V(0);
    PG8_BAR;
#undef PG8_KLOOPS
#undef PG8_KLOOP
#undef PG8_SA
#undef PG8_SB
#undef PG8_STG
#undef PG8_STG_A
#undef PG8_STG_B
#undef PG8_LDA
#undef PG8_LDB
#undef PG8_MMA
#undef PG8_WAIT_V
#undef PG8_WAIT_L
#undef PG8_BAR
#undef PG8_SCHED
}
}
using pg8::Unit;

typedef f32x4 Acc[2][2][4][2];
#define EPI_ROWS(ai, m) (128 * (ai) + 64 * wr + 16 * (m) + fr)
#define EPI_COL0 (32 * wc + 8 * fq)
__device__ __forceinline__ u32x4 pack8(const f32x4 a, const f32x4 b) { u32x4 w; w.x = cvt_pk_bf16(a[0], a[1]); w.y = cvt_pk_bf16(a[2], a[3]); w.z = cvt_pk_bf16(b[0], b[1]); w.w = cvt_pk_bf16(b[2], b[3]); return w; }

struct EpiPlain {
    int ldc; float scale;
    __device__ __forceinline__ void operator()(Acc& acc, const Unit& u, int, int wr, int wc, int fr, int fq, LAS unsigned char*) const {
        asm volatile("" : "+v"(fr), "+v"(fq));
        const int ld = ldc ? ldc : u.aux; bf16_t* base = (bf16_t*)u.C + EPI_COL0;
#pragma unroll
        for (int ai = 0; ai < 2; ++ai)
#pragma unroll
            for (int m = 0; m < 4; ++m) { bf16_t* rowp = base + (size_t)EPI_ROWS(ai, m) * ld;
#pragma unroll
                for (int bj = 0; bj < 2; ++bj) *(u32x4*)(rowp + bj * 128) = pack8(acc[ai][bj][m][0] * scale, acc[ai][bj][m][1] * scale); }
    }
};
__device__ __forceinline__ void epi_softmax(Acc& acc, const Unit& u, int wr, int wc, int fr, int fq, LAS unsigned char* scr, int ldc, float c) {
    LAS float* XA = (LAS float*)scr; LAS float* XB = (LAS float*)(scr + 4096);
#pragma unroll
    for (int ai = 0; ai < 2; ++ai)
#pragma unroll
        for (int m = 0; m < 4; ++m) { float mx = -3.0e38f;
#pragma unroll
            for (int bj = 0; bj < 2; ++bj)
#pragma unroll
                for (int n = 0; n < 2; ++n) { const f32x4 x = acc[ai][bj][m][n]; mx = fmaxf(mx, fmaxf(fmaxf(x[0], x[1]), fmaxf(x[2], x[3]))); }
            mx = fmaxf(mx, __shfl_xor(mx, 16)); mx = fmaxf(mx, __shfl_xor(mx, 32));
            if (fq == 0) XA[EPI_ROWS(ai, m) * 4 + wc] = mx; }
    LDS_WAIT(); __builtin_amdgcn_s_barrier(); asm volatile("" ::: "memory");
#pragma unroll
    for (int ai = 0; ai < 2; ++ai)
#pragma unroll
        for (int m = 0; m < 4; ++m) { const f32x4 q = *(const LAS f32x4*)(XA + EPI_ROWS(ai, m) * 4); const float mx = fmaxf(fmaxf(q[0], q[1]), fmaxf(q[2], q[3])) * c; float s = 0.f;
#pragma unroll
            for (int bj = 0; bj < 2; ++bj)
#pragma unroll
                for (int n = 0; n < 2; ++n) { f32x4 x = acc[ai][bj][m][n];
#pragma unroll
                    for (int j = 0; j < 4; ++j) { x[j] = __builtin_amdgcn_exp2f(x[j] * c - mx); s += x[j]; }
                    acc[ai][bj][m][n] = x; }
            s += __shfl_xor(s, 16); s += __shfl_xor(s, 32);
            if (fq == 0) XB[EPI_ROWS(ai, m) * 4 + wc] = s; asm volatile("" ::: "memory"); }
    LDS_WAIT(); __builtin_amdgcn_s_barrier(); asm volatile("" ::: "memory");
    unsigned char* base = (unsigned char*)u.C + 32 * wc + 8 * (fq & ~1); const bool odd = fq & 1;
#pragma unroll
    for (int ai = 0; ai < 2; ++ai) {
        u32x2 w8[4][2];
#pragma unroll
        for (int m = 0; m < 4; ++m) { const int r = EPI_ROWS(ai, m); const f32x4 q = *(const LAS f32x4*)(XB + r * 4); const float inv = P_S * __builtin_amdgcn_rcpf((q[0] + q[1]) + (q[2] + q[3]));
#pragma unroll
            for (int bj = 0; bj < 2; ++bj) { const f32x4 v0 = acc[ai][bj][m][0] * inv, v1 = acc[ai][bj][m][1] * inv; w8[m][bj].x = pk4_fp8(v0[0], v0[1], v0[2], v0[3]); w8[m][bj].y = pk4_fp8(v1[0], v1[1], v1[2], v1[3]); } }
#pragma unroll
        for (int mp = 0; mp < 4; mp += 2)
#pragma unroll
            for (int bj = 0; bj < 2; ++bj) { const u32x2 mine = odd ? w8[mp + 1][bj] : w8[mp][bj], send = odd ? w8[mp][bj] : w8[mp + 1][bj];
                u32x2 recv; recv.x = (unsigned)__shfl_xor((int)send.x, 16); recv.y = (unsigned)__shfl_xor((int)send.y, 16);
                u32x4 o; if (odd) { o.x = recv.x; o.y = recv.y; o.z = mine.x; o.w = mine.y; } else { o.x = mine.x; o.y = mine.y; o.z = recv.x; o.w = recv.y; }
                *(u32x4*)(base + (size_t)EPI_ROWS(ai, mp + (odd ? 1 : 0)) * ldc + bj * 128) = o; }
        asm volatile("" ::: "memory"); }
}
struct EpiFp8 {
    float scale0; int ldc0; float scale1; int ldc1;
    __device__ __forceinline__ void operator()(Acc& acc, const Unit& u, int, int wr, int wc, int fr, int fq, LAS unsigned char*) const {
        asm volatile("" : "+v"(fr), "+v"(fq));
        unsigned char* base = (unsigned char*)u.C + EPI_COL0; const float scale = u.aux ? scale1 : scale0; const int ldc = u.aux ? ldc1 : ldc0;
#pragma unroll
        for (int ai = 0; ai < 2; ++ai)
#pragma unroll
            for (int m = 0; m < 4; ++m)
#pragma unroll
                for (int bj = 0; bj < 2; ++bj) { const f32x4 v0 = acc[ai][bj][m][0] * scale, v1 = acc[ai][bj][m][1] * scale; u32x2 w; w.x = pk4_fp8(v0[0], v0[1], v0[2], v0[3]); w.y = pk4_fp8(v1[0], v1[1], v1[2], v1[3]);
                    *(u32x2*)(base + (size_t)EPI_ROWS(ai, m) * ldc + bj * 128) = w; }
    }
};
template <int MODE> struct EpiProj {
    int ldc; const float* rs; float* ssqv; int qt;
    LAS float* rtab; float sc;
    __device__ __forceinline__ void operator()(Acc& acc, const Unit& u, int ui, int wr, int wc, int fr, int fq, LAS unsigned char* scr) const {
        asm volatile("" : "+v"(fr), "+v"(fq));
        bf16_t* base = (bf16_t*)u.C + EPI_COL0;
#pragma unroll
        for (int ai = 0; ai < 2; ++ai)
#pragma unroll
            for (int m = 0; m < 4; ++m) {
                const int r = EPI_ROWS(ai, m), t = u.pm * 256 + r; const float rstd = rtab[ui * 256 + r] * sc;
                float sq = 0.f;
#pragma unroll
                for (int bj = 0; bj < 2; ++bj) { f32x4 v0 = acc[ai][bj][m][0] * rstd, v1 = acc[ai][bj][m][1] * rstd;
                    if (MODE == 1 && u.pn < 8) {
#pragma unroll
                        for (int j = 0; j < 4; ++j) { v0[j] = gelu_tanh(v0[j]); v1[j] = gelu_tanh(v1[j]); } }
                    const u32x4 w = pack8(v0, v1);
                    if (MODE == 1) { const float a0 = bflo(w.x), a1 = bfhi(w.x), a2 = bflo(w.y), a3 = bfhi(w.y), a4 = bflo(w.z), a5 = bfhi(w.z), a6 = bflo(w.w), a7 = bfhi(w.w);
                        sq += (a0 * a0 + a1 * a1) + (a2 * a2 + a3 * a3) + (a4 * a4 + a5 * a5) + (a6 * a6 + a7 * a7); }
                    *(u32x4*)(base + (size_t)r * ldc + bj * 128) = w; }
                if (MODE == 1 && u.pn >= 4 && u.pn < 8) { sq += __shfl_xor(sq, 16); sq += __shfl_xor(sq, 32); if (fq == 0) ssqv[(size_t)t * 16 + (u.pn - 4) * 4 + wc] = sq; }
            }
    }
};
template <int MODE> struct EpiScore {
    LAS float* rtab;
    __device__ __forceinline__ void operator()(Acc& acc, const Unit& u, int ui, int wr, int wc, int fr, int fq, LAS unsigned char* scr) const {
        asm volatile("" : "+v"(fr), "+v"(fq));
#pragma unroll
        for (int ai = 0; ai < 2; ++ai)
#pragma unroll
            for (int m = 0; m < 4; ++m) { const float rstd = rtab[ui * 256 + EPI_ROWS(ai, m)];
#pragma unroll
                for (int bj = 0; bj < 2; ++bj) { acc[ai][bj][m][0] = acc[ai][bj][m][0] * rstd; acc[ai][bj][m][1] = acc[ai][bj][m][1] * rstd; } }
        epi_softmax(acc, u, wr, wc, fr, fq, scr, 3072, 1.442695041f / WQ_S);
    }
};
struct EpiSpatial {
    const bf16_t* uproj; const float* bs;
    __device__ __forceinline__ void operator()(Acc& acc, const Unit& u, int, int wr, int wc, int fr, int fq, LAS unsigned char*) const {
        asm volatile("" : "+v"(fr), "+v"(fq));
        unsigned char* base = (unsigned char*)u.C + EPI_COL0; const bf16_t* ub = uproj + (size_t)u.pm * 256 * 3072 + u.pn * 256 + EPI_COL0;
#pragma unroll
        for (int ai = 0; ai < 2; ++ai)
#pragma unroll
            for (int m = 0; m < 4; ++m) { const int r = EPI_ROWS(ai, m); const float b = bs[u.pn * 128 + (r & 127)];
#pragma unroll
                for (int bj = 0; bj < 2; ++bj) { const u32x4 uw = *(const u32x4*)(ub + (size_t)r * 3072 + bj * 128); f32x4 v0 = acc[ai][bj][m][0] + b, v1 = acc[ai][bj][m][1] + b;
                    v0[0] *= bflo(uw.x); v0[1] *= bfhi(uw.x); v0[2] *= bflo(uw.y); v0[3] *= bfhi(uw.y); v1[0] *= bflo(uw.z); v1[1] *= bfhi(uw.z); v1[2] *= bflo(uw.w); v1[3] *= bfhi(uw.w);
                    v0 = v0 * MX_S; v1 = v1 * MX_S; u32x2 w8; w8.x = pk4_fp8(v0[0], v0[1], v0[2], v0[3]); w8.y = pk4_fp8(v1[0], v1[1], v1[2], v1[3]);
                    *(u32x2*)(base + (size_t)r * 3072 + bj * 128) = w8; }
                asm volatile("" ::: "memory"); }
    }
};
struct EpiOut {
    float* part; unsigned char* xb8; float rsc;
    __device__ __forceinline__ void operator()(Acc& acc, const Unit& u, int, int wr, int wc, int fr, int fq, LAS unsigned char* scr) const {
        asm volatile("" : "+v"(fr), "+v"(fq));
        bf16_t* base = (bf16_t*)u.C + EPI_COL0; LAS float* XA = (LAS float*)scr;
        const bool odd = fq & 1;
#pragma unroll
        for (int ai = 0; ai < 2; ++ai) {
            u32x4 xw[4][2];
#pragma unroll
            for (int m = 0; m < 4; ++m)
#pragma unroll
                for (int bj = 0; bj < 2; ++bj) xw[m][bj] = *(const u32x4*)(base + (size_t)EPI_ROWS(ai, m) * D + bj * 128);
            u32x2 w8[4][2];
#pragma unroll
            for (int m = 0; m < 4; ++m) { const int r = EPI_ROWS(ai, m); float sq = 0.f;
#pragma unroll
                for (int bj = 0; bj < 2; ++bj) { u32x4* p = (u32x4*)(base + (size_t)r * D + bj * 128); const u32x4 x = xw[m][bj]; f32x4 v0 = acc[ai][bj][m][0] * rsc, v1 = acc[ai][bj][m][1] * rsc;
                    v0[0] += bflo(x.x); v0[1] += bfhi(x.x); v0[2] += bflo(x.y); v0[3] += bfhi(x.y); v1[0] += bflo(x.z); v1[1] += bfhi(x.z); v1[2] += bflo(x.w); v1[3] += bfhi(x.w);
                    const u32x4 w = pack8(v0, v1); *p = w;
                    const float a0 = bflo(w.x), a1 = bfhi(w.x), a2 = bflo(w.y), a3 = bfhi(w.y), a4 = bflo(w.z), a5 = bfhi(w.z), a6 = bflo(w.w), a7 = bfhi(w.w);
                    w8[m][bj].x = pk4_fp8(a0, a1, a2, a3); w8[m][bj].y = pk4_fp8(a4, a5, a6, a7);
                    sq += (a0 * a0 + a1 * a1) + (a2 * a2 + a3 * a3) + (a4 * a4 + a5 * a5) + (a6 * a6 + a7 * a7); }
                sq += __shfl_xor(sq, 16); sq += __shfl_xor(sq, 32);
                if (fq == 0) XA[r * 4 + wc] = sq; }
#pragma unroll
            for (int mp = 0; mp < 4; mp += 2)
#pragma unroll
                for (int bj = 0; bj < 2; ++bj) { const u32x2 mine = odd ? w8[mp + 1][bj] : w8[mp][bj], send = odd ? w8[mp][bj] : w8[mp + 1][bj];
                    u32x2 recv; recv.x = (unsigned)__shfl_xor((int)send.x, 16); recv.y = (unsigned)__shfl_xor((int)send.y, 16);
                    u32x4 o; if (odd) { o.x = recv.x; o.y = recv.y; o.z = mine.x; o.w = mine.y; } else { o.x = mine.x; o.y = mine.y; o.z = recv.x; o.w = recv.y; }
                    const int r = EPI_ROWS(ai, mp + (odd ? 1 : 0));
                    *(u32x4*)(xb8 + (size_t)(u.pm * 256 + r) * D + u.pn * 256 + bj * 128 + 32 * wc + 8 * (fq & ~1)) = o; }
            asm volatile("" ::: "memory"); }
        LDS_WAIT(); __builtin_amdgcn_s_barrier(); asm volatile("" ::: "memory");
        { int tid = threadIdx.x; asm volatile("" : "+v"(tid));
          if (tid < 256) { const f32x4 q = *(const LAS f32x4*)(XA + tid * 4); part[(size_t)(u.pm * 256 + tid) * 8 + u.pn] = (q[0] + q[1]) + (q[2] + q[3]); } }
    }
};
struct EpiRoute {
    float* lg;
    __device__ __forceinline__ void operator()(Acc& acc, const Unit& u, int, int wr, int wc, int fr, int fq, LAS unsigned char*) const {
        asm volatile("" : "+v"(fr), "+v"(fq));
        if (wc >= 2) return;
        float* base = lg + (size_t)u.pn * T * 64 + (size_t)u.pm * 256 * 64 + EPI_COL0;
#pragma unroll
        for (int ai = 0; ai < 2; ++ai)
#pragma unroll
            for (int m = 0; m < 4; ++m) { float* rowp = base + (size_t)EPI_ROWS(ai, m) * 64;
                if (wc == 0) { *(f32x4*)rowp = acc[ai][0][m][0] + acc[ai][1][m][0]; *(f32x4*)(rowp + 4) = acc[ai][0][m][1] + acc[ai][1][m][1]; }
                else if (fq == 0) *(f32x4*)rowp = acc[ai][0][m][0] + acc[ai][1][m][0]; }
    }
};
struct SchedMoe {
    LAS int* pre; LAS int* cnt; LAS int* idx; LAS int* preB; LAS int* preS; int lo, hi, G, c, nbu, nunits; int mode;
    int perm;
    __device__ __forceinline__ int plist(int p) const { return perm ? ((p & 1) * 32 + (p >> 1)) : p; }
    LAS int* ul; int nmy;
    const char* A0; const char* B0; char* C0;
    __device__ __forceinline__ bool decode(int i, int& l, int& rt, int& pn, int& tile) const {
        const long L = (long)i * G + c; if (L >= nunits) return false;
        int wgid = (int)L, q; LAS int* px; bool small = wgid >= nbu;
        if (!small) { const int qq = nbu / 8, r = nbu % 8, xcd = wgid % 8, off = wgid / 8; wgid = (xcd < r ? xcd * (qq + 1) : r * (qq + 1) + (xcd - r) * qq) + off; q = wgid >> 3; px = preB; }
        else { wgid -= nbu; q = wgid >> 3; px = preS; }
        pn = wgid & 7;
        const int base = rfl(px[lo]); int a = lo, b = hi;
        while (b - a > 1) { const int mid = (a + b) >> 1; if (rfl(px[mid]) - base <= q) a = mid; else b = mid; }
        l = a; rt = small ? ((rfl(cnt[l]) + 255) >> 8) - 1 : q - (rfl(px[l]) - base); tile = rfl(pre[l]) + rt; return true;
    }
    __device__ __forceinline__ void decode_t(int i, int& l, int& rt, int& pn, int& tile) const {
        int wgid = i * G + c, q; LAS int* px; const bool small = wgid >= nbu;
        if (!small) { const int qq = nbu / 8, r = nbu % 8, xcd = wgid % 8, off = wgid / 8; wgid = (xcd < r ? xcd * (qq + 1) : r * (qq + 1) + (xcd - r) * qq) + off; q = wgid >> 3; px = preB; }
        else { wgid -= nbu; q = wgid >> 3; px = preS; }
        pn = wgid & 7;
        const int base = px[lo]; int a = lo, b = hi;
        while (b - a > 1) { const int mid = (a + b) >> 1; if (px[mid] - base <= q) a = mid; else b = mid; }
        l = plist(a); rt = small ? ((cnt[l] + 255) >> 8) - 1 : q - (px[a] - base); tile = pre[l] + rt;
    }
    __device__ __forceinline__ bool next(int i, Unit& u) const {
        if (i >= nmy) return false;
        const int w0 = rfl(ul[2 * i]), w1 = rfl(ul[2 * i + 1]); const int l = w0 & 255, rt = (w0 >> 8) & 4095, pn = w0 >> 20, tile = w1 & 0xffff;
        const int e = l & 31;
        u.pm = rt; u.pn = pn; u.aux = l; u.nvalid = w1 >> 16;
        if (mode == 0) { u.A = A0; u.B = B0 + (size_t)e * (2048 * 2048) + (size_t)pn * (128 * 2048); u.C = C0 + (size_t)tile * (256 * 1024) + (size_t)pn * 128; }
        else { u.A = A0 + (size_t)tile * (256 * 1024); u.B = B0 + (size_t)e * (2048 * 1024) + (size_t)pn * (256 * 1024); u.C = C0; }
        return true;
    }
    __device__ __forceinline__ int row(int j, int r) const { return idx[j * 256 + r] & 0x1ffff; }
};
template <int KIND  >
__device__ __forceinline__ void moe_setup(SchedMoe& S, const int* totals, const int* listp, const float* vals) {
    int tid = threadIdx.x; LAS int* cnt = S.cnt;
    if (tid < 64) { const int c_ = totals[tid]; cnt[tid] = c_; int a = (c_ + 255) >> 8;
        const int cp = totals[S.plist(tid)], nt_ = (cp + 255) >> 8, sm = (nt_ > 0 && cp - (nt_ - 1) * 256 <= 128) ? 1 : 0; int ab = nt_ - sm, as = sm;
#pragma unroll
        for (int o = 1; o < 64; o <<= 1) { const int ta = __shfl_up(a, o), tb = __shfl_up(ab, o), ts = __shfl_up(as, o); if (tid >= o) { a += ta; ab += tb; as += ts; } }
        S.pre[tid + 1] = a; S.preB[tid + 1] = ab; S.preS[tid + 1] = as; if (tid == 0) { S.pre[0] = 0; S.preB[0] = 0; S.preS[0] = 0; } }
    __syncthreads();
    S.nbu = (rfl(S.preB[S.hi]) - rfl(S.preB[S.lo])) * 8; S.nunits = S.nbu + (rfl(S.preS[S.hi]) - rfl(S.preS[S.lo])) * 8;
    { const int n_ = S.c < S.nunits ? (S.nunits - S.c + S.G - 1) / S.G : 0; S.nmy = n_ < MAX_MOE_UNITS ? n_ : MAX_MOE_UNITS; }
    if (tid < S.nmy) { int li, rt, pn, tile; S.decode_t(tid, li, rt, pn, tile); const int nv_ = cnt[li] - rt * 256; S.ul[2 * tid] = li | (rt << 8) | (pn << 20); S.ul[2 * tid + 1] = tile | ((nv_ < 256 ? nv_ : 256) << 16); }
    __syncthreads();
    const int j2 = tid >> 8, r = tid & 255; int tk[6]; float vv[6]; size_t off[6];
#pragma unroll
    for (int q = 0; q < 6; ++q) { const int j = j2 + 2 * q; tk[q] = T; vv[q] = 0.f; off[q] = 0;
        if (j < S.nmy) { const int w0 = S.ul[2 * j], w1 = S.ul[2 * j + 1]; const int li = w0 & 255, rt = (w0 >> 8) & 4095, nv = w1 >> 16;
            if (r < nv) { off[q] = (size_t)li * T + rt * 256 + r; tk[q] = listp[off[q]]; if (KIND == 1) vv[q] = vals[off[q]]; } } }
    if (KIND == 0) {
#pragma unroll
        for (int q = 0; q < 6; ++q) vv[q] = vals[tk[q]]; }
#pragma unroll
    for (int q = 0; q < 6; ++q) { const int j = j2 + 2 * q; if (j < S.nmy) S.idx[j * 256 + r] = tk[q] | (int)(((__float_as_uint(vv[q]) + 0x8000u) >> 16) << 17); }
    __syncthreads();
}
struct EpiGu {
    const float* rstd; LAS int* idx;
    __device__ __forceinline__ void operator()(Acc& acc, const Unit& u, int ui, int wr, int wc, int fr, int fq, LAS unsigned char*) const {
        asm volatile("" : "+v"(fr), "+v"(fq));
        unsigned char* base = (unsigned char*)u.C + EPI_COL0;
#pragma unroll
        for (int ai = 0; ai < 2; ++ai)
#pragma unroll
            for (int m = 0; m < 4; ++m) { const int r = EPI_ROWS(ai, m); const float rs = __uint_as_float(((unsigned)idx[ui * 256 + r] >> 17) << 16) * (1.0f / GU_WS);
                f32x4 h0, h1;
#pragma unroll
                for (int j = 0; j < 4; ++j) { h0[j] = silu_f(acc[ai][0][m][0][j] * rs) * (acc[ai][1][m][0][j] * (rs * HID_S)); h1[j] = silu_f(acc[ai][0][m][1][j] * rs) * (acc[ai][1][m][1][j] * (rs * HID_S)); }
                u32x2 w; w.x = pk4_fp8(h0[0], h0[1], h0[2], h0[3]); w.y = pk4_fp8(h1[0], h1[1], h1[2], h1[3]);
                *(u32x2*)(base + (size_t)r * DEXP) = w; }
    }
};
template <int MODE> struct EpiDown {
    bf16_t* xb; unsigned char* y0; unsigned char* y1; LAS int* idx; float* part; float rsc, ysc; unsigned char* x8;
    __device__ __forceinline__ void operator()(Acc& acc, const Unit& u, int ui, int wr, int wc, int fr, int fq, LAS unsigned char*) const {
        asm volatile("" : "+v"(fr), "+v"(fq));
        int tok[2][4]; float gt[2][4];
#pragma unroll
        for (int ai = 0; ai < 2; ++ai)
#pragma unroll
            for (int m = 0; m < 4; ++m) { const unsigned e = (unsigned)idx[ui * 256 + EPI_ROWS(ai, m)]; tok[ai][m] = (int)(e & 0x1ffffu); gt[ai][m] = __uint_as_float((e >> 17) << 16) * rsc; }
        if constexpr (MODE == 0) {
            unsigned char* yb = (u.aux >> 5) ? y1 : y0; const bool odd = fq & 1;
#pragma unroll
            for (int ai = 0; ai < 2; ++ai) {
                u32x2 w8[4][2];
#pragma unroll
                for (int m = 0; m < 4; ++m) { const float g = gt[ai][m] * Y_S;
#pragma unroll
                    for (int bj = 0; bj < 2; ++bj) { const f32x4 v0 = acc[ai][bj][m][0] * g, v1 = acc[ai][bj][m][1] * g; w8[m][bj].x = pk4_fp8(v0[0], v0[1], v0[2], v0[3]); w8[m][bj].y = pk4_fp8(v1[0], v1[1], v1[2], v1[3]); } }
#pragma unroll
                for (int mp = 0; mp < 4; mp += 2) { const int msk = -(int)(fq & 1); const int tk = (tok[ai][mp] & ~msk) | (tok[ai][mp + 1] & msk); const int ts = tk + (tk >= T ? 1 : 0);
#pragma unroll
                    for (int bj = 0; bj < 2; ++bj) { const u32x2 mine = odd ? w8[mp + 1][bj] : w8[mp][bj], send = odd ? w8[mp][bj] : w8[mp + 1][bj];
                        u32x2 recv; recv.x = (unsigned)__shfl_xor((int)send.x, 16); recv.y = (unsigned)__shfl_xor((int)send.y, 16);
                        u32x4 o; if (odd) { o.x = recv.x; o.y = recv.y; o.z = mine.x; o.w = mine.y; } else { o.x = mine.x; o.y = mine.y; o.z = recv.x; o.w = recv.y; }
                        *(u32x4*)(yb + (size_t)ts * D + u.pn * 256 + bj * 128 + 32 * wc + 8 * (fq & ~1)) = o; } }
                asm volatile("" ::: "memory"); }
        } else {
#pragma unroll
            for (int ai = 0; ai < 2; ++ai) {
                u32x4 xw[4][2]; u32x2 yw[4][2]; u32x2 w8[4][2];
#pragma unroll
                for (int m = 0; m < 4; ++m)
#pragma unroll
                    for (int bj = 0; bj < 2; ++bj) { xw[m][bj] = *(const u32x4*)(xb + (size_t)tok[ai][m] * D + u.pn * 256 + EPI_COL0 + bj * 128); yw[m][bj] = *(const u32x2*)(y0 + (size_t)tok[ai][m] * D + u.pn * 256 + EPI_COL0 + bj * 128); }
#pragma unroll
                for (int m = 0; m < 4; ++m) { const float g = gt[ai][m]; float sq = 0.f; const int ts = tok[ai][m] + (tok[ai][m] >= T ? 1 : 0); bf16_t* rowp = xb + (size_t)ts * D + u.pn * 256 + EPI_COL0;
#pragma unroll
                    for (int bj = 0; bj < 2; ++bj) { const u32x4 x = xw[m][bj]; float y[8]; fp8x8_to_f32(yw[m][bj], y); f32x4 v0 = acc[ai][bj][m][0] * g, v1 = acc[ai][bj][m][1] * g;
                        v0[0] += bflo(x.x) + y[0] * ysc; v0[1] += bfhi(x.x) + y[1] * ysc; v0[2] += bflo(x.y) + y[2] * ysc; v0[3] += bfhi(x.y) + y[3] * ysc;
                        v1[0] += bflo(x.z) + y[4] * ysc; v1[1] += bfhi(x.z) + y[5] * ysc; v1[2] += bflo(x.w) + y[6] * ysc; v1[3] += bfhi(x.w) + y[7] * ysc;
                        const u32x4 w = pack8(v0, v1); *(u32x4*)(rowp + bj * 128) = w;
                        const float a0 = bflo(w.x), a1 = bfhi(w.x), a2 = bflo(w.y), a3 = bfhi(w.y), a4 = bflo(w.z), a5 = bfhi(w.z), a6 = bflo(w.w), a7 = bfhi(w.w);
                        w8[m][bj].x = pk4_fp8(a0, a1, a2, a3); w8[m][bj].y = pk4_fp8(a4, a5, a6, a7);
                        sq += (a0 * a0 + a1 * a1) + (a2 * a2 + a3 * a3) + (a4 * a4 + a5 * a5) + (a6 * a6 + a7 * a7); }
                    if (part) { sq += __shfl_xor(sq, 16); sq += __shfl_xor(sq, 32); if (fq == 0 && ts < T) part[(size_t)ts * 32 + u.pn * 4 + wc] = sq; } }
#pragma unroll
                for (int mp = 0; mp < 4; mp += 2) { const int msk = -(int)(fq & 1); const int tk = (tok[ai][mp] & ~msk) | (tok[ai][mp + 1] & msk); const int ts = tk + (tk >= T ? 1 : 0); const bool odd = fq & 1;
#pragma unroll
                    for (int bj = 0; bj < 2; ++bj) { const u32x2 mine = odd ? w8[mp + 1][bj] : w8[mp][bj], send = odd ? w8[mp][bj] : w8[mp + 1][bj];
                        u32x2 recv; recv.x = (unsigned)__shfl_xor((int)send.x, 16); recv.y = (unsigned)__shfl_xor((int)send.y, 16);
                        u32x4 o; if (odd) { o.x = recv.x; o.y = recv.y; o.z = mine.x; o.w = mine.y; } else { o.x = mine.x; o.y = mine.y; o.z = recv.x; o.w = recv.y; }
                        *(u32x4*)(x8 + (size_t)ts * D + u.pn * 256 + bj * 128 + 32 * wc + 8 * (fq & ~1)) = o; } }
                asm volatile("" ::: "memory"); }
        }
    }
};
struct SchedSp { pg8::SchedGrid g; __device__ __forceinline__ bool next(int i, Unit& u) const { if (!g.next(i, u)) return false; u.B = g.B0 + ((size_t)u.pm * 4 + u.pn) * (256 * 512); return true; } __device__ __forceinline__ int row(int, int) const { return 0; } };
struct SchedProj {
    int nN, qt, G, c; const char* A0; const char* B0; const char* BQ; char* C0; size_t c_pm; char* CQ; int rb;
    __device__ __forceinline__ bool next(int i, Unit& u) const {
        int pm, pn; if (!pg8::grid_order(i, G, c, T / 256, nN, pm, pn)) return false;
        u.pm = pm; u.pn = pn; u.aux = 0; u.nvalid = 256;
        if (qt) { u.A = A0 + (size_t)pm * 256 * rb; u.B = B0 + (size_t)pn * 256 * rb; u.C = C0 + (size_t)pm * c_pm + (size_t)pn * 512; }
        else { u.A = A0 + (size_t)pm * (256 * 2048); u.B = BQ + (size_t)(pm >> 6) * (1024 * 2048) + (size_t)pn * (256 * 2048); u.C = CQ + (size_t)pm * (256 * 3072) + (size_t)(2048 + pn * 256); }
        return true;
    }
    __device__ __forceinline__ int row(int, int) const { return 0; }
};
template <int MODE, class Sched> __device__ __forceinline__ void proj_fill_rstd(const Sched& S, const float* rs, LAS float* rtab) {
    Unit u; int tid = threadIdx.x;
    for (int j = 0; j < 6 && S.next(j, u); ++j)
        if (tid < 256) { const int t = u.pm * 256 + tid; float v;
            if (MODE == 0) v = rs[t];
            else { const f32x4* pp = (const f32x4*)(rs + (size_t)t * 32); float sm = 0.f;
#pragma unroll
                for (int q = 0; q < 8; ++q) { const f32x4 p = pp[q]; sm += (p[0] + p[1]) + (p[2] + p[3]); }
                v = __builtin_amdgcn_rsqf(sm * (1.0f / D) + EPS); }
            rtab[j * 256 + tid] = v; }
    __syncthreads();
}
struct SchedKV {
    int G, c; const char* memn; const char* wkv; char* kvn;
    __device__ __forceinline__ bool next(int i, Unit& u) const {
        const int id = i * G + c; if (id >= 32) return false;
        const int l = id >> 4, b = (id >> 3) & 1, j = id & 7;
        u.pm = 0; u.pn = 0; u.nvalid = 256; u.aux = 2048;
        u.A = memn + (size_t)l * (512 * 4096) + (size_t)b * (256 * 4096); u.B = wkv + (size_t)l * (2048 * 4096) + (size_t)j * (256 * 4096);
        u.C = kvn + (size_t)l * (512 * 4096) + (size_t)b * (256 * 4096) + (size_t)j * 512; return true;
    }
    __device__ __forceinline__ int row(int, int) const { return 0; }
};
struct SchedFold {
    int G, c; const char* woutT; const char* kvn; const char* grpn; char* bto; const char* wqn; char* winq; int mode;
    __device__ __forceinline__ bool next(int i, Unit& u) const {
        const int id = i * G + c; if (id >= (mode ? 256 : 64)) return false;
        u.pm = 0; u.pn = 0; u.nvalid = 256; u.aux = 0;
        if (mode == 0) { const int b = id >> 5, g = (id >> 3) & 3, rt = id & 7;
            u.A = woutT + (size_t)rt * (256 * 4096) + (size_t)g * 512; u.B = grpn + (size_t)g * 512;
            u.C = bto + (size_t)b * (2048 * 3072) + (size_t)rt * (256 * 3072) + (size_t)g * 512; u.aux = 1536; }
        else if (id < 128) { const int l = id >> 6, b = (id >> 5) & 1, h = (id >> 3) & 3, rt = id & 7;
            u.A = woutT + (size_t)l * (2048 * 4096) + (size_t)rt * (256 * 4096) + (size_t)(1024 + h * 256) * 2;
            u.B = kvn + (size_t)l * (512 * 4096) + (size_t)b * (256 * 4096) + (size_t)(1024 + h * 256) * 2;
            u.C = bto + (size_t)(l * 2 + b) * (2048 * 3072) + (size_t)rt * (256 * 3072) + (size_t)(2048 + h * 256); }
        else { const int r = id - 128, l = r >> 6, b = (r >> 5) & 1, h = (r >> 3) & 3, ct = r & 7;
            u.A = kvn + (size_t)l * (512 * 4096) + (size_t)b * (256 * 4096) + (size_t)h * 512;
            u.B = wqn + (size_t)l * (2048 * 4096) + (size_t)ct * (256 * 4096) + (size_t)h * 512;
            u.C = winq + (size_t)(l * 2 + b) * (1024 * 2048) + (size_t)h * (256 * 2048) + (size_t)ct * 256; u.aux = 1; }
        return true;
    }
    __device__ __forceinline__ int row(int, int) const { return 0; }
};

struct Args { const float* in[22]; float* out; unsigned char* ws; int ph_lo, ph_hi; };
struct Frame { LAS unsigned char* lds; LAS unsigned char* scr; int tid, lane, wave, G, bid; };

struct TrDesc { const float* W; void* WT; const float* ks; const float* ns; float cs; int ldw, kd, k0, n0; bool f8; };
__device__ __forceinline__ void tr_load(const TrDesc& d, f32x4 (&v)[16], int lane) {
    const int kq = lane >> 4, n4 = (lane & 15) * 4;
#pragma unroll
    for (int i = 0; i < 16; ++i) v[i] = *(const f32x4*)(d.W + (size_t)(d.k0 + 16 * kq + i) * d.ldw + d.n0 + n4);
}
__device__ __forceinline__ void tr_finish(const TrDesc& d, f32x4 (&v)[16], LAS unsigned* s32, int lane) {
    const int kq = lane >> 4, n4 = (lane & 15) * 4;
    f32x4 ns = (f32x4){d.cs, d.cs, d.cs, d.cs}; if (d.ns) ns = *(const f32x4*)(d.ns + d.n0 + n4) * d.cs;
    if (d.ks) {
#pragma unroll
        for (int q = 0; q < 4; ++q) { const f32x4 ks = *(const f32x4*)(d.ks + d.k0 + 16 * kq + 4 * q);
#pragma unroll
            for (int e = 0; e < 4; ++e) v[4 * q + e] = v[4 * q + e] * ks[e]; } }
#pragma unroll
    for (int i = 0; i < 16; ++i) v[i] = v[i] * ns;
    if (!d.f8) {
#pragma unroll
        for (int j = 0; j < 4; ++j)
#pragma unroll
            for (int p = 0; p < 8; ++p) s32[(n4 + j) * 33 + 8 * kq + p] = cvt_pk_bf16(v[2 * p][j], v[2 * p + 1][j]);
        LDS_WAIT(); asm volatile("" ::: "memory");
        const int c = lane & 7; bf16_t* WT = (bf16_t*)d.WT;
#pragma unroll
        for (int j = 0; j < 8; ++j) { const int n = (lane >> 3) + 8 * j; const LAS unsigned* sp = s32 + n * 33 + 4 * c;
            u32x4 o; o.x = sp[0]; o.y = sp[1]; o.z = sp[2]; o.w = sp[3];
            *(u32x4*)(WT + (size_t)(d.n0 + n) * d.kd + d.k0 + 8 * c) = o; }
    } else {
#pragma unroll
        for (int j = 0; j < 4; ++j)
#pragma unroll
            for (int p = 0; p < 4; ++p) s32[(n4 + j) * 17 + 4 * kq + p] = pk4_fp8(v[4 * p][j], v[4 * p + 1][j], v[4 * p + 2][j], v[4 * p + 3][j]);
        LDS_WAIT(); asm volatile("" ::: "memory");
        const int c = lane & 3; unsigned char* WT = (unsigned char*)d.WT;
#pragma unroll
        for (int j = 0; j < 4; ++j) { const int n = (lane >> 2) + 16 * j; const LAS unsigned* sp = s32 + n * 17 + 4 * c;
            u32x4 o; o.x = sp[0]; o.y = sp[1]; o.z = sp[2]; o.w = sp[3];
            *(u32x4*)(WT + (size_t)(d.n0 + n) * d.kd + d.k0 + 16 * c) = o; }
    }
    LDS_WAIT(); asm volatile("" ::: "memory");
}
__device__ __forceinline__ void tr_desc(TrDesc& d, const float* W, int K, int N, void* WT, const float* ks, const float* ns, float cs, bool f8, int item) {
    const int nblk = N / 64, kb = item / nblk, nb = item % nblk;
    d.W = W; d.WT = WT; d.ks = ks; d.ns = ns; d.cs = cs; d.ldw = N; d.kd = K; d.k0 = 64 * kb; d.n0 = 64 * nb; d.f8 = f8;
}

#define x_in (args.in[0])
#define mem_in (args.in[1])
#define norm_mix_g (args.in[2])
#define norm_mem_g (args.in[3])
#define norm_ffn_g (args.in[4])
#define pool_w_in (args.in[5])
#define pool_w_grp (args.in[6])
#define pool_scale (args.in[7])
#define pool_w_out (args.in[8])
#define sgu_w_in (args.in[9])
#define sgu_norm_g (args.in[10])
#define sgu_w_s (args.in[11])
#define sgu_b_s (args.in[12])
#define sgu_w_out (args.in[13])
#define xa_w_kv (args.in[14])
#define moe_w_group (args.in[15])
#define moe_b_group (args.in[16])
#define moe_w_expert (args.in[17])
#define moe_b_expert (args.in[18])
#define moe_w_gu (args.in[19])
#define moe_w_down (args.in[20])
#define final_norm_g (args.in[21])
#define WSP(type, off) ((type*)(args.ws + (off)))
#define RSTD0 WSP(float, WS_RSTD)
#define RSTD1 WSP(float, WS_RSTD + RSTD_STRIDE)
#define PART1 WSP(float, WS_PART1)
#define PART2 WSP(float, WS_PART2)
#define SSQV WSP(float, WS_SSQV)
#define LOGITS WSP(float, WS_LOGITS)
#define LIST WSP(int, WS_LIST)
#define GATEW WSP(float, WS_GATEW)
#define KMAT WSP(bf16_t, WS_KMAT)
#define VT WSP(bf16_t, WS_VT)
#define MEMN WSP(bf16_t, WS_MEMN)
#define WIN0 WSP(bf16_t, WS_WIN0)
#define WIN1 WSP(bf16_t, WS_WIN1)
#define WOUT WSP(bf16_t, WS_WOUT)
#define WKV WSP(bf16_t, WS_WKV)
#define GRP WSP(bf16_t, WS_GRP)
#define W2 WSP(bf16_t, WS_W2)
#define RT WSP(bf16_t, WS_RT)
#define GUT WSP(unsigned char, WS_GUT)
#define DOWNT WSP(unsigned char, WS_DOWNT)
#define XB WSP(bf16_t, WS_XB)
#define PROJ WSP(bf16_t, WS_PROJ)
#define POOLED WSP(bf16_t, WS_POOLED)
#define PBUF WSP(bf16_t, WS_PBUF)
#define CONCAT WSP(bf16_t, WS_CONCAT)
#define HIDDEN WSP(unsigned char, WS_HIDDEN)
#define CNTM WSP(int, WS_CNT)
#define TOTALS WSP(int, WS_CNT + 128 * 1024)
#define TOKREC WSP(u32x4, WS_TOKREC)
#define XB8 WSP(unsigned char, WS_XB8)
#define BTO WSP(bf16_t, WS_BTO)
#define GRPW WSP(bf16_t, WS_GRPW)
#define WQN WSP(bf16_t, WS_WQN)
#define WINQ WSP(unsigned char, WS_WINQ)
#define KVN WSP(bf16_t, WS_KMAT)
#define YB0 WSP(unsigned char, WS_PROJ)
#define YB1 WSP(unsigned char, WS_PROJ + 96 * MiB)

#ifndef PHMASK
#define PHMASK 0xffffffffu
#endif
#define IN(k) (((PHMASK >> (((k) < 3) ? (k) : ((k) == 23 ? 13 : 3 + ((k) - 3) % 10))) & 1u) && lo <= (k) && (k) < hi)
#ifndef PROBE_EPI2
#define PROBE_EPI2 false
#endif
#ifndef RMASK
#define RMASK 0u
#endif
#define PHASE(k) if (IN(k)) _Pragma("unroll") for (int rep_ = 0; rep_ < 1 + (int)((RMASK >> (k)) & 1u); ++rep_)
#define REPBAR() do { if (rep_) xcd_barrier(bar); } while (0)
#define SEAM(k) do { if (IN(k) && IN((k) + 1)) xcd_barrier(bar); } while (0)

constexpr int TAIL_PER0 = 4096, TAIL_PER1 = 2048, TAIL_WIN0 = 9, TAIL_WIN1 = 6, TAIL_ITEMS = TAIL_WIN0 * TAIL_PER0 + TAIL_WIN1 * TAIL_PER1;
constexpr int TAIL_HG = TAIL_ITEMS < 32768 ? TAIL_ITEMS : 32768, TAIL_HD = TAIL_ITEMS - TAIL_HG;
#define TAIL_DESC(d_, h_) do { const int hh_ = (h_); if (hh_ < 32768) { const int le_ = 32 + (hh_ >> 10); tr_desc(d_, moe_w_gu + (size_t)le_ * D * D, 2048, 2048, GUT + (size_t)le_ * D * D, norm_ffn_g + D, nullptr, GU_WS, true, hh_ & 1023); } \
        else { const int q_ = hh_ - 32768, le_ = 32 + (q_ >> 9); tr_desc(d_, moe_w_down + (size_t)le_ * DEXP * D, 1024, 2048, DOWNT + (size_t)le_ * DEXP * D, nullptr, nullptr, DN_WS, true, q_ & 511); } } while (0)
#define TAIL_CONVERT(w_) do { if ((l == 0) || (w_) < TAIL_WIN1) { const int tb_ = l == 0 ? (w_) * TAIL_PER0 : TAIL_WIN0 * TAIL_PER0 + (w_) * TAIL_PER1, tn_ = l == 0 ? TAIL_PER0 : TAIL_PER1; \
        __syncthreads(); LAS unsigned* tscr_ = (LAS unsigned*)(F.lds + F.wave * 16384); TrDesc dA_, dB_; f32x4 vA_[16], vB_[16]; \
        for (int j_ = gw; j_ < tn_; j_ += 2 * NGW) { const bool hasB_ = j_ + NGW < tn_; \
            TAIL_DESC(dA_, tb_ + j_); tr_load(dA_, vA_, F.lane); if (hasB_) { TAIL_DESC(dB_, tb_ + j_ + NGW); tr_load(dB_, vB_, F.lane); } \
            tr_finish(dA_, vA_, tscr_, F.lane); if (hasB_) tr_finish(dB_, vB_, tscr_, F.lane); } } } while (0)
template <int l> __device__ __forceinline__ void layer_phases(const Args& args, const Frame& F, const XcdBarrier& bar, unsigned* ctl, const int lo, const int hi, const int gw, const int NGW, const int gt, const int NGT) {
#ifdef LMASK
        if (!((LMASK >> l) & 1)) return;
#endif
        constexpr int pb = 3 + 10 * l;
        const int ldp = l ? 3072 : 2048, qoff = l ? 2048 : 1024;
        float* RS1 = (float*)((char*)RSTD1 + (size_t)l * RSTD_STRIDE); float* P1 = PART1 + (size_t)l * T * 32;
        PHASE(pb + 0) { REPBAR();
            if (l == 0) {
                if (F.G < EARLY_PLAIN_MIN_G)
                { SchedProj S{4, 4, F.G, F.bid, (const char*)XB, (const char*)WIN0, nullptr, (char*)PROJ, (size_t)256 * 2048 * 2, nullptr, 4096};
                  LAS float* rtab = (LAS float*)(F.scr + SCR_IDX); proj_fill_rstd<0>(S, RSTD0, rtab); EpiProj<0> E{2048, RSTD0, nullptr, 4, rtab, 1.f};
                  pg8::gemm_phase<EpiProj<0>, SchedProj, false>(F.lds, F.scr, 2048, 4096u, 4096u, (size_t)128 * 4096, S, E); }
                const bool early = F.G >= EARLY_PLAIN_MIN_G, poolfirst = early && (F.bid & 1);
                if (poolfirst) {
                for (int it = gt; it < (T / 32) * 128; it += NGT) {
                    const int chunk = it & 127, rb = it >> 7, c0 = chunk * 8, g = c0 >> 8, w = 2 << g, t0 = rb * 32, tl0 = t0 & (SEQ - 1);
                    const bf16_t* pp = PROJ + (size_t)t0 * 2048 + c0; bf16_t* op = CONCAT + (size_t)t0 * 1536 + c0; float s[8];
#pragma unroll
                    for (int j = 0; j < 8; ++j) s[j] = 0.f;
                    for (int j = 1; j < w; ++j) if (tl0 - j >= 0) { const u32x4 v = *(const u32x4*)(pp - (size_t)j * 2048);
                        s[0] += bflo(v.x); s[1] += bfhi(v.x); s[2] += bflo(v.y); s[3] += bfhi(v.y); s[4] += bflo(v.z); s[5] += bfhi(v.z); s[6] += bflo(v.w); s[7] += bfhi(v.w); }
#pragma unroll 8
                    for (int r = 0; r < 32; ++r) { const int tl = tl0 + r; const u32x4 v = *(const u32x4*)(pp + (size_t)r * 2048); float p[8] = {bflo(v.x), bfhi(v.x), bflo(v.y), bfhi(v.y), bflo(v.z), bfhi(v.z), bflo(v.w), bfhi(v.w)};
                        const float inv = 1.0f / (float)(tl + 1 < w ? tl + 1 : w); float o[8];
#pragma unroll
                        for (int j = 0; j < 8; ++j) { s[j] += p[j]; o[j] = s[j] * inv - p[j]; }
                        u32x4 ow; ow.x = pk2(o[0], o[1]); ow.y = pk2(o[2], o[3]); ow.z = pk2(o[4], o[5]); ow.w = pk2(o[6], o[7]); *(u32x4*)(op + (size_t)r * 1536) = ow;
                        if (tl - (w - 1) >= 0) { const u32x4 q = *(const u32x4*)(pp + (size_t)(r - (w - 1)) * 2048);
                            s[0] -= bflo(q.x); s[1] -= bfhi(q.x); s[2] -= bflo(q.y); s[3] -= bfhi(q.y); s[4] -= bflo(q.z); s[5] -= bfhi(q.z); s[6] -= bflo(q.w); s[7] -= bfhi(q.w); } }
                }
                                }
                { SchedProj S{4, 0, F.G, F.bid, (const char*)XB8, nullptr, (const char*)WINQ, nullptr, 0, (char*)CONCAT};
                  LAS float* rtab = (LAS float*)(F.scr + SCR_IDX); proj_fill_rstd<0>(S, RSTD0, rtab); EpiScore<0> E{rtab};
                  pg8::gemm_phase<EpiScore<0>, SchedProj, false, true>(F.lds, F.scr, 1024, 2048u, 2048u, (size_t)128 * 2048, S, E); }
                if (early && !poolfirst) {
                for (int it = gt; it < (T / 32) * 128; it += NGT) {
                    const int chunk = it & 127, rb = it >> 7, c0 = chunk * 8, g = c0 >> 8, w = 2 << g, t0 = rb * 32, tl0 = t0 & (SEQ - 1);
                    const bf16_t* pp = PROJ + (size_t)t0 * 2048 + c0; bf16_t* op = CONCAT + (size_t)t0 * 1536 + c0; float s[8];
#pragma unroll
                    for (int j = 0; j < 8; ++j) s[j] = 0.f;
                    for (int j = 1; j < w; ++j) if (tl0 - j >= 0) { const u32x4 v = *(const u32x4*)(pp - (size_t)j * 2048);
                        s[0] += bflo(v.x); s[1] += bfhi(v.x); s[2] += bflo(v.y); s[3] += bfhi(v.y); s[4] += bflo(v.z); s[5] += bfhi(v.z); s[6] += bflo(v.w); s[7] += bfhi(v.w); }
#pragma unroll 8
                    for (int r = 0; r < 32; ++r) { const int tl = tl0 + r; const u32x4 v = *(const u32x4*)(pp + (size_t)r * 2048); float p[8] = {bflo(v.x), bfhi(v.x), bflo(v.y), bfhi(v.y), bflo(v.z), bfhi(v.z), bflo(v.w), bfhi(v.w)};
                        const float inv = 1.0f / (float)(tl + 1 < w ? tl + 1 : w); float o[8];
#pragma unroll
                        for (int j = 0; j < 8; ++j) { s[j] += p[j]; o[j] = s[j] * inv - p[j]; }
                        u32x4 ow; ow.x = pk2(o[0], o[1]); ow.y = pk2(o[2], o[3]); ow.z = pk2(o[4], o[5]); ow.w = pk2(o[6], o[7]); *(u32x4*)(op + (size_t)r * 1536) = ow;
                        if (tl - (w - 1) >= 0) { const u32x4 q = *(const u32x4*)(pp + (size_t)(r - (w - 1)) * 2048);
                            s[0] -= bflo(q.x); s[1] -= bfhi(q.x); s[2] -= bflo(q.y); s[3] -= bfhi(q.y); s[4] -= bflo(q.z); s[5] -= bfhi(q.z); s[6] -= bflo(q.w); s[7] -= bfhi(q.w); } }
                }
                                }
            } else {
                { SchedProj S{8, 8, F.G, F.bid, (const char*)XB8, (const char*)WIN1, nullptr, (char*)PROJ, (size_t)256 * 3072 * 2, nullptr, 2048};
                  LAS float* rtab = (LAS float*)(F.scr + SCR_IDX); proj_fill_rstd<1>(S, PART2, rtab); EpiProj<1> E{3072, PART2, SSQV, 8, rtab, 1.f / WIN_S};
                  pg8::gemm_phase<EpiProj<1>, SchedProj, false, true>(F.lds, F.scr, 1024, 2048u, 2048u, (size_t)128 * 2048, S, E); }
            }
            TAIL_CONVERT(0);
        }
        SEAM(pb + 0);
        PHASE(pb + 1) { REPBAR();
            if (l == 0) {
                if (F.G < EARLY_PLAIN_MIN_G) {
                for (int it = gt; it < (T / 32) * 128; it += NGT) {
                    const int chunk = it & 127, rb = it >> 7, c0 = chunk * 8, g = c0 >> 8, w = 2 << g, t0 = rb * 32, tl0 = t0 & (SEQ - 1);
                    const bf16_t* pp = PROJ + (size_t)t0 * 2048 + c0; bf16_t* op = CONCAT + (size_t)t0 * 1536 + c0; float s[8];
#pragma unroll
                    for (int j = 0; j < 8; ++j) s[j] = 0.f;
                    for (int j = 1; j < w; ++j) if (tl0 - j >= 0) { const u32x4 v = *(const u32x4*)(pp - (size_t)j * 2048);
                        s[0] += bflo(v.x); s[1] += bfhi(v.x); s[2] += bflo(v.y); s[3] += bfhi(v.y); s[4] += bflo(v.z); s[5] += bfhi(v.z); s[6] += bflo(v.w); s[7] += bfhi(v.w); }
#pragma unroll 8
                    for (int r = 0; r < 32; ++r) { const int tl = tl0 + r; const u32x4 v = *(const u32x4*)(pp + (size_t)r * 2048); float p[8] = {bflo(v.x), bfhi(v.x), bflo(v.y), bfhi(v.y), bflo(v.z), bfhi(v.z), bflo(v.w), bfhi(v.w)};
                        const float inv = 1.0f / (float)(tl + 1 < w ? tl + 1 : w); float o[8];
#pragma unroll
                        for (int j = 0; j < 8; ++j) { s[j] += p[j]; o[j] = s[j] * inv - p[j]; }
                        u32x4 ow; ow.x = pk2(o[0], o[1]); ow.y = pk2(o[2], o[3]); ow.z = pk2(o[4], o[5]); ow.w = pk2(o[6], o[7]); *(u32x4*)(op + (size_t)r * 1536) = ow;
                        if (tl - (w - 1) >= 0) { const u32x4 q = *(const u32x4*)(pp + (size_t)(r - (w - 1)) * 2048);
                            s[0] -= bflo(q.x); s[1] -= bfhi(q.x); s[2] -= bflo(q.y); s[3] -= bfhi(q.y); s[4] -= bflo(q.z); s[5] -= bfhi(q.z); s[6] -= bflo(q.w); s[7] -= bfhi(q.w); } }
                }
                }
            } else {
                const bool sfirst = !(F.bid & 1);
                if (sfirst) {
                { SchedProj S{4, 0, F.G, F.bid, (const char*)XB8, nullptr, (const char*)(WINQ + (size_t)2 * 1024 * D), nullptr, 0, (char*)CONCAT};
                  LAS float* rtab = (LAS float*)(F.scr + SCR_IDX); proj_fill_rstd<1>(S, PART2, rtab); EpiScore<1> E{rtab};
                  pg8::gemm_phase<EpiScore<1>, SchedProj, false, true>(F.lds, F.scr, 1024, 2048u, 2048u, (size_t)128 * 2048, S, E); }
                  __syncthreads(); }
                pg8::SchedGrid S{T / 256, 4, F.G, F.bid, (const char*)W2, 0, (size_t)256 * 512, (const char*)POOLED, 0, (size_t)256 * 512, (char*)CONCAT + 1024, (size_t)256 * 3072, 256};
                SchedSp S2{S};
                LAS bf16_t* Ts = (LAS bf16_t*)F.lds; LAS float* rsv = (LAS float*)(F.lds + 128 * 264 * 2);
                Unit uu;
                for (int it = 0; S2.next(it >> 1, uu); ++it) { const int win = uu.pm, g = uu.pn, half = it & 1;
                    if (F.tid < 256) { const f32x4* pp = (const f32x4*)(SSQV + (size_t)(win * 256 + F.tid) * 16); const f32x4 a = pp[0], b = pp[1], c = pp[2], d = pp[3];
                        const float s = ((a[0] + a[1]) + (a[2] + a[3])) + ((b[0] + b[1]) + (b[2] + b[3])) + ((c[0] + c[1]) + (c[2] + c[3])) + ((d[0] + d[1]) + (d[2] + d[3]));
                        rsv[F.tid] = __builtin_amdgcn_rsqf(s * (1.0f / 1024.0f) + EPS); }
                    __syncthreads();
                    { const int r8 = F.tid >> 4, ch = F.tid & 15, cg = g * 256 + half * 128 + ch * 8; float ng[8];
#pragma unroll
                      for (int j = 0; j < 8; ++j) ng[j] = sgu_norm_g[cg + j];
#pragma unroll
                      for (int st = 0; st < 8; ++st) { const int s = st * 32 + r8; const u32x4 v = *(const u32x4*)(PROJ + (size_t)(win * 256 + s) * 3072 + 1024 + cg); const float rs = rsv[s];
                          const float p[8] = {bflo(v.x), bfhi(v.x), bflo(v.y), bfhi(v.y), bflo(v.z), bfhi(v.z), bflo(v.w), bfhi(v.w)};
#pragma unroll
                          for (int j = 0; j < 8; ++j) Ts[(ch * 8 + j) * 264 + s] = (bf16_t)f2bf(p[j] * rs * ng[j]); } }
                    __syncthreads();
                    { const int c = F.tid >> 5, sc = F.tid & 31; bf16_t* ob = POOLED + ((size_t)(win * 4 + g) * 256 + half * 128) * 256;
#pragma unroll
                      for (int st = 0; st < 8; ++st) { const int cc = st * 16 + c; *(u32x4*)(ob + (size_t)cc * 256 + sc * 8) = *(const LAS u32x4*)(Ts + cc * 264 + sc * 8); } }
                    __syncthreads();
                }
                __syncthreads();
                EpiSpatial E{PROJ, sgu_b_s};
                pg8::gemm_phase<EpiSpatial, SchedSp, false>(F.lds, F.scr, 256, 512u, 512u, (size_t)128 * 512, S2, E);
                if (!sfirst) {
                { SchedProj S{4, 0, F.G, F.bid, (const char*)XB8, nullptr, (const char*)(WINQ + (size_t)2 * 1024 * D), nullptr, 0, (char*)CONCAT};
                  LAS float* rtab = (LAS float*)(F.scr + SCR_IDX); proj_fill_rstd<1>(S, PART2, rtab); EpiScore<1> E{rtab};
                  pg8::gemm_phase<EpiScore<1>, SchedProj, false, true>(F.lds, F.scr, 1024, 2048u, 2048u, (size_t)128 * 2048, S, E); }
                }
            }
            if (!(l == 0 && F.G >= EARLY_PLAIN_MIN_G)) TAIL_CONVERT(1);
        }
        if (!(l == 0 && F.G >= EARLY_PLAIN_MIN_G)) SEAM(pb + 1);
        PHASE(pb + 3) { REPBAR();
            pg8::SchedGrid S{T / 256, 8, F.G, F.bid, (const char*)CONCAT + (l ? 1024 : 0), (size_t)256 * 3072, 0, (const char*)(BTO + (size_t)l * 2 * (2048 * 1536)) + (l ? 1024 : 0), (size_t)2048 * 3072, (size_t)256 * 3072, (char*)XB, (size_t)256 * 4096, 512};
            EpiOut E{P1, XB8, rep_ ? 0.f : 1.0f / F_S};
            if constexpr (l == 1) pg8::gemm_phase<EpiOut, pg8::SchedGrid, false, true>(F.lds, F.scr, 1024, 3072u, 3072u, (size_t)128 * 3072, S, E);
            else pg8::gemm_phase<EpiOut, pg8::SchedGrid, false, false, false, false, 16>(F.lds, F.scr, 1536, 3072u, 3072u, (size_t)128 * 3072, S, E);
            TAIL_CONVERT(2);
        }
        SEAM(pb + 3);
        PHASE(pb + 4) { REPBAR();
            pg8::SchedGrid S{T / 256, 2, F.G, F.bid, (const char*)XB, (size_t)256 * 4096, 2048, (const char*)(RT + (size_t)l * 256 * 2048), 0, 2048, (char*)LOGITS, 0, 0};
            EpiRoute E{LOGITS};
            pg8::gemm_phase<EpiRoute, pg8::SchedGrid, false>(F.lds, F.scr, 1024, 4096u, 4096u, (size_t)128 * 4096, S, E);
            TAIL_CONVERT(3);
        }
        SEAM(pb + 4);
        PHASE(pb + 5) { REPBAR();
            LAS int* hc = (LAS int*)(F.scr + SCR_TAB);
            for (int t0 = F.bid * 128; t0 < T; t0 += F.G * 128) {
                if (F.tid < 64) hc[F.tid] = 0;
                __syncthreads();
                const int t = t0 + F.tid;
                if (F.tid < 128) {
                    const f32x4* pp = (const f32x4*)(P1 + (size_t)t * 8); const f32x4 pa = pp[0], pb_ = pp[1]; const float s = ((pa[0] + pa[1]) + (pa[2] + pa[3])) + ((pb_[0] + pb_[1]) + (pb_[2] + pb_[3]));
                    const float rstd = __builtin_amdgcn_rsqf(s * (1.0f / D) + EPS); RS1[t] = rstd;
                    const float* la = LOGITS + (size_t)t * 64; const float* lb = la + (size_t)T * 64;
                    float gl[4]; int gi = 0;
#pragma unroll
                    for (int j = 0; j < 4; ++j) gl[j] = (la[j] + lb[j]) * rstd + moe_b_group[l * 4 + j];
#pragma unroll
                    for (int j = 1; j < 4; ++j) if (gl[j] > gl[gi]) gi = j;
                    float gs = 0.f;
#pragma unroll
                    for (int j = 0; j < 4; ++j) gs += __expf(gl[j] - gl[gi]);
                    const float pg = 1.0f / gs;
                    float el[8];
#pragma unroll
                    for (int j = 0; j < 8; ++j) el[j] = (la[4 + gi * 8 + j] + lb[4 + gi * 8 + j]) * rstd + moe_b_expert[l * 32 + gi * 8 + j];
                    int i0 = 0;
#pragma unroll
                    for (int j = 1; j < 8; ++j) if (el[j] > el[i0]) i0 = j;
                    int i1 = (i0 == 0) ? 1 : 0;
#pragma unroll
                    for (int j = 0; j < 8; ++j) if (j != i0 && el[j] > el[i1]) i1 = j;
                    const float x1 = __expf(el[i1] - el[i0]); const float tp0 = 1.0f / (1.0f + x1), tp1 = x1 / (1.0f + x1);
                    const int e0 = gi * 8 + i0, e1 = gi * 8 + i1;
                    const int r0 = __hip_atomic_fetch_add(&hc[e0], 1, __ATOMIC_RELAXED, __HIP_MEMORY_SCOPE_WORKGROUP), r1 = __hip_atomic_fetch_add(&hc[32 + e1], 1, __ATOMIC_RELAXED, __HIP_MEMORY_SCOPE_WORKGROUP);
                    u32x4 rec; rec.x = (unsigned)e0 | ((unsigned)e1 << 8) | ((unsigned)r0 << 16) | ((unsigned)r1 << 24); rec.y = __float_as_uint(pg * tp0); rec.z = __float_as_uint(pg * tp1); rec.w = 0u;
                    TOKREC[t] = rec;
                }
                __syncthreads();
                if (F.tid < 64) CNTM[(t0 >> 7) * 64 + F.tid] = hc[F.tid];
                __syncthreads();
            }
            TAIL_CONVERT(4);
        }
        SEAM(pb + 5);
        PHASE(pb + 6) { REPBAR();
            LAS int* ps = (LAS int*)(F.scr + SCR_IDX);
            LAS int* hb = (LAS int*)(F.scr + SCR_TAB);
            for (int t0 = F.bid * 128; t0 < T; t0 += F.G * 128) {
                const int blk = t0 >> 7, li = F.tid & 63, part = F.tid >> 6; int full = 0, upto = 0;
                for (int w = part * 32; w < part * 32 + 32; ++w) { const int c = CNTM[w * 64 + li]; full += c; upto += (w < blk) ? c : 0; }
                ps[part * 64 + li] = full; ps[512 + part * 64 + li] = upto;
                __syncthreads();
                if (F.tid < 64) { int base = 0, tot = 0;
#pragma unroll
                    for (int p = 0; p < 8; ++p) { tot += ps[p * 64 + F.tid]; base += ps[512 + p * 64 + F.tid]; }
                    hb[F.tid] = base; if (blk == 0) TOTALS[l * 64 + F.tid] = tot; }
                __syncthreads();
                if (F.tid < 128) { const int t = t0 + F.tid; const u32x4 rec = TOKREC[t]; const int e0 = rec.x & 255, e1 = (rec.x >> 8) & 255, r0 = (rec.x >> 16) & 255, r1 = rec.x >> 24;
                    const int p0 = hb[e0] + r0, p1 = hb[32 + e1] + r1;
                    LIST[(size_t)e0 * T + p0] = t; GATEW[(size_t)e0 * T + p0] = __uint_as_float(rec.y); LIST[(size_t)(32 + e1) * T + p1] = t; GATEW[(size_t)(32 + e1) * T + p1] = __uint_as_float(rec.z); }
                __syncthreads();
            }
            TAIL_CONVERT(5);
        }
        SEAM(pb + 6);
        { constexpr int ph = 0;
            if (!(l == 1 && ph == 2)) PHASE(pb + 7 + ph) { REPBAR();
                LAS int* cnt = (LAS int*)(F.scr + SCR_TAB); LAS int* pre = cnt + 64; LAS int* preB = cnt + 130; LAS int* preS = cnt + 196; LAS int* idx = (LAS int*)(F.scr + SCR_IDX);
                SchedMoe S; S.pre = pre; S.cnt = cnt; S.idx = idx; S.preB = preB; S.preS = preS; S.G = F.G; S.c = F.bid; S.ul = cnt + 264; S.nmy = 0; S.perm = 0;
                if (ph == 0) { S.lo = 0; S.hi = 64; S.mode = 0; S.perm = 1; S.A0 = (const char*)XB8; S.B0 = (const char*)(GUT + (size_t)l * 32 * D * D); S.C0 = (char*)HIDDEN; }
                else { S.lo = (ph == 1) ? 0 : 32; S.hi = (ph == 1 && l == 0) ? 32 : 64; S.mode = 1; S.perm = (ph == 1 && l == 1) ? 1 : 0; S.A0 = (const char*)HIDDEN; S.B0 = (const char*)(DOWNT + (size_t)l * 32 * DEXP * D); S.C0 = nullptr; }
                if (ph == 0) {
                    moe_setup<0>(S, TOTALS + l * 64, LIST, RS1);
                    EpiGu E{RS1, idx};
                    pg8::gemm_phase<EpiGu, SchedMoe, true, true, true>(F.lds, F.scr, 1024, 2048u, 2048u, (size_t)1024 * 2048, S, E);
                } else if (ph == 1) {
                    moe_setup<1>(S, TOTALS + l * 64, LIST, GATEW);
                    EpiDown<0> E{XB, YB0, YB1, idx, nullptr, 1.0f / (HID_S * DN_WS), 0.f, nullptr};
                    pg8::gemm_phase<EpiDown<0>, SchedMoe, false, true, true>(F.lds, F.scr, 512, 1024u, 1024u, (size_t)128 * 1024, S, E);
                } else {
                    moe_setup<1>(S, TOTALS + l * 64, LIST, GATEW);
                    EpiDown<1> E{XB, YB0, YB1, idx, PART2, rep_ ? 0.f : 1.0f / (HID_S * DN_WS), rep_ ? 0.f : 1.0f / Y_S, XB8};
                    pg8::gemm_phase<EpiDown<1>, SchedMoe, false, true, true>(F.lds, F.scr, 512, 1024u, 1024u, (size_t)128 * 1024, S, E);
                }
                __syncthreads();
                TAIL_CONVERT(6 + ph);
            }
            if (!(l == 1 && ph == 2)) SEAM(pb + 7 + ph);
        }
        { constexpr int ph = 1;
            if (!(l == 1 && ph == 2)) PHASE(pb + 7 + ph) { REPBAR();
                LAS int* cnt = (LAS int*)(F.scr + SCR_TAB); LAS int* pre = cnt + 64; LAS int* preB = cnt + 130; LAS int* preS = cnt + 196; LAS int* idx = (LAS int*)(F.scr + SCR_IDX);
                SchedMoe S; S.pre = pre; S.cnt = cnt; S.idx = idx; S.preB = preB; S.preS = preS; S.G = F.G; S.c = F.bid; S.ul = cnt + 264; S.nmy = 0; S.perm = 0;
                if (ph == 0) { S.lo = 0; S.hi = 64; S.mode = 0; S.perm = 1; S.A0 = (const char*)XB8; S.B0 = (const char*)(GUT + (size_t)l * 32 * D * D); S.C0 = (char*)HIDDEN; }
                else { S.lo = (ph == 1) ? 0 : 32; S.hi = (ph == 1 && l == 0) ? 32 : 64; S.mode = 1; S.perm = (ph == 1 && l == 1) ? 1 : 0; S.A0 = (const char*)HIDDEN; S.B0 = (const char*)(DOWNT + (size_t)l * 32 * DEXP * D); S.C0 = nullptr; }
                if (ph == 0) {
                    moe_setup<0>(S, TOTALS + l * 64, LIST, RS1);
                    EpiGu E{RS1, idx};
                    pg8::gemm_phase<EpiGu, SchedMoe, true, true, true>(F.lds, F.scr, 1024, 2048u, 2048u, (size_t)1024 * 2048, S, E);
                } else if (ph == 1) {
                    moe_setup<1>(S, TOTALS + l * 64, LIST, GATEW);
                    EpiDown<0> E{XB, YB0, YB1, idx, nullptr, 1.0f / (HID_S * DN_WS), 0.f, nullptr};
                    pg8::gemm_phase<EpiDown<0>, SchedMoe, false, true, true>(F.lds, F.scr, 512, 1024u, 1024u, (size_t)128 * 1024, S, E);
                } else {
                    moe_setup<1>(S, TOTALS + l * 64, LIST, GATEW);
                    EpiDown<1> E{XB, YB0, YB1, idx, PART2, rep_ ? 0.f : 1.0f / (HID_S * DN_WS), rep_ ? 0.f : 1.0f / Y_S, XB8};
                    pg8::gemm_phase<EpiDown<1>, SchedMoe, false, true, true>(F.lds, F.scr, 512, 1024u, 1024u, (size_t)128 * 1024, S, E);
                }
                __syncthreads();
                TAIL_CONVERT(6 + ph);
            }
            if (!(l == 1 && ph == 2)) SEAM(pb + 7 + ph);
        }
        { constexpr int ph = 2;
            if (!(l == 1 && ph == 2)) PHASE(pb + 7 + ph) { REPBAR();
                LAS int* cnt = (LAS int*)(F.scr + SCR_TAB); LAS int* pre = cnt + 64; LAS int* preB = cnt + 130; LAS int* preS = cnt + 196; LAS int* idx = (LAS int*)(F.scr + SCR_IDX);
                SchedMoe S; S.pre = pre; S.cnt = cnt; S.idx = idx; S.preB = preB; S.preS = preS; S.G = F.G; S.c = F.bid; S.ul = cnt + 264; S.nmy = 0; S.perm = 0;
                if (ph == 0) { S.lo = 0; S.hi = 64; S.mode = 0; S.perm = 1; S.A0 = (const char*)XB8; S.B0 = (const char*)(GUT + (size_t)l * 32 * D * D); S.C0 = (char*)HIDDEN; }
                else { S.lo = (ph == 1) ? 0 : 32; S.hi = (ph == 1 && l == 0) ? 32 : 64; S.mode = 1; S.perm = (ph == 1 && l == 1) ? 1 : 0; S.A0 = (const char*)HIDDEN; S.B0 = (const char*)(DOWNT + (size_t)l * 32 * DEXP * D); S.C0 = nullptr; }
                if (ph == 0) {
                    moe_setup<0>(S, TOTALS + l * 64, LIST, RS1);
                    EpiGu E{RS1, idx};
                    pg8::gemm_phase<EpiGu, SchedMoe, true, true, true>(F.lds, F.scr, 1024, 2048u, 2048u, (size_t)1024 * 2048, S, E);
                } else if (ph == 1) {
                    moe_setup<1>(S, TOTALS + l * 64, LIST, GATEW);
                    EpiDown<0> E{XB, YB0, YB1, idx, nullptr, 1.0f / (HID_S * DN_WS), 0.f, nullptr};
                    pg8::gemm_phase<EpiDown<0>, SchedMoe, false, true, true>(F.lds, F.scr, 512, 1024u, 1024u, (size_t)128 * 1024, S, E);
                } else {
                    moe_setup<1>(S, TOTALS + l * 64, LIST, GATEW);
                    EpiDown<1> E{XB, YB0, YB1, idx, PART2, rep_ ? 0.f : 1.0f / (HID_S * DN_WS), rep_ ? 0.f : 1.0f / Y_S, XB8};
                    pg8::gemm_phase<EpiDown<1>, SchedMoe, false, true, true>(F.lds, F.scr, 512, 1024u, 1024u, (size_t)128 * 1024, S, E);
                }
                __syncthreads();
                TAIL_CONVERT(6 + ph);
            }
            if (!(l == 1 && ph == 2)) SEAM(pb + 7 + ph);
        }
}
__global__ void __launch_bounds__(NWAVES * 64, 2) fwd(Args args) {
    extern __shared__ __attribute__((aligned(16))) unsigned char lds_raw[];
    Frame F; F.lds = (LAS unsigned char*)lds_raw; F.scr = F.lds + SCR_OFF;
    F.tid = threadIdx.x; F.lane = F.tid & 63; F.wave = rfl(F.tid >> 6); F.G = gridDim.x; F.bid = blockIdx.x;
    volatile LAS unsigned* MISC = (volatile LAS unsigned*)(F.lds + MISC_OFF);
    unsigned* ctl = (unsigned*)(args.ws + WS_CTL);
    if (F.tid < 32) MISC[F.tid] = 0u;
    __syncthreads();
    XcdBarrier bar; bar.bar = ctl + CW_BAR; bar.x = 0; bar.st = nullptr;
    if (!MK_PER_PHASE) bar = xcd_barrier_post(ctl + CW_BAR, MISC + 8);
    const int lo = args.ph_lo, hi = args.ph_hi;

    const int gw = F.bid * NWAVES + F.wave, NGW = F.G * NWAVES;
    const int gt = F.bid * (NWAVES * 64) + F.tid, NGT = F.G * NWAVES * 64;
    constexpr int I_SQ = (2048 / 64) * (2048 / 64), I_IN1 = (2048 / 64) * (3072 / 64), I_DN = (1024 / 64) * (2048 / 64);
    constexpr int NSMALL = I_SQ + I_IN1 + 2 * I_SQ + 2 * I_SQ;
    PHASE(0) { REPBAR();
        LAS unsigned* scr = (LAS unsigned*)(F.lds + F.wave * 16384);
        for (int m = gw; m < T; m += NGW) {
            const f32x4* xr = (const f32x4*)(x_in + (size_t)m * D) + F.lane * 2; unsigned* o = (unsigned*)(XB + (size_t)m * D) + F.lane * 4; float s = 0.f;
#pragma unroll
            for (int j = 0; j < 4; ++j) { const f32x4 a = xr[128 * j], b = xr[128 * j + 1]; u32x4 w; w.x = pk2(a[0], a[1]); w.y = pk2(a[2], a[3]); w.z = pk2(b[0], b[1]); w.w = pk2(b[2], b[3]);
                const float a0 = bflo(w.x), a1 = bfhi(w.x), a2 = bflo(w.y), a3 = bfhi(w.y), a4 = bflo(w.z), a5 = bfhi(w.z), a6 = bflo(w.w), a7 = bfhi(w.w);
                s += (a0 * a0 + a1 * a1) + (a2 * a2 + a3 * a3) + (a4 * a4 + a5 * a5) + (a6 * a6 + a7 * a7);
                u32x2 w8; w8.x = pk4_fp8(a0, a1, a2, a3); w8.y = pk4_fp8(a4, a5, a6, a7); *(u32x2*)(XB8 + (size_t)m * D + 512 * j + 8 * F.lane) = w8;
                *(u32x4*)(o + 256 * j) = w; }
            s = wave_sum(s); if (F.lane == 0) RSTD0[m] = __builtin_amdgcn_rsqf(s * (1.0f / D) + EPS);
        }
        if (gt < D / 2) ((unsigned*)(XB + (size_t)T * D))[gt] = 0u;
        if (gt < D / 4) ((unsigned*)(XB8 + (size_t)T * D))[gt] = 0u;
        if (gt == 0) { RSTD0[T] = 0.f; RSTD1[T] = 0.f; ((float*)((char*)RSTD1 + RSTD_STRIDE))[T] = 0.f; }
        for (int m = gw; m < 2 * 512; m += NGW) { const int l = m >> 9, r = m & 511;
            const f32x4* xr = (const f32x4*)(mem_in + (size_t)r * D) + F.lane * 2; const f32x4* gr = (const f32x4*)(norm_mem_g + (size_t)l * D) + F.lane * 2; f32x4 a[4], b[4]; float s = 0.f;
#pragma unroll
            for (int j = 0; j < 4; ++j) { a[j] = xr[128 * j]; b[j] = xr[128 * j + 1]; s += (a[j][0] * a[j][0] + a[j][1] * a[j][1]) + (a[j][2] * a[j][2] + a[j][3] * a[j][3]) + (b[j][0] * b[j][0] + b[j][1] * b[j][1]) + (b[j][2] * b[j][2] + b[j][3] * b[j][3]); }
            const float rstd = __builtin_amdgcn_rsqf(wave_sum(s) * (1.0f / D) + EPS); unsigned* o = (unsigned*)(MEMN + (size_t)m * D) + F.lane * 4;
#pragma unroll
            for (int j = 0; j < 4; ++j) { const f32x4 ga = gr[128 * j], gb = gr[128 * j + 1]; u32x4 w; w.x = pk2(a[j][0] * rstd * ga[0], a[j][1] * rstd * ga[1]); w.y = pk2(a[j][2] * rstd * ga[2], a[j][3] * rstd * ga[3]);
                w.z = pk2(b[j][0] * rstd * gb[0], b[j][1] * rstd * gb[1]); w.w = pk2(b[j][2] * rstd * gb[2], b[j][3] * rstd * gb[3]); *(u32x4*)(o + 256 * j) = w; }
        }
        for (int i = gt; i < 2 * 256 * 2048; i += NGT) { const int l = i >> 19, n = (i >> 11) & 255, k = i & 2047, j = n & 127; float w = 0.f;
            if (j < 4) w = moe_w_group[((size_t)l * D + k) * 4 + j]; else if (j < 36) w = moe_w_expert[((size_t)l * D + k) * 32 + (j - 4)];
            w *= norm_ffn_g[l * D + k]; const unsigned hi16 = f2bf(w); const float lof = w - __uint_as_float(hi16 << 16);
            RT[i] = (bf16_t)(n < 128 ? hi16 : f2bf(lof)); }
        for (int i = gt; i < 4 * 256 * 256; i += NGT) { const int g = i >> 16, t = (i >> 8) & 255, s = i & 255; float w = 0.f;
            if ((t >> 7) == (s >> 7) && (s & 127) <= (t & 127)) w = sgu_w_s[((size_t)g * 128 + (t & 127)) * 128 + (s & 127)];
            W2[i] = (bf16_t)f2bf(w); }
        for (int i = gt; i < 2 * 2048 * 256; i += NGT) { const int l = i >> 19, kk = (i >> 8) & 2047, c4 = (i & 255) * 4;
            const float* src = l ? sgu_w_in + (size_t)kk * 3072 + 2048 + c4 : pool_w_in + (size_t)kk * 2048 + 1024 + c4; const f32x4 w = *(const f32x4*)src; const float gs = norm_mix_g[l * D + kk] * 0.0625f;
            u32x2 o; o.x = pk2(w[0] * gs, w[1] * gs); o.y = pk2(w[2] * gs, w[3] * gs); *(u32x2*)(WQN + (size_t)l * D * D + (size_t)kk * D + c4) = o; }
        for (int i = gt; i < 4 * 256 * 256; i += NGT) { const int g = i >> 16, c = (i >> 8) & 255, d = i & 255; GRPW[(size_t)c * 2048 + g * 256 + d] = (bf16_t)f2bf(pool_w_grp[i] * pool_scale[g * 256 + d]); }
#define TR_DECODE(d, it_) do { int r = (it_); \
            if (r < I_SQ) { tr_desc(d, pool_w_in, 2048, 2048, WIN0, norm_mix_g, nullptr, 1.f, false, r); break; } r -= I_SQ; \
            if (r < I_IN1) { tr_desc(d, sgu_w_in, 2048, 3072, WIN1, norm_mix_g + D, nullptr, WIN_S, true, r); break; } r -= I_IN1; \
            if (r < 2 * I_SQ) { const int l_ = r / I_SQ; tr_desc(d, l_ ? sgu_w_out : pool_w_out, 2048, 2048, WOUT + (size_t)l_ * D * D, nullptr, nullptr, 1.f, false, r % I_SQ); break; } r -= 2 * I_SQ; \
            if (r < 2 * I_SQ) { const int l_ = r / I_SQ; tr_desc(d, xa_w_kv + (size_t)l_ * D * D, 2048, 2048, WKV + (size_t)l_ * D * D, nullptr, nullptr, 1.f, false, r % I_SQ); break; } r -= 2 * I_SQ; \
            if (r >= 32 * I_SQ) { r += TAIL_HG; if (r >= 64 * I_SQ + 32 * I_DN) r += TAIL_HD; }     \
            if (r < 64 * I_SQ) { const int le = r / I_SQ; tr_desc(d, moe_w_gu + (size_t)le * D * D, 2048, 2048, GUT + (size_t)le * D * D, norm_ffn_g + (le >> 5) * D, nullptr, GU_WS, true, r % I_SQ); break; } r -= 64 * I_SQ; \
            { const int le = r / I_DN; tr_desc(d, moe_w_down + (size_t)le * DEXP * D, 1024, 2048, DOWNT + (size_t)le * DEXP * D, nullptr, nullptr, DN_WS, true, r % I_DN); } } while (0)
#define TR_ID(j) ((j) < nj1 ? id1 + (j) * st1 : id2 + ((j) - nj1) * st2)
#define TR_RUN() do {   \
            TrDesc dA, dB; f32x4 vA[16], vB[16]; const int nj = nj1 + nj2; int j = 0; \
            if (nj > 0) { TR_DECODE(dA, TR_ID(0)); tr_load(dA, vA, F.lane); \
                for (;;) { \
                    const bool hasB = j + 1 < nj; if (hasB) { TR_DECODE(dB, TR_ID(j + 1)); tr_load(dB, vB, F.lane); } \
                    tr_finish(dA, vA, scr, F.lane); \
                    if (!hasB) break; \
                    const bool hasA = j + 2 < nj; if (hasA) { TR_DECODE(dA, TR_ID(j + 2)); tr_load(dA, vA, F.lane); } \
                    tr_finish(dB, vB, scr, F.lane); \
                    if (!hasA) break; \
                    j += 2; \
                } } } while (0)
        {
            const int id1 = gw, st1 = NGW, nj1 = (NSMALL - gw + NGW - 1) / NGW > 0 ? (NSMALL - gw + NGW - 1) / NGW : 0, id2 = 0, st2 = 1, nj2 = 0;
            TR_RUN();
        }
    }
    SEAM(0);
    PHASE(1) { REPBAR();
        {
            SchedKV S{F.G, F.bid, (const char*)MEMN, (const char*)WKV, (char*)KVN};
            EpiPlain E{0, 1.f};
            pg8::gemm_phase<EpiPlain, SchedKV, false>(F.lds, F.scr, 2048, 4096u, 4096u, (size_t)128 * 4096, S, E);
        }
        if (F.G >= EARLY_PLAIN_MIN_G && F.bid >= 32 && F.bid < 160) {
            SchedProj S{4, 4, 128, F.bid - 32, (const char*)XB, (const char*)WIN0, nullptr, (char*)PROJ, (size_t)256 * 2048 * 2, nullptr, 4096};
            LAS float* rtab = (LAS float*)(F.scr + SCR_IDX); proj_fill_rstd<0>(S, RSTD0, rtab); EpiProj<0> E{2048, RSTD0, nullptr, 4, rtab, 1.f};
            pg8::gemm_phase<EpiProj<0>, SchedProj, false>(F.lds, F.scr, 2048, 4096u, 4096u, (size_t)128 * 4096, S, E);
        }
        if (F.G >= EARLY_PLAIN_MIN_G && F.G > 160 && F.bid >= 160) {
        for (int i = (F.bid - 160) * (NWAVES * 64) + F.tid; i < 2 * 2048 * 128; i += (F.G - 160) * (NWAVES * 64)) { const int b = i >> 18, n = (i >> 7) & 2047, c = i & 127;
            const u32x4 w = *(const u32x4*)(WOUT + (size_t)D * D + (size_t)n * D + c * 8); u32x4 o;
            u32x2 o8; o8.x = pk4_fp8(bflo(w.x) * WO_S, bfhi(w.x) * WO_S, bflo(w.y) * WO_S, bfhi(w.y) * WO_S); o8.y = pk4_fp8(bflo(w.z) * WO_S, bfhi(w.z) * WO_S, bflo(w.w) * WO_S, bfhi(w.w) * WO_S);
            *(u32x2*)((unsigned char*)(BTO + (size_t)(2 + b) * (2048 * 1536) + (size_t)n * 1536) + 1024 + c * 8) = o8; }
        { SchedFold S{F.G - 160, F.bid - 160, (const char*)WOUT, (const char*)KVN, (const char*)GRPW, (char*)BTO, (const char*)WQN, (char*)WINQ, 0};
          EpiPlain E{0, F_S};
          pg8::gemm_phase<EpiPlain, SchedFold, false>(F.lds, F.scr, 256, 4096u, 4096u, (size_t)128 * 4096, S, E); }
        }
        {
            LAS unsigned* scr = (LAS unsigned*)(F.lds + F.wave * 16384);
            constexpr int NMOE = 64 * I_SQ + 64 * I_DN - TAIL_ITEMS; static_assert(NMOE % 16 == 0 && TAIL_PER0 % 16 == 0, "tickets of 16 items");
            const int NTK = (NMOE + (F.G >= EARLY_PLAIN_MIN_G ? TAIL_PER0 : 0)) / 16;
#define CONV_DESC(d_, it_) do { const int ci_ = (it_); if (ci_ < NMOE) TR_DECODE(d_, NSMALL + ci_); else TAIL_DESC(d_, TAIL_PER0 + ci_ - NMOE); } while (0)
            unsigned* q = ctl + CW_CONVQ; volatile LAS unsigned* tk = MISC + 16; TrDesc dA, dB; f32x4 vA[16], vB[16];
            __syncthreads(); if (F.tid == 0) tk[0] = xb_add(q, 1u); __syncthreads();
            unsigned b = tk[0]; int par = 1;
            while (b < (unsigned)NTK) { unsigned nt = 0u; if (F.tid == 0) nt = xb_add(q, 1u);
                const int iA = (int)b * 16 + F.wave;
                CONV_DESC(dA, iA); tr_load(dA, vA, F.lane); CONV_DESC(dB, iA + 8); tr_load(dB, vB, F.lane);
                tr_finish(dA, vA, scr, F.lane); tr_finish(dB, vB, scr, F.lane);
                if (F.tid == 0) tk[par] = nt; __syncthreads(); b = tk[par]; par ^= 1; }
        }
#undef CONV_DESC
#undef TR_RUN
#undef TR_ID

#undef TR_DECODE
    }
    SEAM(1);
    PHASE(2) { REPBAR();
        if (F.G < EARLY_PLAIN_MIN_G) {
        for (int i = gt; i < 2 * 2048 * 128; i += NGT) { const int b = i >> 18, n = (i >> 7) & 2047, c = i & 127;
            const u32x4 w = *(const u32x4*)(WOUT + (size_t)D * D + (size_t)n * D + c * 8); u32x4 o;
            u32x2 o8; o8.x = pk4_fp8(bflo(w.x) * WO_S, bfhi(w.x) * WO_S, bflo(w.y) * WO_S, bfhi(w.y) * WO_S); o8.y = pk4_fp8(bflo(w.z) * WO_S, bfhi(w.z) * WO_S, bflo(w.w) * WO_S, bfhi(w.w) * WO_S);
            *(u32x2*)((unsigned char*)(BTO + (size_t)(2 + b) * (2048 * 1536) + (size_t)n * 1536) + 1024 + c * 8) = o8; }
        { SchedFold S{F.G, F.bid, (const char*)WOUT, (const char*)KVN, (const char*)GRPW, (char*)BTO, (const char*)WQN, (char*)WINQ, 0};
          EpiPlain E{0, F_S};
          pg8::gemm_phase<EpiPlain, SchedFold, false>(F.lds, F.scr, 256, 4096u, 4096u, (size_t)128 * 4096, S, E); }
        }
        { SchedFold S{F.G, F.bid, (const char*)WOUT, (const char*)KVN, (const char*)GRPW, (char*)BTO, (const char*)WQN, (char*)WINQ, 1};
          EpiFp8 E{VW_S, 3072, WQ_S, 2048};
          pg8::gemm_phase<EpiFp8, SchedFold, false>(F.lds, F.scr, 256, 4096u, 4096u, (size_t)128 * 4096, S, E); }
    }
    SEAM(2);

    layer_phases<0>(args, F, bar, ctl, lo, hi, gw, NGW, gt, NGT);
    layer_phases<1>(args, F, bar, ctl, lo, hi, gw, NGW, gt, NGT);
    PHASE(23) { REPBAR();
        f32x4 gv[4][2];
#pragma unroll
        for (int j = 0; j < 4; ++j) { gv[j][0] = ((const f32x4*)final_norm_g)[F.lane * 2 + 128 * j]; gv[j][1] = ((const f32x4*)final_norm_g)[F.lane * 2 + 128 * j + 1]; }
        for (int m0 = gw; m0 < T; m0 += 2 * NGW) {
            u32x4 xw[2][4]; u32x2 ya[2][4], yb[2][4]; const int m1 = m0 + NGW; const bool has1 = m1 < T;
#pragma unroll
            for (int rr = 0; rr < 2; ++rr) { const int m = (rr == 0 || has1) ? (rr ? m1 : m0) : m0;
                const u32x4* xr = (const u32x4*)(XB + (size_t)m * D) + F.lane; const u32x2* y0r = (const u32x2*)(YB0 + (size_t)m * D) + F.lane; const u32x2* y1r = (const u32x2*)(YB1 + (size_t)m * D) + F.lane;
#pragma unroll
                for (int j = 0; j < 4; ++j) { xw[rr][j] = xr[64 * j]; ya[rr][j] = y0r[64 * j]; yb[rr][j] = y1r[64 * j]; } }
#pragma unroll
            for (int rr = 0; rr < 2; ++rr) { if (rr == 1 && !has1) break; const int m = rr ? m1 : m0;
                float xv[4][8]; float s = 0.f;
#pragma unroll
                for (int j = 0; j < 4; ++j) { const u32x4 v = xw[rr][j]; float fa[8], fb[8]; fp8x8_to_f32(ya[rr][j], fa); fp8x8_to_f32(yb[rr][j], fb);
                    const float xx[8] = {bflo(v.x), bfhi(v.x), bflo(v.y), bfhi(v.y), bflo(v.z), bfhi(v.z), bflo(v.w), bfhi(v.w)};
#pragma unroll
                    for (int e = 0; e < 8; ++e) { xv[j][e] = xx[e] + (fa[e] + fb[e]) * (1.0f / Y_S); s += xv[j][e] * xv[j][e]; } }
                const float rstd = __builtin_amdgcn_rsqf(wave_sum(s) * (1.0f / D) + EPS);
                f32x4* o = (f32x4*)(args.out + (size_t)m * D) + F.lane * 2;
#pragma unroll
                for (int j = 0; j < 4; ++j) { const f32x4 ga = gv[j][0], gb = gv[j][1];
                    o[128 * j] = (f32x4){xv[j][0] * rstd * ga[0], xv[j][1] * rstd * ga[1], xv[j][2] * rstd * ga[2], xv[j][3] * rstd * ga[3]};
                    o[128 * j + 1] = (f32x4){xv[j][4] * rstd * gb[0], xv[j][5] * rstd * gb[1], xv[j][6] * rstd * gb[2], xv[j][7] * rstd * gb[3]}; } }
        }
    }
#undef IN
#undef SEAM
}

extern "C" void kernel_launch(void* const* d_in, const int* in_sizes, int n_in, void* d_out, int out_size, void* d_ws, size_t ws_size, hipStream_t stream) {
    static int grid = 0;
    if (grid == 0) {
        if (n_in != 22 || out_size != T * D || ws_size < WS_END) { fprintf(stderr, "kernel_launch: unexpected shapes (n_in %d, out %d, ws %zu)\n", n_in, out_size, ws_size); grid = -1; return; }
        int dev = 0, cus = 0, per_cu = 0;
        if (hipGetDevice(&dev) != hipSuccess || hipDeviceGetAttribute(&cus, hipDeviceAttributeMultiprocessorCount, dev) != hipSuccess) { grid = -1; return; }
        if (hipFuncSetAttribute((const void*)fwd, hipFuncAttributeMaxDynamicSharedMemorySize, LDS_BYTES) != hipSuccess) { fprintf(stderr, "kernel_launch: hipFuncSetAttribute failed\n"); grid = -1; return; }
        if (hipOccupancyMaxActiveBlocksPerMultiprocessor(&per_cu, (const void*)fwd, NWAVES * 64, LDS_BYTES) != hipSuccess || per_cu < 1) { fprintf(stderr, "kernel_launch: occupancy query says %d\n", per_cu); }
        (void)hipGetLastError();
        grid = cus;
    }
    if (grid < 0) return;
    (void)hipMemsetAsync((char*)d_ws + WS_CTL, 0, CTL_ZERO_BYTES, stream);
    Args a{};
    for (int i = 0; i < 22; ++i) a.in[i] = (const float*)d_in[i];
    a.out = (float*)d_out; a.ws = (unsigned char*)d_ws;
#if MK_PER_PHASE
    for (int p = 0; p < NPHASE; ++p) { a.ph_lo = p; a.ph_hi = p + 1; hipLaunchKernelGGL(fwd, dim3(grid), dim3(NWAVES * 64), LDS_BYTES, stream, a); }
#else
    a.ph_lo = 0; a.ph_hi = NPHASE; hipLaunchKernelGGL(fwd, dim3(grid), dim3(NWAVES * 64), LDS_BYTES, stream, a);
#endif
}
```

```cpp
#include <hip/hip_runtime.h>
#include <cstdio>
#include <cstdint>

#ifndef MK_PER_PHASE
#define MK_PER_PHASE 0
#endif

#define GAS __attribute__((address_space(1)))
#define LAS __attribute__((address_space(3)))
typedef unsigned short bf16_t;
typedef short bf16x8 __attribute__((ext_vector_type(8)));
typedef float f32x4 __attribute__((ext_vector_type(4)));
typedef float f32x2 __attribute__((ext_vector_type(2)));
typedef unsigned u32x4 __attribute__((ext_vector_type(4)));
typedef unsigned u32x2 __attribute__((ext_vector_type(2)));
typedef int i32x4 __attribute__((ext_vector_type(4)));
typedef int i32x8 __attribute__((ext_vector_type(8)));

constexpr int T = 32768, SEQ = 16384, D = 2048, NMEM = 256, NEXP = 32, DEXP = 1024;
constexpr float EPS = 1e-6f;
constexpr int NWAVES = 8;
constexpr int NPHASE = 24;
constexpr float GU_WS = 64.f, DN_WS = 32.f, HID_S = 8.f, Y_S = 16.f, WQ_S = 64.f, WIN_S = 64.f, MX_S = 8.f, WO_S = 128.f, P_S = 256.f, VW_S = 4.f, F_S = P_S * VW_S;

constexpr size_t MiB = 1u << 20;
constexpr size_t WS_CTL = 0, CTL_ZERO_BYTES = 1 * MiB;
constexpr size_t WS_RSTD = 1 * MiB;
constexpr size_t RSTD_STRIDE = 320 * 1024;
constexpr size_t WS_PART1 = 2 * MiB;
constexpr size_t WS_PART2 = 10 * MiB;
constexpr size_t WS_SSQV = 14 * MiB;
constexpr size_t WS_LOGITS = 16 * MiB;
constexpr size_t WS_LIST = 32 * MiB;
constexpr size_t WS_GATEW = 40 * MiB;
constexpr size_t WS_KMAT = 48 * MiB;
constexpr size_t WS_VT = 50 * MiB;
constexpr size_t WS_MEMN = 52 * MiB;
constexpr size_t WS_WIN0 = 56 * MiB;
constexpr size_t WS_WIN1 = 64 * MiB;
constexpr size_t WS_WOUT = 76 * MiB;
constexpr size_t WS_WKV = 92 * MiB;
constexpr size_t WS_GRP = 108 * MiB;
constexpr size_t WS_W2 = 109 * MiB;
constexpr size_t WS_CNT = 108 * MiB + 512 * 1024;
constexpr size_t WS_TOKREC = 109 * MiB + 512 * 1024;
constexpr size_t WS_RT = 110 * MiB;
constexpr size_t WS_GUT = 112 * MiB;
constexpr size_t WS_DOWNT = 624 * MiB;
constexpr size_t WS_XB = 880 * MiB;
constexpr size_t WS_PROJ = 1010 * MiB;
constexpr size_t WS_POOLED = 1202 * MiB;
constexpr size_t WS_PBUF = 1266 * MiB;
constexpr size_t WS_CONCAT = 1330 * MiB;
constexpr size_t WS_HIDDEN = 1458 * MiB;
constexpr size_t WS_XB8 = 1618 * MiB;
constexpr size_t WS_BTO = 1684 * MiB;
constexpr size_t WS_GRPW = 1716 * MiB;
constexpr size_t WS_WQN = 1718 * MiB;
constexpr size_t WS_WINQ = 1734 * MiB;
constexpr size_t WS_END = 1750 * MiB;
constexpr int CW_BAR = 4096;
constexpr int CW_CONVQ = 2048;
constexpr int EARLY_PLAIN_MIN_G = 160;
constexpr int CW_CURSOR = 16384;

constexpr int RING_BYTES = 131072;
constexpr int SCR_OFF = RING_BYTES;
constexpr int SCR_IDX = 8192, SCR_TAB = 20480, SCR_BYTES = 22528;
constexpr int MISC_OFF = SCR_OFF + SCR_BYTES;
constexpr int LDS_BYTES = MISC_OFF + 128;
constexpr int MAX_MOE_UNITS = 12;

#define RLX_AGENT __ATOMIC_RELAXED, __HIP_MEMORY_SCOPE_AGENT
#define LDS_WAIT() asm volatile("s_waitcnt lgkmcnt(0)" ::: "memory")
#define VM_WAIT() asm volatile("s_waitcnt vmcnt(0)" ::: "memory")
__device__ __forceinline__ int rfl(int v) { return __builtin_amdgcn_readfirstlane(v); }
__device__ __forceinline__ unsigned f2bf(float f) { unsigned u = __builtin_bit_cast(unsigned, f); return (u + 0x7fffu + ((u >> 16) & 1u)) >> 16; }
__device__ __forceinline__ unsigned pk2(float lo, float hi) { return f2bf(lo) | (f2bf(hi) << 16); }
__device__ __forceinline__ unsigned cvt_pk_bf16(float lo, float hi) { unsigned r; asm volatile("v_cvt_pk_bf16_f32 %0, %1, %2" : "=v"(r) : "v"(lo), "v"(hi)); return r; }
__device__ __forceinline__ unsigned pk4_fp8(float a, float b, float c, float d) {
    a = __builtin_amdgcn_fmed3f(a, -448.f, 448.f); b = __builtin_amdgcn_fmed3f(b, -448.f, 448.f); c = __builtin_amdgcn_fmed3f(c, -448.f, 448.f); d = __builtin_amdgcn_fmed3f(d, -448.f, 448.f);
    int w = 0; w = __builtin_amdgcn_cvt_pk_fp8_f32(a, b, w, false); w = __builtin_amdgcn_cvt_pk_fp8_f32(c, d, w, true); return (unsigned)w; }
typedef float f32x2v __attribute__((ext_vector_type(2)));
__device__ __forceinline__ void fp8x8_to_f32(const u32x2 w, float (&o)[8]) { const f32x2v a = __builtin_amdgcn_cvt_pk_f32_fp8((int)w.x, false), b = __builtin_amdgcn_cvt_pk_f32_fp8((int)w.x, true), c = __builtin_amdgcn_cvt_pk_f32_fp8((int)w.y, false), d = __builtin_amdgcn_cvt_pk_f32_fp8((int)w.y, true);
    o[0] = a.x; o[1] = a.y; o[2] = b.x; o[3] = b.y; o[4] = c.x; o[5] = c.y; o[6] = d.x; o[7] = d.y; }
__device__ __forceinline__ float bflo(unsigned w) { return __uint_as_float(w << 16); }
__device__ __forceinline__ float bfhi(unsigned w) { return __uint_as_float(w & 0xffff0000u); }
__device__ __forceinline__ float wave_sum(float v) {
#pragma unroll
    for (int o = 1; o < 64; o <<= 1) v += __shfl_xor(v, o);
    return v;
}
__device__ __forceinline__ float gelu_tanh(float x) {
    const float e = __builtin_amdgcn_exp2f(x * (-2.302208198f - 0.1029432396f * x * x));
    return x * __builtin_amdgcn_rcpf(1.0f + e);
}
__device__ __forceinline__ float silu_f(float x) { return x * __builtin_amdgcn_rcpf(1.0f + __builtin_amdgcn_exp2f(-1.442695041f * x)); }

#define XB_TMO      128
#define XB_XCNT(j)  (256  + 64 * (j))
#define XB_XSUB(j)  (1280 + 64 * (j))
#define XB_XGEN(j)  (2304 + 64 * (j))
#define XB_TOP      3328
#define XB_TOPGEN   3392
#define XCD_BAR_WORDS 3456
#define XB_SPIN_CAP (1u << 20)

__device__ __forceinline__ unsigned xb_ld(unsigned* p)              { return __hip_atomic_load(p, __ATOMIC_RELAXED, __HIP_MEMORY_SCOPE_AGENT); }
__device__ __forceinline__ unsigned xb_add(unsigned* p, unsigned v) { return __hip_atomic_fetch_add(p, v, __ATOMIC_RELAXED, __HIP_MEMORY_SCOPE_AGENT); }
__device__ __forceinline__ unsigned xb_xcc_id() { return (unsigned)__builtin_amdgcn_s_getreg((3 << 11) | 20) & 0xFu; }
#define XB_SPIN(cond, bar) do { unsigned _sp = 0; while (cond) { __builtin_amdgcn_s_sleep(1); \
    if ((++_sp & 255u) == 0u) { if (xb_ld(&(bar)[XB_TMO])) break; if (_sp > XB_SPIN_CAP) { atomicAdd(&(bar)[XB_TMO], 1u); break; } } } } while (0)

struct XcdBarrier { unsigned* bar; unsigned x; volatile LAS unsigned* st; };
__device__ __forceinline__ XcdBarrier xcd_barrier_post(unsigned* bar, volatile LAS unsigned* st) {
    XcdBarrier b; b.bar = bar; b.x = xb_xcc_id(); b.st = st;
    if (threadIdx.x == 0) (void)xb_add(&bar[XB_XCNT(b.x)], 1u);
    return b;
}
__device__ __forceinline__ void xcd_barrier_complete(unsigned* bar, unsigned x, unsigned& nloc, unsigned& nx) {
    const unsigned G = gridDim.x * gridDim.y * gridDim.z;
    unsigned sum, cnt, mine, sp = 0u;
    for (;;) {
        sum = 0u; cnt = 0u; mine = 0u;
#pragma unroll
        for (unsigned j = 0; j < 16; ++j) { const unsigned c = xb_ld(&bar[XB_XCNT(j)]); sum += c; cnt += (c > 0u) ? 1u : 0u; mine = (j == x) ? c : mine; }
        if (sum == G) break;
        __builtin_amdgcn_s_sleep(1);
        if ((++sp & 255u) == 0u) { if (xb_ld(&bar[XB_TMO])) break; if (sp > XB_SPIN_CAP) { atomicAdd(&bar[XB_TMO], 1u); break; } }
    }
    nloc = mine > 0u ? mine : 1u; nx = cnt > 0u ? cnt : 1u;
}
__device__ __forceinline__ void xcd_barrier(const XcdBarrier& b) {
    asm volatile("s_waitcnt vmcnt(0)" ::: "memory");
    __syncthreads();
    if (threadIdx.x == 0) {
        unsigned* bar = b.bar;
        __builtin_amdgcn_s_waitcnt(0);
        unsigned nloc = b.st[0], nx = b.st[1];
        if (nloc == 0u) { xcd_barrier_complete(bar, b.x, nloc, nx); b.st[0] = nloc; b.st[1] = nx; }
        const unsigned old = xb_add(&bar[XB_XSUB(b.x)], 1u);
        const unsigned gen = old / nloc;
        if (old + 1u == (gen + 1u) * nloc) {
            __builtin_amdgcn_fence(__ATOMIC_RELEASE, "agent");
            asm volatile("s_waitcnt vmcnt(0)" ::: "memory");
            const unsigned og = xb_add(&bar[XB_TOP], 1u);
            const unsigned tg = og / nx;
            if (og + 1u == (tg + 1u) * nx) xb_add(&bar[XB_TOPGEN], 1u);
            else XB_SPIN(xb_ld(&bar[XB_TOPGEN]) == tg, bar);
            __builtin_amdgcn_fence(__ATOMIC_ACQUIRE, "agent");
            xb_add(&bar[XB_XGEN(b.x)], 1u);
            asm volatile("s_waitcnt vmcnt(0)" ::: "memory");
        } else {
            XB_SPIN(xb_ld(&bar[XB_XGEN(b.x)]) == gen, bar);
            __builtin_amdgcn_fence(__ATOMIC_ACQUIRE, "agent");
            asm volatile("s_waitcnt vmcnt(0)" ::: "memory");
        }
    }
    __syncthreads();
}

namespace pg8 {
constexpr int BM = 256, BK = 64, HALF = 128, HTB = HALF * BK * 2, NXCD = 8, WGM = 4;
__device__ __forceinline__ int lds_byte(int r, int c) { const int st = (r >> 4) * 2 + (c >> 5), rr = r & 15, cc = c & 31, ob = rr * 64 + cc * 2; return st * 1024 + (ob ^ (((ob >> 9) & 1) << 5)); }
__device__ __forceinline__ void stage_rc(int b, int& R, int& C) { const int st = b / 1024, sb = b % 1024, swz = sb ^ (((sb >> 9) & 1) << 5); R = (st >> 1) * 16 + swz / 64; C = (st & 1) * 32 + (swz % 64) / 2; }
__device__ __forceinline__ int perm32(int rho) { const int n = rho >> 4, i = rho & 15; return 8 * (i >> 2) + 4 * n + (i & 3); }

struct Unit { const char* A; const char* B; char* C; int pm, pn, aux, nvalid; };

__device__ __forceinline__ bool grid_order(int i, int G, int c, int nM, int nN, int& pm, int& pn) {
    const int nwg = nM * nN; const long L = (long)i * G + c; if (L >= nwg) return false;
    int wgid = (int)L; { const int q = nwg / NXCD, r = nwg % NXCD, xcd = wgid % NXCD, off = wgid / NXCD; wgid = (xcd < r ? xcd * (q + 1) : r * (q + 1) + (xcd - r) * q) + off; }
    const int nig = WGM * nN, gid = wgid / nig, fm = gid * WGM, gsz = (nM - fm) < WGM ? (nM - fm) : WGM;
    pm = fm + ((wgid % nig) % gsz); pn = (wgid % nig) / gsz; return true;
}
struct SchedGrid {
    int nM, nN, G, c; const char* A0; size_t a_pm, a_pn; const char* B0; size_t b_bt, b_pn; char* C0; size_t c_pm, c_pn;
    __device__ __forceinline__ bool next(int i, Unit& u) const {
        int pm, pn; if (!grid_order(i, G, c, nM, nN, pm, pn)) return false;
        u.pm = pm; u.pn = pn; u.aux = 0; u.nvalid = 256;
        u.A = A0 + (size_t)pm * a_pm + (size_t)pn * a_pn; u.B = B0 + (size_t)(pm >> 6) * b_bt + (size_t)pn * b_pn; u.C = C0 + (size_t)pm * c_pm + (size_t)pn * c_pn; return true;
    }
    __device__ __forceinline__ int row(int, int) const { return 0; }
};

template <bool F8> struct FragSel { struct A { i32x4 v[4][2]; }; struct B { i32x4 v[2][2]; }; };
template <> struct FragSel<true> { struct A { i32x8 v[4]; }; struct B { i32x8 v[2]; }; };
template <class Epi, class Sched, bool GATHER, bool FP8 = false, bool HALFSKIP = false, bool EPI2 = false, int MIXSW = 0>
__device__ __forceinline__ void gemm_phase(LAS unsigned char* lds, LAS unsigned char* scr, const int K, const unsigned lda2, const unsigned ldb2, const size_t hstepB, const Sched& S, const Epi& E) {
    const int tid = threadIdx.x, wid = __builtin_amdgcn_readfirstlane(tid >> 6), lane = tid & 63, wr = wid >> 2, wc = wid & 3, fr = lane & 15, fq = lane >> 4;
    const int nt = K / BK;
    unsigned voffB[2], vAc[2][2], vAn[2][2]; int Rr[2], Cc[2];
#pragma unroll
    for (int i = 0; i < 2; ++i) { int R, C; stage_rc(tid * 16 + i * 8192, R, C); const int Rb = (R & ~31) + perm32(R & 31); Rr[i] = R; Cc[i] = C;
        voffB[i] = (unsigned)Rb * ldb2 + (unsigned)C * 2u; vAc[0][i] = (unsigned)R * lda2 + (unsigned)C * 2u; vAc[1][i] = vAc[0][i]; vAn[0][i] = vAc[0][i]; vAn[1][i] = vAc[0][i]; }
    const size_t kstep = (size_t)(BK * 2);
    const size_t hstepA = GATHER ? (size_t)0 : (size_t)HALF * lda2;
    const unsigned ldsw = (unsigned)wid * 1024u;
    const int aoff = lds_byte(wr * 64 + fr, fq * 8), boff = lds_byte(wc * 32 + fr, fq * 8);
#define PG8_SA(b, h) (((b) * 2 + (h)) * HTB)
#define PG8_SB(b, h) ((4 + (b) * 2 + (h)) * HTB)
#define PG8_STG(bufoff, gptr, v0, v1) do { \
        __builtin_amdgcn_global_load_lds((const unsigned*)((const char*)(gptr) + (v0)), (LAS unsigned*)(lds + (bufoff) + ldsw), 16, 0, 0); \
        __builtin_amdgcn_global_load_lds((const unsigned*)((const char*)(gptr) + (v1)), (LAS unsigned*)(lds + (bufoff) + ldsw + 8192), 16, 0, 0); } while (0)
#define PG8_STG_B(b, h, bp) PG8_STG(PG8_SB(b, h), (bp) + (h) * hstepB, voffB[0], voffB[1])
#define PG8_STG_A(b, h, ap, nx) do { if constexpr (GATHER) { const unsigned _o0 = (nx) ? vAn[h][0] : vAc[h][0], _o1 = (nx) ? vAn[h][1] : vAc[h][1]; PG8_STG(PG8_SA(b, h), (ap), _o0, _o1); } \
        else { PG8_STG(PG8_SA(b, h), (ap) + (h) * hstepA, vAc[0][0], vAc[0][1]); } } while (0)
#define PG8_LDA(KIND, b, h) do { _Pragma("unroll") for (int m = 0; m < 4; ++m) { const i32x4 _l0 = *(const LAS i32x4*)(lds + PG8_SA(b, h) + aoff + m * 2048), _l1 = *(const LAS i32x4*)(lds + PG8_SA(b, h) + aoff + m * 2048 + 1024); \
        if constexpr (KIND) AtQ.v[m] = __builtin_shufflevector(_l0, _l1, 0, 1, 2, 3, 4, 5, 6, 7); else { AtH.v[m][0] = _l0; AtH.v[m][1] = _l1; } } } while (0)
#define PG8_LDB(KIND, W, b, h) do { _Pragma("unroll") for (int n = 0; n < 2; ++n) { const i32x4 _l0 = *(const LAS i32x4*)(lds + PG8_SB(b, h) + boff + n * 2048), _l1 = *(const LAS i32x4*)(lds + PG8_SB(b, h) + boff + n * 2048 + 1024); \
        if constexpr (KIND) B##W##Q.v[n] = __builtin_shufflevector(_l0, _l1, 0, 1, 2, 3, 4, 5, 6, 7); else { B##W##H.v[n][0] = _l0; B##W##H.v[n][1] = _l1; } } } while (0)
#define PG8_MMA(KIND, ai, bj, W) do { __builtin_amdgcn_s_setprio(1); _Pragma("unroll") for (int m = 0; m < 4; ++m) _Pragma("unroll") for (int n = 0; n < 2; ++n) { \
        if constexpr (KIND) asm volatile("v_mfma_scale_f32_16x16x128_f8f6f4 %0, %1, %2, %0, %3, %3 op_sel_hi:[0,0,0]" : "+v"(acc[ai][bj][m][n]) : "v"(B##W##Q.v[n]), "v"(AtQ.v[m]), "v"(scl1)); \
        else { _Pragma("unroll") for (int k = 0; k < 2; ++k) acc[ai][bj][m][n] = __builtin_amdgcn_mfma_f32_16x16x32_bf16(__builtin_bit_cast(bf16x8, B##W##H.v[n][k]), __builtin_bit_cast(bf16x8, AtH.v[m][k]), acc[ai][bj][m][n], 0, 0, 0); } } \
        __builtin_amdgcn_s_setprio(0); } while (0)
#define PG8_WAIT_V(n) asm volatile("s_waitcnt vmcnt(" #n ")" ::: "memory")
#define PG8_WAIT_L(n) asm volatile("s_waitcnt lgkmcnt(" #n ")" ::: "memory")
#define PG8_BAR __builtin_amdgcn_s_barrier()
#define PG8_SCHED __builtin_amdgcn_sched_barrier(0)
    Unit cur, nxt; int ui = 0;
    if (!S.next(0, cur)) return;
    int scl1 = 0x7f7f7f7f; asm volatile("" : "+v"(scl1));
    if constexpr (GATHER) {
#pragma unroll
        for (int h = 0; h < 2; ++h)
#pragma unroll
            for (int i = 0; i < 2; ++i) vAc[h][i] = (unsigned)S.row(0, Rr[i] + HALF * h) * lda2 + (unsigned)Cc[i] * 2u;
    }
    f32x4 acc[2][2][4][2];
#pragma unroll
    for (int a = 0; a < 2; ++a)
#pragma unroll
        for (int b = 0; b < 2; ++b)
#pragma unroll
            for (int m = 0; m < 4; ++m)
#pragma unroll
                for (int n = 0; n < 2; ++n) acc[a][b][m][n] = (f32x4){0.f, 0.f, 0.f, 0.f};
    typename FragSel<false>::A AtH; typename FragSel<false>::B B0H, B1H; typename FragSel<true>::A AtQ; typename FragSel<true>::B B0Q, B1Q;
    const char* cA = cur.A; const char* cB = cur.B;
    PG8_STG_B(0, 0, cB); PG8_STG_B(0, 1, cB); PG8_STG_A(0, 0, cA, false); PG8_STG_A(0, 1, cA, false);
    if (wr == 1) PG8_BAR;
    PG8_WAIT_V(2); PG8_BAR;
    PG8_STG_B(1, 0, cB + kstep); PG8_STG_A(1, 0, cA + kstep, false); PG8_STG_B(1, 1, cB + kstep);
    PG8_WAIT_V(6); PG8_BAR;
    for (;;) {
        const bool has_next = S.next(ui + 1, nxt);
        const char* nA = has_next ? nxt.A : cA; const char* nB = has_next ? nxt.B : cB;
        if constexpr (GATHER) {
#pragma unroll
            for (int h = 0; h < 2; ++h)
#pragma unroll
                for (int i = 0; i < 2; ++i) vAn[h][i] = has_next ? (unsigned)S.row(ui + 1, Rr[i] + HALF * h) * lda2 + (unsigned)Cc[i] * 2u : vAc[h][i];
        }
#define PG8_KLOOP(KIND, MMA1, TBEG, TEND, FINAL) _Pragma("unroll 1") for (int t = (TBEG); t < (TEND); t += 2) { \
            const bool last = (FINAL) && (t == nt - 2); \
            const char* a1 = cA + (size_t)(t + 1) * kstep; \
            const char* a2 = last ? nA : cA + (size_t)(t + 2) * kstep; const char* b2 = last ? nB : cB + (size_t)(t + 2) * kstep; \
            const char* a3 = a2 + kstep; const char* b3 = b2 + kstep; \
              \
            PG8_LDB(KIND, 0, 0, 0); PG8_LDB(KIND, 1, 0, 1); PG8_SCHED; PG8_LDA(KIND, 0, 0); PG8_STG_A(1, 1, a1, false); \
            PG8_WAIT_V(8); PG8_WAIT_L(0); PG8_BAR; PG8_MMA(KIND, 0, 0, 0); PG8_MMA(KIND, 0, 1, 1); PG8_BAR; PG8_SCHED; \
              \
            PG8_LDA(KIND, 0, 1); PG8_STG_B(0, 0, b2); PG8_STG_B(0, 1, b2); PG8_STG_A(0, 0, a2, last); \
            PG8_WAIT_V(8); PG8_WAIT_L(0); PG8_BAR; if (MMA1) { PG8_MMA(KIND, 1, 0, 0); PG8_MMA(KIND, 1, 1, 1); } PG8_BAR; PG8_SCHED; \
              \
            PG8_LDB(KIND, 0, 1, 0); PG8_LDB(KIND, 1, 1, 1); PG8_SCHED; PG8_LDA(KIND, 1, 0); PG8_STG_A(0, 1, a2, last); \
            PG8_WAIT_V(8); PG8_WAIT_L(0); PG8_BAR; PG8_MMA(KIND, 0, 0, 0); PG8_MMA(KIND, 0, 1, 1); PG8_BAR; PG8_SCHED; \
              \
            PG8_LDA(KIND, 1, 1); PG8_STG_B(1, 0, b3); PG8_STG_B(1, 1, b3); PG8_STG_A(1, 0, a3, last); \
            PG8_WAIT_V(8); PG8_WAIT_L(0); PG8_BAR; if (MMA1) { PG8_MMA(KIND, 1, 0, 0); PG8_MMA(KIND, 1, 1, 1); } PG8_BAR; PG8_SCHED; \
        }
#define PG8_KLOOPS(KIND, TBEG, TEND, FINAL) do { if (HALFSKIP && cur.nvalid <= 128) { PG8_KLOOP(KIND, false, TBEG, TEND, FINAL) } else { PG8_KLOOP(KIND, true, TBEG, TEND, FINAL) } } while (0)
        if constexpr (MIXSW > 0) { PG8_KLOOPS(0, 0, MIXSW, false); PG8_KLOOPS(1, MIXSW, nt, true); }
        else if constexpr (FP8) { PG8_KLOOPS(1, 0, nt, true); }
        else { PG8_KLOOPS(0, 0, nt, true); }
        if constexpr (FP8 || MIXSW > 0) asm volatile("s_nop 15\n\ts_nop 15" ::: "memory");
        if (wr == 0) PG8_BAR;
        E(acc, cur, ui, wr, wc, fr, fq, scr);
        if constexpr (EPI2) { asm volatile("" ::: "memory"); E(acc, cur, ui, wr, wc, fr, fq, scr); }
        if (!has_next) break;
#pragma unroll
        for (int a = 0; a < 2; ++a)
#pragma unroll
            for (int b = 0; b < 2; ++b)
#pragma unroll
                for (int m = 0; m < 4; ++m)
#pragma unroll
                    for (int n = 0; n < 2; ++n) acc[a][b][m][n] = (f32x4){0.f, 0.f, 0.f, 0.f};
        cur = nxt; cA = nA; cB = nB; ++ui;
        if constexpr (GATHER) {
#pragma unroll
            for (int h = 0; h < 2; ++h)
#pragma unroll
                for (int i = 0; i < 2; ++i) vAc[h][i] = vAn[h][i];
        }
        if (wr == 1) PG8_BAR;
    }
    PG8_WAIT_V(0);
    PG8_BAR;
#undef PG8_KLOOPS
#undef PG8_KLOOP
#undef PG8_SA
#undef PG8_SB
#undef PG8_STG
#undef PG8_STG_A
#undef PG8_STG_B
#undef PG8_LDA
#undef PG8_LDB
#undef PG8_MMA
#undef PG8_WAIT_V
#undef PG8_WAIT_L
#undef PG8_BAR
#undef PG8_SCHED
}
}
using pg8::Unit;

typedef f32x4 Acc[2][2][4][2];
#define EPI_ROWS(ai, m) (128 * (ai) + 64 * wr + 16 * (m) + fr)
#define EPI_COL0 (32 * wc + 8 * fq)
__device__ __forceinline__ u32x4 pack8(const f32x4 a, const f32x4 b) { u32x4 w; w.x = cvt_pk_bf16(a[0], a[1]); w.y = cvt_pk_bf16(a[2], a[3]); w.z = cvt_pk_bf16(b[0], b[1]); w.w = cvt_pk_bf16(b[2], b[3]); return w; }

struct EpiPlain {
    int ldc; float scale;
    __device__ __forceinline__ void operator()(Acc& acc, const Unit& u, int, int wr, int wc, int fr, int fq, LAS unsigned char*) const {
        asm volatile("" : "+v"(fr), "+v"(fq));
        const int ld = ldc ? ldc : u.aux; bf16_t* base = (bf16_t*)u.C + EPI_COL0;
#pragma unroll
        for (int ai = 0; ai < 2; ++ai)
#pragma unroll
            for (int m = 0; m < 4; ++m) { bf16_t* rowp = base + (size_t)EPI_ROWS(ai, m) * ld;
#pragma unroll
                for (int bj = 0; bj < 2; ++bj) *(u32x4*)(rowp + bj * 128) = pack8(acc[ai][bj][m][0] * scale, acc[ai][bj][m][1] * scale); }
    }
};
__device__ __forceinline__ void epi_softmax(Acc& acc, const Unit& u, int wr, int wc, int fr, int fq, LAS unsigned char* scr, int ldc, float c) {
    LAS float* XA = (LAS float*)scr; LAS float* XB = (LAS float*)(scr + 4096);
#pragma unroll
    for (int ai = 0; ai < 2; ++ai)
#pragma unroll
        for (int m = 0; m < 4; ++m) { float mx = -3.0e38f;
#pragma unroll
            for (int bj = 0; bj < 2; ++bj)
#pragma unroll
                for (int n = 0; n < 2; ++n) { const f32x4 x = acc[ai][bj][m][n]; mx = fmaxf(mx, fmaxf(fmaxf(x[0], x[1]), fmaxf(x[2], x[3]))); }
            mx = fmaxf(mx, __shfl_xor(mx, 16)); mx = fmaxf(mx, __shfl_xor(mx, 32));
            if (fq == 0) XA[EPI_ROWS(ai, m) * 4 + wc] = mx; }
    LDS_WAIT(); __builtin_amdgcn_s_barrier(); asm volatile("" ::: "memory");
#pragma unroll
    for (int ai = 0; ai < 2; ++ai)
#pragma unroll
        for (int m = 0; m < 4; ++m) { const f32x4 q = *(const LAS f32x4*)(XA + EPI_ROWS(ai, m) * 4); const float mx = fmaxf(fmaxf(q[0], q[1]), fmaxf(q[2], q[3])) * c; float s = 0.f;
#pragma unroll
            for (int bj = 0; bj < 2; ++bj)
#pragma unroll
                for (int n = 0; n < 2; ++n) { f32x4 x = acc[ai][bj][m][n];
#pragma unroll
                    for (int j = 0; j < 4; ++j) { x[j] = __builtin_amdgcn_exp2f(x[j] * c - mx); s += x[j]; }
                    acc[ai][bj][m][n] = x; }
            s += __shfl_xor(s, 16); s += __shfl_xor(s, 32);
            if (fq == 0) XB[EPI_ROWS(ai, m) * 4 + wc] = s; asm volatile("" ::: "memory"); }
    LDS_WAIT(); __builtin_amdgcn_s_barrier(); asm volatile("" ::: "memory");
    unsigned char* base = (unsigned char*)u.C + 32 * wc + 8 * (fq & ~1); const bool odd = fq & 1;
#pragma unroll
    for (int ai = 0; ai < 2; ++ai) {
        u32x2 w8[4][2];
#pragma unroll
        for (int m = 0; m < 4; ++m) { const int r = EPI_ROWS(ai, m); const f32x4 q = *(const LAS f32x4*)(XB + r * 4); const float inv = P_S * __builtin_amdgcn_rcpf((q[0] + q[1]) + (q[2] + q[3]));
#pragma unroll
            for (int bj = 0; bj < 2; ++bj) { const f32x4 v0 = acc[ai][bj][m][0] * inv, v1 = acc[ai][bj][m][1] * inv; w8[m][bj].x = pk4_fp8(v0[0], v0[1], v0[2], v0[3]); w8[m][bj].y = pk4_fp8(v1[0], v1[1], v1[2], v1[3]); } }
#pragma unroll
        for (int mp = 0; mp < 4; mp += 2)
#pragma unroll
            for (int bj = 0; bj < 2; ++bj) { const u32x2 mine = odd ? w8[mp + 1][bj] : w8[mp][bj], send = odd ? w8[mp][bj] : w8[mp + 1][bj];
                u32x2 recv; recv.x = (unsigned)__shfl_xor((int)send.x, 16); recv.y = (unsigned)__shfl_xor((int)send.y, 16);
                u32x4 o; if (odd) { o.x = recv.x; o.y = recv.y; o.z = mine.x; o.w = mine.y; } else { o.x = mine.x; o.y = mine.y; o.z = recv.x; o.w = recv.y; }
                *(u32x4*)(base + (size_t)EPI_ROWS(ai, mp + (odd ? 1 : 0)) * ldc + bj * 128) = o; }
        asm volatile("" ::: "memory"); }
}
struct EpiFp8 {
    float scale0; int ldc0; float scale1; int ldc1;
    __device__ __forceinline__ void operator()(Acc& acc, const Unit& u, int, int wr, int wc, int fr, int fq, LAS unsigned char*) const {
        asm volatile("" : "+v"(fr), "+v"(fq));
        unsigned char* base = (unsigned char*)u.C + EPI_COL0; const float scale = u.aux ? scale1 : scale0; const int ldc = u.aux ? ldc1 : ldc0;
#pragma unroll
        for (int ai = 0; ai < 2; ++ai)
#pragma unroll
            for (int m = 0; m < 4; ++m)
#pragma unroll
                for (int bj = 0; bj < 2; ++bj) { const f32x4 v0 = acc[ai][bj][m][0] * scale, v1 = acc[ai][bj][m][1] * scale; u32x2 w; w.x = pk4_fp8(v0[0], v0[1], v0[2], v0[3]); w.y = pk4_fp8(v1[0], v1[1], v1[2], v1[3]);
                    *(u32x2*)(base + (size_t)EPI_ROWS(ai, m) * ldc + bj * 128) = w; }
    }
};
template <int MODE> struct EpiProj {
    int ldc; const float* rs; float* ssqv; int qt;
    LAS float* rtab; float sc;
    __device__ __forceinline__ void operator()(Acc& acc, const Unit& u, int ui, int wr, int wc, int fr, int fq, LAS unsigned char* scr) const {
        asm volatile("" : "+v"(fr), "+v"(fq));
        bf16_t* base = (bf16_t*)u.C + EPI_COL0;
#pragma unroll
        for (int ai = 0; ai < 2; ++ai)
#pragma unroll
            for (int m = 0; m < 4; ++m) {
                const int r = EPI_ROWS(ai, m), t = u.pm * 256 + r; const float rstd = rtab[ui * 256 + r] * sc;
                float sq = 0.f;
#pragma unroll
                for (int bj = 0; bj < 2; ++bj) { f32x4 v0 = acc[ai][bj][m][0] * rstd, v1 = acc[ai][bj][m][1] * rstd;
                    if (MODE == 1 && u.pn < 8) {
#pragma unroll
                        for (int j = 0; j < 4; ++j) { v0[j] = gelu_tanh(v0[j]); v1[j] = gelu_tanh(v1[j]); } }
                    const u32x4 w = pack8(v0, v1);
                    if (MODE == 1) { const float a0 = bflo(w.x), a1 = bfhi(w.x), a2 = bflo(w.y), a3 = bfhi(w.y), a4 = bflo(w.z), a5 = bfhi(w.z), a6 = bflo(w.w), a7 = bfhi(w.w);
                        sq += (a0 * a0 + a1 * a1) + (a2 * a2 + a3 * a3) + (a4 * a4 + a5 * a5) + (a6 * a6 + a7 * a7); }
                    *(u32x4*)(base + (size_t)r * ldc + bj * 128) = w; }
                if (MODE == 1 && u.pn >= 4 && u.pn < 8) { sq += __shfl_xor(sq, 16); sq += __shfl_xor(sq, 32); if (fq == 0) ssqv[(size_t)t * 16 + (u.pn - 4) * 4 + wc] = sq; }
            }
    }
};
template <int MODE> struct EpiScore {
    LAS float* rtab;
    __device__ __forceinline__ void operator()(Acc& acc, const Unit& u, int ui, int wr, int wc, int fr, int fq, LAS unsigned char* scr) const {
        asm volatile("" : "+v"(fr), "+v"(fq));
#pragma unroll
        for (int ai = 0; ai < 2; ++ai)
#pragma unroll
            for (int m = 0; m < 4; ++m) { const float rstd = rtab[ui * 256 + EPI_ROWS(ai, m)];
#pragma unroll
                for (int bj = 0; bj < 2; ++bj) { acc[ai][bj][m][0] = acc[ai][bj][m][0] * rstd; acc[ai][bj][m][1] = acc[ai][bj][m][1] * rstd; } }
        epi_softmax(acc, u, wr, wc, fr, fq, scr, 3072, 1.442695041f / WQ_S);
    }
};
struct EpiSpatial {
    const bf16_t* uproj; const float* bs;
    __device__ __forceinline__ void operator()(Acc& acc, const Unit& u, int, int wr, int wc, int fr, int fq, LAS unsigned char*) const {
        asm volatile("" : "+v"(fr), "+v"(fq));
        unsigned char* base = (unsigned char*)u.C + EPI_COL0; const bf16_t* ub = uproj + (size_t)u.pm * 256 * 3072 + u.pn * 256 + EPI_COL0;
#pragma unroll
        for (int ai = 0; ai < 2; ++ai)
#pragma unroll
            for (int m = 0; m < 4; ++m) { const int r = EPI_ROWS(ai, m); const float b = bs[u.pn * 128 + (r & 127)];
#pragma unroll
                for (int bj = 0; bj < 2; ++bj) { const u32x4 uw = *(const u32x4*)(ub + (size_t)r * 3072 + bj * 128); f32x4 v0 = acc[ai][bj][m][0] + b, v1 = acc[ai][bj][m][1] + b;
                    v0[0] *= bflo(uw.x); v0[1] *= bfhi(uw.x); v0[2] *= bflo(uw.y); v0[3] *= bfhi(uw.y); v1[0] *= bflo(uw.z); v1[1] *= bfhi(uw.z); v1[2] *= bflo(uw.w); v1[3] *= bfhi(uw.w);
                    v0 = v0 * MX_S; v1 = v1 * MX_S; u32x2 w8; w8.x = pk4_fp8(v0[0], v0[1], v0[2], v0[3]); w8.y = pk4_fp8(v1[0], v1[1], v1[2], v1[3]);
                    *(u32x2*)(base + (size_t)r * 3072 + bj * 128) = w8; }
                asm volatile("" ::: "memory"); }
    }
};
struct EpiOut {
    float* part; unsigned char* xb8; float rsc;
    __device__ __forceinline__ void operator()(Acc& acc, const Unit& u, int, int wr, int wc, int fr, int fq, LAS unsigned char* scr) const {
        asm volatile("" : "+v"(fr), "+v"(fq));
        bf16_t* base = (bf16_t*)u.C + EPI_COL0; LAS float* XA = (LAS float*)scr;
        const bool odd = fq & 1;
#pragma unroll
        for (int ai = 0; ai < 2; ++ai) {
            u32x4 xw[4][2];
#pragma unroll
            for (int m = 0; m < 4; ++m)
#pragma unroll
                for (int bj = 0; bj < 2; ++bj) xw[m][bj] = *(const u32x4*)(base + (size_t)EPI_ROWS(ai, m) * D + bj * 128);
            u32x2 w8[4][2];
#pragma unroll
            for (int m = 0; m < 4; ++m) { const int r = EPI_ROWS(ai, m); float sq = 0.f;
#pragma unroll
                for (int bj = 0; bj < 2; ++bj) { u32x4* p = (u32x4*)(base + (size_t)r * D + bj * 128); const u32x4 x = xw[m][bj]; f32x4 v0 = acc[ai][bj][m][0] * rsc, v1 = acc[ai][bj][m][1] * rsc;
                    v0[0] += bflo(x.x); v0[1] += bfhi(x.x); v0[2] += bflo(x.y); v0[3] += bfhi(x.y); v1[0] += bflo(x.z); v1[1] += bfhi(x.z); v1[2] += bflo(x.w); v1[3] += bfhi(x.w);
                    const u32x4 w = pack8(v0, v1); *p = w;
                    const float a0 = bflo(w.x), a1 = bfhi(w.x), a2 = bflo(w.y), a3 = bfhi(w.y), a4 = bflo(w.z), a5 = bfhi(w.z), a6 = bflo(w.w), a7 = bfhi(w.w);
                    w8[m][bj].x = pk4_fp8(a0, a1, a2, a3); w8[m][bj].y = pk4_fp8(a4, a5, a6, a7);
                    sq += (a0 * a0 + a1 * a1) + (a2 * a2 + a3 * a3) + (a4 * a4 + a5 * a5) + (a6 * a6 + a7 * a7); }
                sq += __shfl_xor(sq, 16); sq += __shfl_xor(sq, 32);
                if (fq == 0) XA[r * 4 + wc] = sq; }
#pragma unroll
            for (int mp = 0; mp < 4; mp += 2)
#pragma unroll
                for (int bj = 0; bj < 2; ++bj) { const u32x2 mine = odd ? w8[mp + 1][bj] : w8[mp][bj], send = odd ? w8[mp][bj] : w8[mp + 1][bj];
                    u32x2 recv; recv.x = (unsigned)__shfl_xor((int)send.x, 16); recv.y = (unsigned)__shfl_xor((int)send.y, 16);
                    u32x4 o; if (odd) { o.x = recv.x; o.y = recv.y; o.z = mine.x; o.w = mine.y; } else { o.x = mine.x; o.y = mine.y; o.z = recv.x; o.w = recv.y; }
                    const int r = EPI_ROWS(ai, mp + (odd ? 1 : 0));
                    *(u32x4*)(xb8 + (size_t)(u.pm * 256 + r) * D + u.pn * 256 + bj * 128 + 32 * wc + 8 * (fq & ~1)) = o; }
            asm volatile("" ::: "memory"); }
        LDS_WAIT(); __builtin_amdgcn_s_barrier(); asm volatile("" ::: "memory");
        { int tid = threadIdx.x; asm volatile("" : "+v"(tid));
          if (tid < 256) { const f32x4 q = *(const LAS f32x4*)(XA + tid * 4); part[(size_t)(u.pm * 256 + tid) * 8 + u.pn] = (q[0] + q[1]) + (q[2] + q[3]); } }
    }
};
struct EpiRoute {
    float* lg;
    __device__ __forceinline__ void operator()(Acc& acc, const Unit& u, int, int wr, int wc, int fr, int fq, LAS unsigned char*) const {
        asm volatile("" : "+v"(fr), "+v"(fq));
        if (wc >= 2) return;
        float* base = lg + (size_t)u.pn * T * 64 + (size_t)u.pm * 256 * 64 + EPI_COL0;
#pragma unroll
        for (int ai = 0; ai < 2; ++ai)
#pragma unroll
            for (int m = 0; m < 4; ++m) { float* rowp = base + (size_t)EPI_ROWS(ai, m) * 64;
                if (wc == 0) { *(f32x4*)rowp = acc[ai][0][m][0] + acc[ai][1][m][0]; *(f32x4*)(rowp + 4) = acc[ai][0][m][1] + acc[ai][1][m][1]; }
                else if (fq == 0) *(f32x4*)rowp = acc[ai][0][m][0] + acc[ai][1][m][0]; }
    }
};
struct SchedMoe {
    LAS int* pre; LAS int* cnt; LAS int* idx; LAS int* preB; LAS int* preS; int lo, hi, G, c, nbu, nunits; int mode;
    int perm;
    __device__ __forceinline__ int plist(int p) const { return perm ? ((p & 1) * 32 + (p >> 1)) : p; }
    LAS int* ul; int nmy;
    const char* A0; const char* B0; char* C0;
    __device__ __forceinline__ bool decode(int i, int& l, int& rt, int& pn, int& tile) const {
        const long L = (long)i * G + c; if (L >= nunits) return false;
        int wgid = (int)L, q; LAS int* px; bool small = wgid >= nbu;
        if (!small) { const int qq = nbu / 8, r = nbu % 8, xcd = wgid % 8, off = wgid / 8; wgid = (xcd < r ? xcd * (qq + 1) : r * (qq + 1) + (xcd - r) * qq) + off; q = wgid >> 3; px = preB; }
        else { wgid -= nbu; q = wgid >> 3; px = preS; }
        pn = wgid & 7;
        const int base = rfl(px[lo]); int a = lo, b = hi;
        while (b - a > 1) { const int mid = (a + b) >> 1; if (rfl(px[mid]) - base <= q) a = mid; else b = mid; }
        l = a; rt = small ? ((rfl(cnt[l]) + 255) >> 8) - 1 : q - (rfl(px[l]) - base); tile = rfl(pre[l]) + rt; return true;
    }
    __device__ __forceinline__ void decode_t(int i, int& l, int& rt, int& pn, int& tile) const {
        int wgid = i * G + c, q; LAS int* px; const bool small = wgid >= nbu;
        if (!small) { const int qq = nbu / 8, r = nbu % 8, xcd = wgid % 8, off = wgid / 8; wgid = (xcd < r ? xcd * (qq + 1) : r * (qq + 1) + (xcd - r) * qq) + off; q = wgid >> 3; px = preB; }
        else { wgid -= nbu; q = wgid >> 3; px = preS; }
        pn = wgid & 7;
        const int base = px[lo]; int a = lo, b = hi;
        while (b - a > 1) { const int mid = (a + b) >> 1; if (px[mid] - base <= q) a = mid; else b = mid; }
        l = plist(a); rt = small ? ((cnt[l] + 255) >> 8) - 1 : q - (px[a] - base); tile = pre[l] + rt;
    }
    __device__ __forceinline__ bool next(int i, Unit& u) const {
        if (i >= nmy) return false;
        const int w0 = rfl(ul[2 * i]), w1 = rfl(ul[2 * i + 1]); const int l = w0 & 255, rt = (w0 >> 8) & 4095, pn = w0 >> 20, tile = w1 & 0xffff;
        const int e = l & 31;
        u.pm = rt; u.pn = pn; u.aux = l; u.nvalid = w1 >> 16;
        if (mode == 0) { u.A = A0; u.B = B0 + (size_t)e * (2048 * 2048) + (size_t)pn * (128 * 2048); u.C = C0 + (size_t)tile * (256 * 1024) + (size_t)pn * 128; }
        else { u.A = A0 + (size_t)tile * (256 * 1024); u.B = B0 + (size_t)e * (2048 * 1024) + (size_t)pn * (256 * 1024); u.C = C0; }
        return true;
    }
    __device__ __forceinline__ int row(int j, int r) const { return idx[j * 256 + r] & 0x1ffff; }
};
template <int KIND  >
__device__ __forceinline__ void moe_setup(SchedMoe& S, const int* totals, const int* listp, const float* vals) {
    int tid = threadIdx.x; LAS int* cnt = S.cnt;
    if (tid < 64) { const int c_ = totals[tid]; cnt[tid] = c_; int a = (c_ + 255) >> 8;
        const int cp = totals[S.plist(tid)], nt_ = (cp + 255) >> 8, sm = (nt_ > 0 && cp - (nt_ - 1) * 256 <= 128) ? 1 : 0; int ab = nt_ - sm, as = sm;
#pragma unroll
        for (int o = 1; o < 64; o <<= 1) { const int ta = __shfl_up(a, o), tb = __shfl_up(ab, o), ts = __shfl_up(as, o); if (tid >= o) { a += ta; ab += tb; as += ts; } }
        S.pre[tid + 1] = a; S.preB[tid + 1] = ab; S.preS[tid + 1] = as; if (tid == 0) { S.pre[0] = 0; S.preB[0] = 0; S.preS[0] = 0; } }
    __syncthreads();
    S.nbu = (rfl(S.preB[S.hi]) - rfl(S.preB[S.lo])) * 8; S.nunits = S.nbu + (rfl(S.preS[S.hi]) - rfl(S.preS[S.lo])) * 8;
    { const int n_ = S.c < S.nunits ? (S.nunits - S.c + S.G - 1) / S.G : 0; S.nmy = n_ < MAX_MOE_UNITS ? n_ : MAX_MOE_UNITS; }
    if (tid < S.nmy) { int li, rt, pn, tile; S.decode_t(tid, li, rt, pn, tile); const int nv_ = cnt[li] - rt * 256; S.ul[2 * tid] = li | (rt << 8) | (pn << 20); S.ul[2 * tid + 1] = tile | ((nv_ < 256 ? nv_ : 256) << 16); }
    __syncthreads();
    const int j2 = tid >> 8, r = tid & 255; int tk[6]; float vv[6]; size_t off[6];
#pragma unroll
    for (int q = 0; q < 6; ++q) { const int j = j2 + 2 * q; tk[q] = T; vv[q] = 0.f; off[q] = 0;
        if (j < S.nmy) { const int w0 = S.ul[2 * j], w1 = S.ul[2 * j + 1]; const int li = w0 & 255, rt = (w0 >> 8) & 4095, nv = w1 >> 16;
            if (r < nv) { off[q] = (size_t)li * T + rt * 256 + r; tk[q] = listp[off[q]]; if (KIND == 1) vv[q] = vals[off[q]]; } } }
    if (KIND == 0) {
#pragma unroll
        for (int q = 0; q < 6; ++q) vv[q] = vals[tk[q]]; }
#pragma unroll
    for (int q = 0; q < 6; ++q) { const int j = j2 + 2 * q; if (j < S.nmy) S.idx[j * 256 + r] = tk[q] | (int)(((__float_as_uint(vv[q]) + 0x8000u) >> 16) << 17); }
    __syncthreads();
}
struct EpiGu {
    const float* rstd; LAS int* idx;
    __device__ __forceinline__ void operator()(Acc& acc, const Unit& u, int ui, int wr, int wc, int fr, int fq, LAS unsigned char*) const {
        asm volatile("" : "+v"(fr), "+v"(fq));
        unsigned char* base = (unsigned char*)u.C + EPI_COL0;
#pragma unroll
        for (int ai = 0; ai < 2; ++ai)
#pragma unroll
            for (int m = 0; m < 4; ++m) { const int r = EPI_ROWS(ai, m); const float rs = __uint_as_float(((unsigned)idx[ui * 256 + r] >> 17) << 16) * (1.0f / GU_WS);
                f32x4 h0, h1;
#pragma unroll
                for (int j = 0; j < 4; ++j) { h0[j] = silu_f(acc[ai][0][m][0][j] * rs) * (acc[ai][1][m][0][j] * (rs * HID_S)); h1[j] = silu_f(acc[ai][0][m][1][j] * rs) * (acc[ai][1][m][1][j] * (rs * HID_S)); }
                u32x2 w; w.x = pk4_fp8(h0[0], h0[1], h0[2], h0[3]); w.y = pk4_fp8(h1[0], h1[1], h1[2], h1[3]);
                *(u32x2*)(base + (size_t)r * DEXP) = w; }
    }
};
template <int MODE> struct EpiDown {
    bf16_t* xb; unsigned char* y0; unsigned char* y1; LAS int* idx; float* part; float rsc, ysc; unsigned char* x8;
    __device__ __forceinline__ void operator()(Acc& acc, const Unit& u, int ui, int wr, int wc, int fr, int fq, LAS unsigned char*) const {
        asm volatile("" : "+v"(fr), "+v"(fq));
        int tok[2][4]; float gt[2][4];
#pragma unroll
        for (int ai = 0; ai < 2; ++ai)
#pragma unroll
            for (int m = 0; m < 4; ++m) { const unsigned e = (unsigned)idx[ui * 256 + EPI_ROWS(ai, m)]; tok[ai][m] = (int)(e & 0x1ffffu); gt[ai][m] = __uint_as_float((e >> 17) << 16) * rsc; }
        if constexpr (MODE == 0) {
            unsigned char* yb = (u.aux >> 5) ? y1 : y0; const bool odd = fq & 1;
#pragma unroll
            for (int ai = 0; ai < 2; ++ai) {
                u32x2 w8[4][2];
#pragma unroll
                for (int m = 0; m < 4; ++m) { const float g = gt[ai][m] * Y_S;
#pragma unroll
                    for (int bj = 0; bj < 2; ++bj) { const f32x4 v0 = acc[ai][bj][m][0] * g, v1 = acc[ai][bj][m][1] * g; w8[m][bj].x = pk4_fp8(v0[0], v0[1], v0[2], v0[3]); w8[m][bj].y = pk4_fp8(v1[0], v1[1], v1[2], v1[3]); } }
#pragma unroll
                for (int mp = 0; mp < 4; mp += 2) { const int msk = -(int)(fq & 1); const int tk = (tok[ai][mp] & ~msk) | (tok[ai][mp + 1] & msk); const int ts = tk + (tk >= T ? 1 : 0);
#pragma unroll
                    for (int bj = 0; bj < 2; ++bj) { const u32x2 mine = odd ? w8[mp + 1][bj] : w8[mp][bj], send = odd ? w8[mp][bj] : w8[mp + 1][bj];
                        u32x2 recv; recv.x = (unsigned)__shfl_xor((int)send.x, 16); recv.y = (unsigned)__shfl_xor((int)send.y, 16);
                        u32x4 o; if (odd) { o.x = recv.x; o.y = recv.y; o.z = mine.x; o.w = mine.y; } else { o.x = mine.x; o.y = mine.y; o.z = recv.x; o.w = recv.y; }
                        *(u32x4*)(yb + (size_t)ts * D + u.pn * 256 + bj * 128 + 32 * wc + 8 * (fq & ~1)) = o; } }
                asm volatile("" ::: "memory"); }
        } else {
#pragma unroll
            for (int ai = 0; ai < 2; ++ai) {
                u32x4 xw[4][2]; u32x2 yw[4][2]; u32x2 w8[4][2];
#pragma unroll
                for (int m = 0; m < 4; ++m)
#pragma unroll
                    for (int bj = 0; bj < 2; ++bj) { xw[m][bj] = *(const u32x4*)(xb + (size_t)tok[ai][m] * D + u.pn * 256 + EPI_COL0 + bj * 128); yw[m][bj] = *(const u32x2*)(y0 + (size_t)tok[ai][m] * D + u.pn * 256 + EPI_COL0 + bj * 128); }
#pragma unroll
                for (int m = 0; m < 4; ++m) { const float g = gt[ai][m]; float sq = 0.f; const int ts = tok[ai][m] + (tok[ai][m] >= T ? 1 : 0); bf16_t* rowp = xb + (size_t)ts * D + u.pn * 256 + EPI_COL0;
#pragma unroll
                    for (int bj = 0; bj < 2; ++bj) { const u32x4 x = xw[m][bj]; float y[8]; fp8x8_to_f32(yw[m][bj], y); f32x4 v0 = acc[ai][bj][m][0] * g, v1 = acc[ai][bj][m][1] * g;
                        v0[0] += bflo(x.x) + y[0] * ysc; v0[1] += bfhi(x.x) + y[1] * ysc; v0[2] += bflo(x.y) + y[2] * ysc; v0[3] += bfhi(x.y) + y[3] * ysc;
                        v1[0] += bflo(x.z) + y[4] * ysc; v1[1] += bfhi(x.z) + y[5] * ysc; v1[2] += bflo(x.w) + y[6] * ysc; v1[3] += bfhi(x.w) + y[7] * ysc;
                        const u32x4 w = pack8(v0, v1); *(u32x4*)(rowp + bj * 128) = w;
                        const float a0 = bflo(w.x), a1 = bfhi(w.x), a2 = bflo(w.y), a3 = bfhi(w.y), a4 = bflo(w.z), a5 = bfhi(w.z), a6 = bflo(w.w), a7 = bfhi(w.w);
                        w8[m][bj].x = pk4_fp8(a0, a1, a2, a3); w8[m][bj].y = pk4_fp8(a4, a5, a6, a7);
                        sq += (a0 * a0 + a1 * a1) + (a2 * a2 + a3 * a3) + (a4 * a4 + a5 * a5) + (a6 * a6 + a7 * a7); }
                    if (part) { sq += __shfl_xor(sq, 16); sq += __shfl_xor(sq, 32); if (fq == 0 && ts < T) part[(size_t)ts * 32 + u.pn * 4 + wc] = sq; } }
#pragma unroll
                for (int mp = 0; mp < 4; mp += 2) { const int msk = -(int)(fq & 1); const int tk = (tok[ai][mp] & ~msk) | (tok[ai][mp + 1] & msk); const int ts = tk + (tk >= T ? 1 : 0); const bool odd = fq & 1;
#pragma unroll
                    for (int bj = 0; bj < 2; ++bj) { const u32x2 mine = odd ? w8[mp + 1][bj] : w8[mp][bj], send = odd ? w8[mp][bj] : w8[mp + 1][bj];
                        u32x2 recv; recv.x = (unsigned)__shfl_xor((int)send.x, 16); recv.y = (unsigned)__shfl_xor((int)send.y, 16);
                        u32x4 o; if (odd) { o.x = recv.x; o.y = recv.y; o.z = mine.x; o.w = mine.y; } else { o.x = mine.x; o.y = mine.y; o.z = recv.x; o.w = recv.y; }
                        *(u32x4*)(x8 + (size_t)ts * D + u.pn * 256 + bj * 128 + 32 * wc + 8 * (fq & ~1)) = o; } }
                asm volatile("" ::: "memory"); }
        }
    }
};
struct SchedSp { pg8::SchedGrid g; __device__ __forceinline__ bool next(int i, Unit& u) const { if (!g.next(i, u)) return false; u.B = g.B0 + ((size_t)u.pm * 4 + u.pn) * (256 * 512); return true; } __device__ __forceinline__ int row(int, int) const { return 0; } };
struct SchedProj {
    int nN, qt, G, c; const char* A0; const char* B0; const char* BQ; char* C0; size_t c_pm; char* CQ; int rb;
    __device__ __forceinline__ bool next(int i, Unit& u) const {
        int pm, pn; if (!pg8::grid_order(i, G, c, T / 256, nN, pm, pn)) return false;
        u.pm = pm; u.pn = pn; u.aux = 0; u.nvalid = 256;
        if (qt) { u.A = A0 + (size_t)pm * 256 * rb; u.B = B0 + (size_t)pn * 256 * rb; u.C = C0 + (size_t)pm * c_pm + (size_t)pn * 512; }
        else { u.A = A0 + (size_t)pm * (256 * 2048); u.B = BQ + (size_t)(pm >> 6) * (1024 * 2048) + (size_t)pn * (256 * 2048); u.C = CQ + (size_t)pm * (256 * 3072) + (size_t)(2048 + pn * 256); }
        return true;
    }
    __device__ __forceinline__ int row(int, int) const { return 0; }
};
template <int MODE, class Sched> __device__ __forceinline__ void proj_fill_rstd(const Sched& S, const float* rs, LAS float* rtab) {
    Unit u; int tid = threadIdx.x;
    for (int j = 0; j < 6 && S.next(j, u); ++j)
        if (tid < 256) { const int t = u.pm * 256 + tid; float v;
            if (MODE == 0) v = rs[t];
            else { const f32x4* pp = (const f32x4*)(rs + (size_t)t * 32); float sm = 0.f;
#pragma unroll
                for (int q = 0; q < 8; ++q) { const f32x4 p = pp[q]; sm += (p[0] + p[1]) + (p[2] + p[3]); }
                v = __builtin_amdgcn_rsqf(sm * (1.0f / D) + EPS); }
            rtab[j * 256 + tid] = v; }
    __syncthreads();
}
struct SchedKV {
    int G, c; const char* memn; const char* wkv; char* kvn;
    __device__ __forceinline__ bool next(int i, Unit& u) const {
        const int id = i * G + c; if (id >= 32) return false;
        const int l = id >> 4, b = (id >> 3) & 1, j = id & 7;
        u.pm = 0; u.pn = 0; u.nvalid = 256; u.aux = 2048;
        u.A = memn + (size_t)l * (512 * 4096) + (size_t)b * (256 * 4096); u.B = wkv + (size_t)l * (2048 * 4096) + (size_t)j * (256 * 4096);
        u.C = kvn + (size_t)l * (512 * 4096) + (size_t)b * (256 * 4096) + (size_t)j * 512; return true;
    }
    __device__ __forceinline__ int row(int, int) const { return 0; }
};
struct SchedFold {
    int G, c; const char* woutT; const char* kvn; const char* grpn; char* bto; const char* wqn; char* winq; int mode;
    __device__ __forceinline__ bool next(int i, Unit& u) const {
        const int id = i * G + c; if (id >= (mode ? 256 : 64)) return false;
        u.pm = 0; u.pn = 0; u.nvalid = 256; u.aux = 0;
        if (mode == 0) { const int b = id >> 5, g = (id >> 3) & 3, rt = id & 7;
            u.A = woutT + (size_t)rt * (256 * 4096) + (size_t)g * 512; u.B = grpn + (size_t)g * 512;
            u.C = bto + (size_t)b * (2048 * 3072) + (size_t)rt * (256 * 3072) + (size_t)g * 512; u.aux = 1536; }
        else if (id < 128) { const int l = id >> 6, b = (id >> 5) & 1, h = (id >> 3) & 3, rt = id & 7;
            u.A = woutT + (size_t)l * (2048 * 4096) + (size_t)rt * (256 * 4096) + (size_t)(1024 + h * 256) * 2;
            u.B = kvn + (size_t)l * (512 * 4096) + (size_t)b * (256 * 4096) + (size_t)(1024 + h * 256) * 2;
            u.C = bto + (size_t)(l * 2 + b) * (2048 * 3072) + (size_t)rt * (256 * 3072) + (size_t)(2048 + h * 256); }
        else { const int r = id - 128, l = r >> 6, b = (r >> 5) & 1, h = (r >> 3) & 3, ct = r & 7;
            u.A = kvn + (size_t)l * (512 * 4096) + (size_t)b * (256 * 4096) + (size_t)h * 512;
            u.B = wqn + (size_t)l * (2048 * 4096) + (size_t)ct * (256 * 4096) + (size_t)h * 512;
            u.C = winq + (size_t)(l * 2 + b) * (1024 * 2048) + (size_t)h * (256 * 2048) + (size_t)ct * 256; u.aux = 1; }
        return true;
    }
    __device__ __forceinline__ int row(int, int) const { return 0; }
};

struct Args { const float* in[22]; float* out; unsigned char* ws; int ph_lo, ph_hi; };
struct Frame { LAS unsigned char* lds; LAS unsigned char* scr; int tid, lane, wave, G, bid; };

struct TrDesc { const float* W; void* WT; const float* ks; const float* ns; float cs; int ldw, kd, k0, n0; bool f8; };
__device__ __forceinline__ void tr_load(const TrDesc& d, f32x4 (&v)[16], int lane) {
    const int kq = lane >> 4, n4 = (lane & 15) * 4;
#pragma unroll
    for (int i = 0; i < 16; ++i) v[i] = *(const f32x4*)(d.W + (size_t)(d.k0 + 16 * kq + i) * d.ldw + d.n0 + n4);
}
__device__ __forceinline__ void tr_finish(const TrDesc& d, f32x4 (&v)[16], LAS unsigned* s32, int lane) {
    const int kq = lane >> 4, n4 = (lane & 15) * 4;
    f32x4 ns = (f32x4){d.cs, d.cs, d.cs, d.cs}; if (d.ns) ns = *(const f32x4*)(d.ns + d.n0 + n4) * d.cs;
    if (d.ks) {
#pragma unroll
        for (int q = 0; q < 4; ++q) { const f32x4 ks = *(const f32x4*)(d.ks + d.k0 + 16 * kq + 4 * q);
#pragma unroll
            for (int e = 0; e < 4; ++e) v[4 * q + e] = v[4 * q + e] * ks[e]; } }
#pragma unroll
    for (int i = 0; i < 16; ++i) v[i] = v[i] * ns;
    if (!d.f8) {
#pragma unroll
        for (int j = 0; j < 4; ++j)
#pragma unroll
            for (int p = 0; p < 8; ++p) s32[(n4 + j) * 33 + 8 * kq + p] = cvt_pk_bf16(v[2 * p][j], v[2 * p + 1][j]);
        LDS_WAIT(); asm volatile("" ::: "memory");
        const int c = lane & 7; bf16_t* WT = (bf16_t*)d.WT;
#pragma unroll
        for (int j = 0; j < 8; ++j) { const int n = (lane >> 3) + 8 * j; const LAS unsigned* sp = s32 + n * 33 + 4 * c;
            u32x4 o; o.x = sp[0]; o.y = sp[1]; o.z = sp[2]; o.w = sp[3];
            *(u32x4*)(WT + (size_t)(d.n0 + n) * d.kd + d.k0 + 8 * c) = o; }
    } else {
#pragma unroll
        for (int j = 0; j < 4; ++j)
#pragma unroll
            for (int p = 0; p < 4; ++p) s32[(n4 + j) * 17 + 4 * kq + p] = pk4_fp8(v[4 * p][j], v[4 * p + 1][j], v[4 * p + 2][j], v[4 * p + 3][j]);
        LDS_WAIT(); asm volatile("" ::: "memory");
        const int c = lane & 3; unsigned char* WT = (unsigned char*)d.WT;
#pragma unroll
        for (int j = 0; j < 4; ++j) { const int n = (lane >> 2) + 16 * j; const LAS unsigned* sp = s32 + n * 17 + 4 * c;
            u32x4 o; o.x = sp[0]; o.y = sp[1]; o.z = sp[2]; o.w = sp[3];
            *(u32x4*)(WT + (size_t)(d.n0 + n) * d.kd + d.k0 + 16 * c) = o; }
    }
    LDS_WAIT(); asm volatile("" ::: "memory");
}
__device__ __forceinline__ void tr_desc(TrDesc& d, const float* W, int K, int N, void* WT, const float* ks, const float* ns, float cs, bool f8, int item) {
    const int nblk = N / 64, kb = item / nblk, nb = item % nblk;
    d.W = W; d.WT = WT; d.ks = ks; d.ns = ns; d.cs = cs; d.ldw = N; d.kd = K; d.k0 = 64 * kb; d.n0 = 64 * nb; d.f8 = f8;
}

#define x_in (args.in[0])
#define mem_in (args.in[1])
#define norm_mix_g (args.in[2])
#define norm_mem_g (args.in[3])
#define norm_ffn_g (args.in[4])
#define pool_w_in (args.in[5])
#define pool_w_grp (args.in[6])
#define pool_scale (args.in[7])
#define pool_w_out (args.in[8])
#define sgu_w_in (args.in[9])
#define sgu_norm_g (args.in[10])
#define sgu_w_s (args.in[11])
#define sgu_b_s (args.in[12])
#define sgu_w_out (args.in[13])
#define xa_w_kv (args.in[14])
#define moe_w_group (args.in[15])
#define moe_b_group (args.in[16])
#define moe_w_expert (args.in[17])
#define moe_b_expert (args.in[18])
#define moe_w_gu (args.in[19])
#define moe_w_down (args.in[20])
#define final_norm_g (args.in[21])
#define WSP(type, off) ((type*)(args.ws + (off)))
#define RSTD0 WSP(float, WS_RSTD)
#define RSTD1 WSP(float, WS_RSTD + RSTD_STRIDE)
#define PART1 WSP(float, WS_PART1)
#define PART2 WSP(float, WS_PART2)
#define SSQV WSP(float, WS_SSQV)
#define LOGITS WSP(float, WS_LOGITS)
#define LIST WSP(int, WS_LIST)
#define GATEW WSP(float, WS_GATEW)
#define KMAT WSP(bf16_t, WS_KMAT)
#define VT WSP(bf16_t, WS_VT)
#define MEMN WSP(bf16_t, WS_MEMN)
#define WIN0 WSP(bf16_t, WS_WIN0)
#define WIN1 WSP(bf16_t, WS_WIN1)
#define WOUT WSP(bf16_t, WS_WOUT)
#define WKV WSP(bf16_t, WS_WKV)
#define GRP WSP(bf16_t, WS_GRP)
#define W2 WSP(bf16_t, WS_W2)
#define RT WSP(bf16_t, WS_RT)
#define GUT WSP(unsigned char, WS_GUT)
#define DOWNT WSP(unsigned char, WS_DOWNT)
#define XB WSP(bf16_t, WS_XB)
#define PROJ WSP(bf16_t, WS_PROJ)
#define POOLED WSP(bf16_t, WS_POOLED)
#define PBUF WSP(bf16_t, WS_PBUF)
#define CONCAT WSP(bf16_t, WS_CONCAT)
#define HIDDEN WSP(unsigned char, WS_HIDDEN)
#define CNTM WSP(int, WS_CNT)
#define TOTALS WSP(int, WS_CNT + 128 * 1024)
#define TOKREC WSP(u32x4, WS_TOKREC)
#define XB8 WSP(unsigned char, WS_XB8)
#define BTO WSP(bf16_t, WS_BTO)
#define GRPW WSP(bf16_t, WS_GRPW)
#define WQN WSP(bf16_t, WS_WQN)
#define WINQ WSP(unsigned char, WS_WINQ)
#define KVN WSP(bf16_t, WS_KMAT)
#define YB0 WSP(unsigned char, WS_PROJ)
#define YB1 WSP(unsigned char, WS_PROJ + 96 * MiB)

#ifndef PHMASK
#define PHMASK 0xffffffffu
#endif
#define IN(k) (((PHMASK >> (((k) < 3) ? (k) : ((k) == 23 ? 13 : 3 + ((k) - 3) % 10))) & 1u) && lo <= (k) && (k) < hi)
#ifndef PROBE_EPI2
#define PROBE_EPI2 false
#endif
#ifndef RMASK
#define RMASK 0u
#endif
#define PHASE(k) if (IN(k)) _Pragma("unroll") for (int rep_ = 0; rep_ < 1 + (int)((RMASK >> (k)) & 1u); ++rep_)
#define REPBAR() do { if (rep_) xcd_barrier(bar); } while (0)
#define SEAM(k) do { if (IN(k) && IN((k) + 1)) xcd_barrier(bar); } while (0)

constexpr int TAIL_PER0 = 4096, TAIL_PER1 = 2048, TAIL_WIN0 = 9, TAIL_WIN1 = 6, TAIL_ITEMS = TAIL_WIN0 * TAIL_PER0 + TAIL_WIN1 * TAIL_PER1;
constexpr int TAIL_HG = TAIL_ITEMS < 32768 ? TAIL_ITEMS : 32768, TAIL_HD = TAIL_ITEMS - TAIL_HG;
#define TAIL_DESC(d_, h_) do { const int hh_ = (h_); if (hh_ < 32768) { const int le_ = 32 + (hh_ >> 10); tr_desc(d_, moe_w_gu + (size_t)le_ * D * D, 2048, 2048, GUT + (size_t)le_ * D * D, norm_ffn_g + D, nullptr, GU_WS, true, hh_ & 1023); } \
        else { const int q_ = hh_ - 32768, le_ = 32 + (q_ >> 9); tr_desc(d_, moe_w_down + (size_t)le_ * DEXP * D, 1024, 2048, DOWNT + (size_t)le_ * DEXP * D, nullptr, nullptr, DN_WS, true, q_ & 511); } } while (0)
#define TAIL_CONVERT(w_) do { if ((l == 0) || (w_) < TAIL_WIN1) { const int tb_ = l == 0 ? (w_) * TAIL_PER0 : TAIL_WIN0 * TAIL_PER0 + (w_) * TAIL_PER1, tn_ = l == 0 ? TAIL_PER0 : TAIL_PER1; \
        __syncthreads(); LAS unsigned* tscr_ = (LAS unsigned*)(F.lds + F.wave * 16384); TrDesc dA_, dB_; f32x4 vA_[16], vB_[16]; \
        for (int j_ = gw; j_ < tn_; j_ += 2 * NGW) { const bool hasB_ = j_ + NGW < tn_; \
            TAIL_DESC(dA_, tb_ + j_); tr_load(dA_, vA_, F.lane); if (hasB_) { TAIL_DESC(dB_, tb_ + j_ + NGW); tr_load(dB_, vB_, F.lane); } \
            tr_finish(dA_, vA_, tscr_, F.lane); if (hasB_) tr_finish(dB_, vB_, tscr_, F.lane); } } } while (0)
template <int l> __device__ __forceinline__ void layer_phases(const Args& args, const Frame& F, const XcdBarrier& bar, unsigned* ctl, const int lo, const int hi, const int gw, const int NGW, const int gt, const int NGT) {
#ifdef LMASK
        if (!((LMASK >> l) & 1)) return;
#endif
        constexpr int pb = 3 + 10 * l;
        const int ldp = l ? 3072 : 2048, qoff = l ? 2048 : 1024;
        float* RS1 = (float*)((char*)RSTD1 + (size_t)l * RSTD_STRIDE); float* P1 = PART1 + (size_t)l * T * 32;
        PHASE(pb + 0) { REPBAR();
            if (l == 0) {
                if (F.G < EARLY_PLAIN_MIN_G)
                { SchedProj S{4, 4, F.G, F.bid, (const char*)XB, (const char*)WIN0, nullptr, (char*)PROJ, (size_t)256 * 2048 * 2, nullptr, 4096};
                  LAS float* rtab = (LAS float*)(F.scr + SCR_IDX); proj_fill_rstd<0>(S, RSTD0, rtab); EpiProj<0> E{2048, RSTD0, nullptr, 4, rtab, 1.f};
                  pg8::gemm_phase<EpiProj<0>, SchedProj, false>(F.lds, F.scr, 2048, 4096u, 4096u, (size_t)128 * 4096, S, E); }
                const bool early = F.G >= EARLY_PLAIN_MIN_G, poolfirst = early && (F.bid & 1);
                if (poolfirst) {
                for (int it = gt; it < (T / 32) * 128; it += NGT) {
                    const int chunk = it & 127, rb = it >> 7, c0 = chunk * 8, g = c0 >> 8, w = 2 << g, t0 = rb * 32, tl0 = t0 & (SEQ - 1);
                    const bf16_t* pp = PROJ + (size_t)t0 * 2048 + c0; bf16_t* op = CONCAT + (size_t)t0 * 1536 + c0; float s[8];
#pragma unroll
                    for (int j = 0; j < 8; ++j) s[j] = 0.f;
                    for (int j = 1; j < w; ++j) if (tl0 - j >= 0) { const u32x4 v = *(const u32x4*)(pp - (size_t)j * 2048);
                        s[0] += bflo(v.x); s[1] += bfhi(v.x); s[2] += bflo(v.y); s[3] += bfhi(v.y); s[4] += bflo(v.z); s[5] += bfhi(v.z); s[6] += bflo(v.w); s[7] += bfhi(v.w); }
#pragma unroll 8
                    for (int r = 0; r < 32; ++r) { const int tl = tl0 + r; const u32x4 v = *(const u32x4*)(pp + (size_t)r * 2048); float p[8] = {bflo(v.x), bfhi(v.x), bflo(v.y), bfhi(v.y), bflo(v.z), bfhi(v.z), bflo(v.w), bfhi(v.w)};
                        const float inv = 1.0f / (float)(tl + 1 < w ? tl + 1 : w); float o[8];
#pragma unroll
                        for (int j = 0; j < 8; ++j) { s[j] += p[j]; o[j] = s[j] * inv - p[j]; }
                        u32x4 ow; ow.x = pk2(o[0], o[1]); ow.y = pk2(o[2], o[3]); ow.z = pk2(o[4], o[5]); ow.w = pk2(o[6], o[7]); *(u32x4*)(op + (size_t)r * 1536) = ow;
                        if (tl - (w - 1) >= 0) { const u32x4 q = *(const u32x4*)(pp + (size_t)(r - (w - 1)) * 2048);
                            s[0] -= bflo(q.x); s[1] -= bfhi(q.x); s[2] -= bflo(q.y); s[3] -= bfhi(q.y); s[4] -= bflo(q.z); s[5] -= bfhi(q.z); s[6] -= bflo(q.w); s[7] -= bfhi(q.w); } }
                }
                                }
                { SchedProj S{4, 0, F.G, F.bid, (const char*)XB8, nullptr, (const char*)WINQ, nullptr, 0, (char*)CONCAT};
                  LAS float* rtab = (LAS float*)(F.scr + SCR_IDX); proj_fill_rstd<0>(S, RSTD0, rtab); EpiScore<0> E{rtab};
                  pg8::gemm_phase<EpiScore<0>, SchedProj, false, true>(F.lds, F.scr, 1024, 2048u, 2048u, (size_t)128 * 2048, S, E); }
                if (early && !poolfirst) {
                for (int it = gt; it < (T / 32) * 128; it += NGT) {
                    const int chunk = it & 127, rb = it >> 7, c0 = chunk * 8, g = c0 >> 8, w = 2 << g, t0 = rb * 32, tl0 = t0 & (SEQ - 1);
                    const bf16_t* pp = PROJ + (size_t)t0 * 2048 + c0; bf16_t* op = CONCAT + (size_t)t0 * 1536 + c0; float s[8];
#pragma unroll
                    for (int j = 0; j < 8; ++j) s[j] = 0.f;
                    for (int j = 1; j < w; ++j) if (tl0 - j >= 0) { const u32x4 v = *(const u32x4*)(pp - (size_t)j * 2048);
                        s[0] += bflo(v.x); s[1] += bfhi(v.x); s[2] += bflo(v.y); s[3] += bfhi(v.y); s[4] += bflo(v.z); s[5] += bfhi(v.z); s[6] += bflo(v.w); s[7] += bfhi(v.w); }
#pragma unroll 8
                    for (int r = 0; r < 32; ++r) { const int tl = tl0 + r; const u32x4 v = *(const u32x4*)(pp + (size_t)r * 2048); float p[8] = {bflo(v.x), bfhi(v.x), bflo(v.y), bfhi(v.y), bflo(v.z), bfhi(v.z), bflo(v.w), bfhi(v.w)};
                        const float inv = 1.0f / (float)(tl + 1 < w ? tl + 1 : w); float o[8];
#pragma unroll
                        for (int j = 0; j < 8; ++j) { s[j] += p[j]; o[j] = s[j] * inv - p[j]; }
                        u32x4 ow; ow.x = pk2(o[0], o[1]); ow.y = pk2(o[2], o[3]); ow.z = pk2(o[4], o[5]); ow.w = pk2(o[6], o[7]); *(u32x4*)(op + (size_t)r * 1536) = ow;
                        if (tl - (w - 1) >= 0) { const u32x4 q = *(const u32x4*)(pp + (size_t)(r - (w - 1)) * 2048);
                            s[0] -= bflo(q.x); s[1] -= bfhi(q.x); s[2] -= bflo(q.y); s[3] -= bfhi(q.y); s[4] -= bflo(q.z); s[5] -= bfhi(q.z); s[6] -= bflo(q.w); s[7] -= bfhi(q.w); } }
                }
                                }
            } else {
                { SchedProj S{8, 8, F.G, F.bid, (const char*)XB8, (const char*)WIN1, nullptr, (char*)PROJ, (size_t)256 * 3072 * 2, nullptr, 2048};
                  LAS float* rtab = (LAS float*)(F.scr + SCR_IDX); proj_fill_rstd<1>(S, PART2, rtab); EpiProj<1> E{3072, PART2, SSQV, 8, rtab, 1.f / WIN_S};
                  pg8::gemm_phase<EpiProj<1>, SchedProj, false, true>(F.lds, F.scr, 1024, 2048u, 2048u, (size_t)128 * 2048, S, E); }
            }
            TAIL_CONVERT(0);
        }
        SEAM(pb + 0);
        PHASE(pb + 1) { REPBAR();
            if (l == 0) {
                if (F.G < EARLY_PLAIN_MIN_G) {
                for (int it = gt; it < (T / 32) * 128; it += NGT) {
                    const int chunk = it & 127, rb = it >> 7, c0 = chunk * 8, g = c0 >> 8, w = 2 << g, t0 = rb * 32, tl0 = t0 & (SEQ - 1);
                    const bf16_t* pp = PROJ + (size_t)t0 * 2048 + c0; bf16_t* op = CONCAT + (size_t)t0 * 1536 + c0; float s[8];
#pragma unroll
                    for (int j = 0; j < 8; ++j) s[j] = 0.f;
                    for (int j = 1; j < w; ++j) if (tl0 - j >= 0) { const u32x4 v = *(const u32x4*)(pp - (size_t)j * 2048);
                        s[0] += bflo(v.x); s[1] += bfhi(v.x); s[2] += bflo(v.y); s[3] += bfhi(v.y); s[4] += bflo(v.z); s[5] += bfhi(v.z); s[6] += bflo(v.w); s[7] += bfhi(v.w); }
#pragma unroll 8
                    for (int r = 0; r < 32; ++r) { const int tl = tl0 + r; const u32x4 v = *(const u32x4*)(pp + (size_t)r * 2048); float p[8] = {bflo(v.x), bfhi(v.x), bflo(v.y), bfhi(v.y), bflo(v.z), bfhi(v.z), bflo(v.w), bfhi(v.w)};
                        const float inv = 1.0f / (float)(tl + 1 < w ? tl + 1 : w); float o[8];
#pragma unroll
                        for (int j = 0; j < 8; ++j) { s[j] += p[j]; o[j] = s[j] * inv - p[j]; }
                        u32x4 ow; ow.x = pk2(o[0], o[1]); ow.y = pk2(o[2], o[3]); ow.z = pk2(o[4], o[5]); ow.w = pk2(o[6], o[7]); *(u32x4*)(op + (size_t)r * 1536) = ow;
                        if (tl - (w - 1) >= 0) { const u32x4 q = *(const u32x4*)(pp + (size_t)(r - (w - 1)) * 2048);
                            s[0] -= bflo(q.x); s[1] -= bfhi(q.x); s[2] -= bflo(q.y); s[3] -= bfhi(q.y); s[4] -= bflo(q.z); s[5] -= bfhi(q.z); s[6] -= bflo(q.w); s[7] -= bfhi(q.w); } }
                }
                }
            } else {
                const bool sfirst = !(F.bid & 1);
                if (sfirst) {
                { SchedProj S{4, 0, F.G, F.bid, (const char*)XB8, nullptr, (const char*)(WINQ + (size_t)2 * 1024 * D), nullptr, 0, (char*)CONCAT};
                  LAS float* rtab = (LAS float*)(F.scr + SCR_IDX); proj_fill_rstd<1>(S, PART2, rtab); EpiScore<1> E{rtab};
                  pg8::gemm_phase<EpiScore<1>, SchedProj, false, true>(F.lds, F.scr, 1024, 2048u, 2048u, (size_t)128 * 2048, S, E); }
                  __syncthreads(); }
                pg8::SchedGrid S{T / 256, 4, F.G, F.bid, (const char*)W2, 0, (size_t)256 * 512, (const char*)POOLED, 0, (size_t)256 * 512, (char*)CONCAT + 1024, (size_t)256 * 3072, 256};
                SchedSp S2{S};
                LAS bf16_t* Ts = (LAS bf16_t*)F.lds; LAS float* rsv = (LAS float*)(F.lds + 128 * 264 * 2);
                Unit uu;
                for (int it = 0; S2.next(it >> 1, uu); ++it) { const int win = uu.pm, g = uu.pn, half = it & 1;
                    if (F.tid < 256) { const f32x4* pp = (const f32x4*)(SSQV + (size_t)(win * 256 + F.tid) * 16); const f32x4 a = pp[0], b = pp[1], c = pp[2], d = pp[3];
                        const float s = ((a[0] + a[1]) + (a[2] + a[3])) + ((b[0] + b[1]) + (b[2] + b[3])) + ((c[0] + c[1]) + (c[2] + c[3])) + ((d[0] + d[1]) + (d[2] + d[3]));
                        rsv[F.tid] = __builtin_amdgcn_rsqf(s * (1.0f / 1024.0f) + EPS); }
                    __syncthreads();
                    { const int r8 = F.tid >> 4, ch = F.tid & 15, cg = g * 256 + half * 128 + ch * 8; float ng[8];
#pragma unroll
                      for (int j = 0; j < 8; ++j) ng[j] = sgu_norm_g[cg + j];
#pragma unroll
                      for (int st = 0; st < 8; ++st) { const int s = st * 32 + r8; const u32x4 v = *(const u32x4*)(PROJ + (size_t)(win * 256 + s) * 3072 + 1024 + cg); const float rs = rsv[s];
                          const float p[8] = {bflo(v.x), bfhi(v.x), bflo(v.y), bfhi(v.y), bflo(v.z), bfhi(v.z), bflo(v.w), bfhi(v.w)};
#pragma unroll
                          for (int j = 0; j < 8; ++j) Ts[(ch * 8 + j) * 264 + s] = (bf16_t)f2bf(p[j] * rs * ng[j]); } }
                    __syncthreads();
                    { const int c = F.tid >> 5, sc = F.tid & 31; bf16_t* ob = POOLED + ((size_t)(win * 4 + g) * 256 + half * 128) * 256;
#pragma unroll
                      for (int st = 0; st < 8; ++st) { const int cc = st * 16 + c; *(u32x4*)(ob + (size_t)cc * 256 + sc * 8) = *(const LAS u32x4*)(Ts + cc * 264 + sc * 8); } }
                    __syncthreads();
                }
                __syncthreads();
                EpiSpatial E{PROJ, sgu_b_s};
                pg8::gemm_phase<EpiSpatial, SchedSp, false>(F.lds, F.scr, 256, 512u, 512u, (size_t)128 * 512, S2, E);
                if (!sfirst) {
                { SchedProj S{4, 0, F.G, F.bid, (const char*)XB8, nullptr, (const char*)(WINQ + (size_t)2 * 1024 * D), nullptr, 0, (char*)CONCAT};
                  LAS float* rtab = (LAS float*)(F.scr + SCR_IDX); proj_fill_rstd<1>(S, PART2, rtab); EpiScore<1> E{rtab};
                  pg8::gemm_phase<EpiScore<1>, SchedProj, false, true>(F.lds, F.scr, 1024, 2048u, 2048u, (size_t)128 * 2048, S, E); }
                }
            }
            if (!(l == 0 && F.G >= EARLY_PLAIN_MIN_G)) TAIL_CONVERT(1);
        }
        if (!(l == 0 && F.G >= EARLY_PLAIN_MIN_G)) SEAM(pb + 1);
        PHASE(pb + 3) { REPBAR();
            pg8::SchedGrid S{T / 256, 8, F.G, F.bid, (const char*)CONCAT + (l ? 1024 : 0), (size_t)256 * 3072, 0, (const char*)(BTO + (size_t)l * 2 * (2048 * 1536)) + (l ? 1024 : 0), (size_t)2048 * 3072, (size_t)256 * 3072, (char*)XB, (size_t)256 * 4096, 512};
            EpiOut E{P1, XB8, rep_ ? 0.f : 1.0f / F_S};
            if constexpr (l == 1) pg8::gemm_phase<EpiOut, pg8::SchedGrid, false, true>(F.lds, F.scr, 1024, 3072u, 3072u, (size_t)128 * 3072, S, E);
            else pg8::gemm_phase<EpiOut, pg8::SchedGrid, false, false, false, false, 16>(F.lds, F.scr, 1536, 3072u, 3072u, (size_t)128 * 3072, S, E);
            TAIL_CONVERT(2);
        }
        SEAM(pb + 3);
        PHASE(pb + 4) { REPBAR();
            pg8::SchedGrid S{T / 256, 2, F.G, F.bid, (const char*)XB, (size_t)256 * 4096, 2048, (const char*)(RT + (size_t)l * 256 * 2048), 0, 2048, (char*)LOGITS, 0, 0};
            EpiRoute E{LOGITS};
            pg8::gemm_phase<EpiRoute, pg8::SchedGrid, false>(F.lds, F.scr, 1024, 4096u, 4096u, (size_t)128 * 4096, S, E);
            TAIL_CONVERT(3);
        }
        SEAM(pb + 4);
        PHASE(pb + 5) { REPBAR();
            LAS int* hc = (LAS int*)(F.scr + SCR_TAB);
            for (int t0 = F.bid * 128; t0 < T; t0 += F.G * 128) {
                if (F.tid < 64) hc[F.tid] = 0;
                __syncthreads();
                const int t = t0 + F.tid;
                if (F.tid < 128) {
                    const f32x4* pp = (const f32x4*)(P1 + (size_t)t * 8); const f32x4 pa = pp[0], pb_ = pp[1]; const float s = ((pa[0] + pa[1]) + (pa[2] + pa[3])) + ((pb_[0] + pb_[1]) + (pb_[2] + pb_[3]));
                    const float rstd = __builtin_amdgcn_rsqf(s * (1.0f / D) + EPS); RS1[t] = rstd;
                    const float* la = LOGITS + (size_t)t * 64; const float* lb = la + (size_t)T * 64;
                    float gl[4]; int gi = 0;
#pragma unroll
                    for (int j = 0; j < 4; ++j) gl[j] = (la[j] + lb[j]) * rstd + moe_b_group[l * 4 + j];
#pragma unroll
                    for (int j = 1; j < 4; ++j) if (gl[j] > gl[gi]) gi = j;
                    float gs = 0.f;
#pragma unroll
                    for (int j = 0; j < 4; ++j) gs += __expf(gl[j] - gl[gi]);
                    const float pg = 1.0f / gs;
                    float el[8];
#pragma unroll
                    for (int j = 0; j < 8; ++j) el[j] = (la[4 + gi * 8 + j] + lb[4 + gi * 8 + j]) * rstd + moe_b_expert[l * 32 + gi * 8 + j];
                    int i0 = 0;
#pragma unroll
                    for (int j = 1; j < 8; ++j) if (el[j] > el[i0]) i0 = j;
                    int i1 = (i0 == 0) ? 1 : 0;
#pragma unroll
                    for (int j = 0; j < 8; ++j) if (j != i0 && el[j] > el[i1]) i1 = j;
                    const float x1 = __expf(el[i1] - el[i0]); const float tp0 = 1.0f / (1.0f + x1), tp1 = x1 / (1.0f + x1);
                    const int e0 = gi * 8 + i0, e1 = gi * 8 + i1;
                    const int r0 = __hip_atomic_fetch_add(&hc[e0], 1, __ATOMIC_RELAXED, __HIP_MEMORY_SCOPE_WORKGROUP), r1 = __hip_atomic_fetch_add(&hc[32 + e1], 1, __ATOMIC_RELAXED, __HIP_MEMORY_SCOPE_WORKGROUP);
                    u32x4 rec; rec.x = (unsigned)e0 | ((unsigned)e1 << 8) | ((unsigned)r0 << 16) | ((unsigned)r1 << 24); rec.y = __float_as_uint(pg * tp0); rec.z = __float_as_uint(pg * tp1); rec.w = 0u;
                    TOKREC[t] = rec;
                }
                __syncthreads();
                if (F.tid < 64) CNTM[(t0 >> 7) * 64 + F.tid] = hc[F.tid];
                __syncthreads();
            }
            TAIL_CONVERT(4);
        }
        SEAM(pb + 5);
        PHASE(pb + 6) { REPBAR();
            LAS int* ps = (LAS int*)(F.scr + SCR_IDX);
            LAS int* hb = (LAS int*)(F.scr + SCR_TAB);
            for (int t0 = F.bid * 128; t0 < T; t0 += F.G * 128) {
                const int blk = t0 >> 7, li = F.tid & 63, part = F.tid >> 6; int full = 0, upto = 0;
                for (int w = part * 32; w < part * 32 + 32; ++w) { const int c = CNTM[w * 64 + li]; full += c; upto += (w < blk) ? c : 0; }
                ps[part * 64 + li] = full; ps[512 + part * 64 + li] = upto;
                __syncthreads();
                if (F.tid < 64) { int base = 0, tot = 0;
#pragma unroll
                    for (int p = 0; p < 8; ++p) { tot += ps[p * 64 + F.tid]; base += ps[512 + p * 64 + F.tid]; }
                    hb[F.tid] = base; if (blk == 0) TOTALS[l * 64 + F.tid] = tot; }
                __syncthreads();
                if (F.tid < 128) { const int t = t0 + F.tid; const u32x4 rec = TOKREC[t]; const int e0 = rec.x & 255, e1 = (rec.x >> 8) & 255, r0 = (rec.x >> 16) & 255, r1 = rec.x >> 24;
                    const int p0 = hb[e0] + r0, p1 = hb[32 + e1] + r1;
                    LIST[(size_t)e0 * T + p0] = t; GATEW[(size_t)e0 * T + p0] = __uint_as_float(rec.y); LIST[(size_t)(32 + e1) * T + p1] = t; GATEW[(size_t)(32 + e1) * T + p1] = __uint_as_float(rec.z); }
                __syncthreads();
            }
            TAIL_CONVERT(5);
        }
        SEAM(pb + 6);
        { constexpr int ph = 0;
            if (!(l == 1 && ph == 2)) PHASE(pb + 7 + ph) { REPBAR();
                LAS int* cnt = (LAS int*)(F.scr + SCR_TAB); LAS int* pre = cnt + 64; LAS int* preB = cnt + 130; LAS int* preS = cnt + 196; LAS int* idx = (LAS int*)(F.scr + SCR_IDX);
                SchedMoe S; S.pre = pre; S.cnt = cnt; S.idx = idx; S.preB = preB; S.preS = preS; S.G = F.G; S.c = F.bid; S.ul = cnt + 264; S.nmy = 0; S.perm = 0;
                if (ph == 0) { S.lo = 0; S.hi = 64; S.mode = 0; S.perm = 1; S.A0 = (const char*)XB8; S.B0 = (const char*)(GUT + (size_t)l * 32 * D * D); S.C0 = (char*)HIDDEN; }
                else { S.lo = (ph == 1) ? 0 : 32; S.hi = (ph == 1 && l == 0) ? 32 : 64; S.mode = 1; S.perm = (ph == 1 && l == 1) ? 1 : 0; S.A0 = (const char*)HIDDEN; S.B0 = (const char*)(DOWNT + (size_t)l * 32 * DEXP * D); S.C0 = nullptr; }
                if (ph == 0) {
                    moe_setup<0>(S, TOTALS + l * 64, LIST, RS1);
                    EpiGu E{RS1, idx};
                    pg8::gemm_phase<EpiGu, SchedMoe, true, true, true>(F.lds, F.scr, 1024, 2048u, 2048u, (size_t)1024 * 2048, S, E);
                } else if (ph == 1) {
                    moe_setup<1>(S, TOTALS + l * 64, LIST, GATEW);
                    EpiDown<0> E{XB, YB0, YB1, idx, nullptr, 1.0f / (HID_S * DN_WS), 0.f, nullptr};
                    pg8::gemm_phase<EpiDown<0>, SchedMoe, false, true, true>(F.lds, F.scr, 512, 1024u, 1024u, (size_t)128 * 1024, S, E);
                } else {
                    moe_setup<1>(S, TOTALS + l * 64, LIST, GATEW);
                    EpiDown<1> E{XB, YB0, YB1, idx, PART2, rep_ ? 0.f : 1.0f / (HID_S * DN_WS), rep_ ? 0.f : 1.0f / Y_S, XB8};
                    pg8::gemm_phase<EpiDown<1>, SchedMoe, false, true, true>(F.lds, F.scr, 512, 1024u, 1024u, (size_t)128 * 1024, S, E);
                }
                __syncthreads();
                TAIL_CONVERT(6 + ph);
            }
            if (!(l == 1 && ph == 2)) SEAM(pb + 7 + ph);
        }
        { constexpr int ph = 1;
            if (!(l == 1 && ph == 2)) PHASE(pb + 7 + ph) { REPBAR();
                LAS int* cnt = (LAS int*)(F.scr + SCR_TAB); LAS int* pre = cnt + 64; LAS int* preB = cnt + 130; LAS int* preS = cnt + 196; LAS int* idx = (LAS int*)(F.scr + SCR_IDX);
                SchedMoe S; S.pre = pre; S.cnt = cnt; S.idx = idx; S.preB = preB; S.preS = preS; S.G = F.G; S.c = F.bid; S.ul = cnt + 264; S.nmy = 0; S.perm = 0;
                if (ph == 0) { S.lo = 0; S.hi = 64; S.mode = 0; S.perm = 1; S.A0 = (const char*)XB8; S.B0 = (const char*)(GUT + (size_t)l * 32 * D * D); S.C0 = (char*)HIDDEN; }
                else { S.lo = (ph == 1) ? 0 : 32; S.hi = (ph == 1 && l == 0) ? 32 : 64; S.mode = 1; S.perm = (ph == 1 && l == 1) ? 1 : 0; S.A0 = (const char*)HIDDEN; S.B0 = (const char*)(DOWNT + (size_t)l * 32 * DEXP * D); S.C0 = nullptr; }
                if (ph == 0) {
                    moe_setup<0>(S, TOTALS + l * 64, LIST, RS1);
                    EpiGu E{RS1, idx};
                    pg8::gemm_phase<EpiGu, SchedMoe, true, true, true>(F.lds, F.scr, 1024, 2048u, 2048u, (size_t)1024 * 2048, S, E);
                } else if (ph == 1) {
                    moe_setup<1>(S, TOTALS + l * 64, LIST, GATEW);
                    EpiDown<0> E{XB, YB0, YB1, idx, nullptr, 1.0f / (HID_S * DN_WS), 0.f, nullptr};
                    pg8::gemm_phase<EpiDown<0>, SchedMoe, false, true, true>(F.lds, F.scr, 512, 1024u, 1024u, (size_t)128 * 1024, S, E);
                } else {
                    moe_setup<1>(S, TOTALS + l * 64, LIST, GATEW);
                    EpiDown<1> E{XB, YB0, YB1, idx, PART2, rep_ ? 0.f : 1.0f / (HID_S * DN_WS), rep_ ? 0.f : 1.0f / Y_S, XB8};
                    pg8::gemm_phase<EpiDown<1>, SchedMoe, false, true, true>(F.lds, F.scr, 512, 1024u, 1024u, (size_t)128 * 1024, S, E);
                }
                __syncthreads();
                TAIL_CONVERT(6 + ph);
            }
            if (!(l == 1 && ph == 2)) SEAM(pb + 7 + ph);
        }
        { constexpr int ph = 2;
            if (!(l == 1 && ph == 2)) PHASE(pb + 7 + ph) { REPBAR();
                LAS int* cnt = (LAS int*)(F.scr + SCR_TAB); LAS int* pre = cnt + 64; LAS int* preB = cnt + 130; LAS int* preS = cnt + 196; LAS int* idx = (LAS int*)(F.scr + SCR_IDX);
                SchedMoe S; S.pre = pre; S.cnt = cnt; S.idx = idx; S.preB = preB; S.preS = preS; S.G = F.G; S.c = F.bid; S.ul = cnt + 264; S.nmy = 0; S.perm = 0;
                if (ph == 0) { S.lo = 0; S.hi = 64; S.mode = 0; S.perm = 1; S.A0 = (const char*)XB8; S.B0 = (const char*)(GUT + (size_t)l * 32 * D * D); S.C0 = (char*)HIDDEN; }
                else { S.lo = (ph == 1) ? 0 : 32; S.hi = (ph == 1 && l == 0) ? 32 : 64; S.mode = 1; S.perm = (ph == 1 && l == 1) ? 1 : 0; S.A0 = (const char*)HIDDEN; S.B0 = (const char*)(DOWNT + (size_t)l * 32 * DEXP * D); S.C0 = nullptr; }
                if (ph == 0) {
                    moe_setup<0>(S, TOTALS + l * 64, LIST, RS1);
                    EpiGu E{RS1, idx};
                    pg8::gemm_phase<EpiGu, SchedMoe, true, true, true>(F.lds, F.scr, 1024, 2048u, 2048u, (size_t)1024 * 2048, S, E);
                } else if (ph == 1) {
                    moe_setup<1>(S, TOTALS + l * 64, LIST, GATEW);
                    EpiDown<0> E{XB, YB0, YB1, idx, nullptr, 1.0f / (HID_S * DN_WS), 0.f, nullptr};
                    pg8::gemm_phase<EpiDown<0>, SchedMoe, false, true, true>(F.lds, F.scr, 512, 1024u, 1024u, (size_t)128 * 1024, S, E);
                } else {
                    moe_setup<1>(S, TOTALS + l * 64, LIST, GATEW);
                    EpiDown<1> E{XB, YB0, YB1, idx, PART2, rep_ ? 0.f : 1.0f / (HID_S * DN_WS), rep_ ? 0.f : 1.0f / Y_S, XB8};
                    pg8::gemm_phase<EpiDown<1>, SchedMoe, false, true, true>(F.lds, F.scr, 512, 1024u, 1024u, (size_t)128 * 1024, S, E);
                }
                __syncthreads();
                TAIL_CONVERT(6 + ph);
            }
            if (!(l == 1 && ph == 2)) SEAM(pb + 7 + ph);
        }
}
__global__ void __launch_bounds__(NWAVES * 64, 2) fwd(Args args) {
    extern __shared__ __attribute__((aligned(16))) unsigned char lds_raw[];
    Frame F; F.lds = (LAS unsigned char*)lds_raw; F.scr = F.lds + SCR_OFF;
    F.tid = threadIdx.x; F.lane = F.tid & 63; F.wave = rfl(F.tid >> 6); F.G = gridDim.x; F.bid = blockIdx.x;
    volatile LAS unsigned* MISC = (volatile LAS unsigned*)(F.lds + MISC_OFF);
    unsigned* ctl = (unsigned*)(args.ws + WS_CTL);
    if (F.tid < 32) MISC[F.tid] = 0u;
    __syncthreads();
    XcdBarrier bar; bar.bar = ctl + CW_BAR; bar.x = 0; bar.st = nullptr;
    if (!MK_PER_PHASE) bar = xcd_barrier_post(ctl + CW_BAR, MISC + 8);
    const int lo = args.ph_lo, hi = args.ph_hi;

    const int gw = F.bid * NWAVES + F.wave, NGW = F.G * NWAVES;
    const int gt = F.bid * (NWAVES * 64) + F.tid, NGT = F.G * NWAVES * 64;
    constexpr int I_SQ = (2048 / 64) * (2048 / 64), I_IN1 = (2048 / 64) * (3072 / 64), I_DN = (1024 / 64) * (2048 / 64);
    constexpr int NSMALL = I_SQ + I_IN1 + 2 * I_SQ + 2 * I_SQ;
    PHASE(0) { REPBAR();
        LAS unsigned* scr = (LAS unsigned*)(F.lds + F.wave * 16384);
        for (int m = gw; m < T; m += NGW) {
            const f32x4* xr = (const f32x4*)(x_in + (size_t)m * D) + F.lane * 2; unsigned* o = (unsigned*)(XB + (size_t)m * D) + F.lane * 4; float s = 0.f;
#pragma unroll
            for (int j = 0; j < 4; ++j) { const f32x4 a = xr[128 * j], b = xr[128 * j + 1]; u32x4 w; w.x = pk2(a[0], a[1]); w.y = pk2(a[2], a[3]); w.z = pk2(b[0], b[1]); w.w = pk2(b[2], b[3]);
                const float a0 = bflo(w.x), a1 = bfhi(w.x), a2 = bflo(w.y), a3 = bfhi(w.y), a4 = bflo(w.z), a5 = bfhi(w.z), a6 = bflo(w.w), a7 = bfhi(w.w);
                s += (a0 * a0 + a1 * a1) + (a2 * a2 + a3 * a3) + (a4 * a4 + a5 * a5) + (a6 * a6 + a7 * a7);
                u32x2 w8; w8.x = pk4_fp8(a0, a1, a2, a3); w8.y = pk4_fp8(a4, a5, a6, a7); *(u32x2*)(XB8 + (size_t)m * D + 512 * j + 8 * F.lane) = w8;
                *(u32x4*)(o + 256 * j) = w; }
            s = wave_sum(s); if (F.lane == 0) RSTD0[m] = __builtin_amdgcn_rsqf(s * (1.0f / D) + EPS);
        }
        if (gt < D / 2) ((unsigned*)(XB + (size_t)T * D))[gt] = 0u;
        if (gt < D / 4) ((unsigned*)(XB8 + (size_t)T * D))[gt] = 0u;
        if (gt == 0) { RSTD0[T] = 0.f; RSTD1[T] = 0.f; ((float*)((char*)RSTD1 + RSTD_STRIDE))[T] = 0.f; }
        for (int m = gw; m < 2 * 512; m += NGW) { const int l = m >> 9, r = m & 511;
            const f32x4* xr = (const f32x4*)(mem_in + (size_t)r * D) + F.lane * 2; const f32x4* gr = (const f32x4*)(norm_mem_g + (size_t)l * D) + F.lane * 2; f32x4 a[4], b[4]; float s = 0.f;
#pragma unroll
            for (int j = 0; j < 4; ++j) { a[j] = xr[128 * j]; b[j] = xr[128 * j + 1]; s += (a[j][0] * a[j][0] + a[j][1] * a[j][1]) + (a[j][2] * a[j][2] + a[j][3] * a[j][3]) + (b[j][0] * b[j][0] + b[j][1] * b[j][1]) + (b[j][2] * b[j][2] + b[j][3] * b[j][3]); }
            const float rstd = __builtin_amdgcn_rsqf(wave_sum(s) * (1.0f / D) + EPS); unsigned* o = (unsigned*)(MEMN + (size_t)m * D) + F.lane * 4;
#pragma unroll
            for (int j = 0; j < 4; ++j) { const f32x4 ga = gr[128 * j], gb = gr[128 * j + 1]; u32x4 w; w.x = pk2(a[j][0] * rstd * ga[0], a[j][1] * rstd * ga[1]); w.y = pk2(a[j][2] * rstd * ga[2], a[j][3] * rstd * ga[3]);
                w.z = pk2(b[j][0] * rstd * gb[0], b[j][1] * rstd * gb[1]); w.w = pk2(b[j][2] * rstd * gb[2], b[j][3] * rstd * gb[3]); *(u32x4*)(o + 256 * j) = w; }
        }
        for (int i = gt; i < 2 * 256 * 2048; i += NGT) { const int l = i >> 19, n = (i >> 11) & 255, k = i & 2047, j = n & 127; float w = 0.f;
            if (j < 4) w = moe_w_group[((size_t)l * D + k) * 4 + j]; else if (j < 36) w = moe_w_expert[((size_t)l * D + k) * 32 + (j - 4)];
            w *= norm_ffn_g[l * D + k]; const unsigned hi16 = f2bf(w); const float lof = w - __uint_as_float(hi16 << 16);
            RT[i] = (bf16_t)(n < 128 ? hi16 : f2bf(lof)); }
        for (int i = gt; i < 4 * 256 * 256; i += NGT) { const int g = i >> 16, t = (i >> 8) & 255, s = i & 255; float w = 0.f;
            if ((t >> 7) == (s >> 7) && (s & 127) <= (t & 127)) w = sgu_w_s[((size_t)g * 128 + (t & 127)) * 128 + (s & 127)];
            W2[i] = (bf16_t)f2bf(w); }
        for (int i = gt; i < 2 * 2048 * 256; i += NGT) { const int l = i >> 19, kk = (i >> 8) & 2047, c4 = (i & 255) * 4;
            const float* src = l ? sgu_w_in + (size_t)kk * 3072 + 2048 + c4 : pool_w_in + (size_t)kk * 2048 + 1024 + c4; const f32x4 w = *(const f32x4*)src; const float gs = norm_mix_g[l * D + kk] * 0.0625f;
            u32x2 o; o.x = pk2(w[0] * gs, w[1] * gs); o.y = pk2(w[2] * gs, w[3] * gs); *(u32x2*)(WQN + (size_t)l * D * D + (size_t)kk * D + c4) = o; }
        for (int i = gt; i < 4 * 256 * 256; i += NGT) { const int g = i >> 16, c = (i >> 8) & 255, d = i & 255; GRPW[(size_t)c * 2048 + g * 256 + d] = (bf16_t)f2bf(pool_w_grp[i] * pool_scale[g * 256 + d]); }
#define TR_DECODE(d, it_) do { int r = (it_); \
            if (r < I_SQ) { tr_desc(d, pool_w_in, 2048, 2048, WIN0, norm_mix_g, nullptr, 1.f, false, r); break; } r -= I_SQ; \
            if (r < I_IN1) { tr_desc(d, sgu_w_in, 2048, 3072, WIN1, norm_mix_g + D, nullptr, WIN_S, true, r); break; } r -= I_IN1; \
            if (r < 2 * I_SQ) { const int l_ = r / I_SQ; tr_desc(d, l_ ? sgu_w_out : pool_w_out, 2048, 2048, WOUT + (size_t)l_ * D * D, nullptr, nullptr, 1.f, false, r % I_SQ); break; } r -= 2 * I_SQ; \
            if (r < 2 * I_SQ) { const int l_ = r / I_SQ; tr_desc(d, xa_w_kv + (size_t)l_ * D * D, 2048, 2048, WKV + (size_t)l_ * D * D, nullptr, nullptr, 1.f, false, r % I_SQ); break; } r -= 2 * I_SQ; \
            if (r >= 32 * I_SQ) { r += TAIL_HG; if (r >= 64 * I_SQ + 32 * I_DN) r += TAIL_HD; }     \
            if (r < 64 * I_SQ) { const int le = r / I_SQ; tr_desc(d, moe_w_gu + (size_t)le * D * D, 2048, 2048, GUT + (size_t)le * D * D, norm_ffn_g + (le >> 5) * D, nullptr, GU_WS, true, r % I_SQ); break; } r -= 64 * I_SQ; \
            { const int le = r / I_DN; tr_desc(d, moe_w_down + (size_t)le * DEXP * D, 1024, 2048, DOWNT + (size_t)le * DEXP * D, nullptr, nullptr, DN_WS, true, r % I_DN); } } while (0)
#define TR_ID(j) ((j) < nj1 ? id1 + (j) * st1 : id2 + ((j) - nj1) * st2)
#define TR_RUN() do {   \
            TrDesc dA, dB; f32x4 vA[16], vB[16]; const int nj = nj1 + nj2; int j = 0; \
            if (nj > 0) { TR_DECODE(dA, TR_ID(0)); tr_load(dA, vA, F.lane); \
                for (;;) { \
                    const bool hasB = j + 1 < nj; if (hasB) { TR_DECODE(dB, TR_ID(j + 1)); tr_load(dB, vB, F.lane); } \
                    tr_finish(dA, vA, scr, F.lane); \
                    if (!hasB) break; \
                    const bool hasA = j + 2 < nj; if (hasA) { TR_DECODE(dA, TR_ID(j + 2)); tr_load(dA, vA, F.lane); } \
                    tr_finish(dB, vB, scr, F.lane); \
                    if (!hasA) break; \
                    j += 2; \
                } } } while (0)
        {
            const int id1 = gw, st1 = NGW, nj1 = (NSMALL - gw + NGW - 1) / NGW > 0 ? (NSMALL - gw + NGW - 1) / NGW : 0, id2 = 0, st2 = 1, nj2 = 0;
            TR_RUN();
        }
    }
    SEAM(0);
    PHASE(1) { REPBAR();
        {
            SchedKV S{F.G, F.bid, (const char*)MEMN, (const char*)WKV, (char*)KVN};
            EpiPlain E{0, 1.f};
            pg8::gemm_phase<EpiPlain, SchedKV, false>(F.lds, F.scr, 2048, 4096u, 4096u, (size_t)128 * 4096, S, E);
        }
        if (F.G >= EARLY_PLAIN_MIN_G && F.bid >= 32 && F.bid < 160) {
            SchedProj S{4, 4, 128, F.bid - 32, (const char*)XB, (const char*)WIN0, nullptr, (char*)PROJ, (size_t)256 * 2048 * 2, nullptr, 4096};
            LAS float* rtab = (LAS float*)(F.scr + SCR_IDX); proj_fill_rstd<0>(S, RSTD0, rtab); EpiProj<0> E{2048, RSTD0, nullptr, 4, rtab, 1.f};
            pg8::gemm_phase<EpiProj<0>, SchedProj, false>(F.lds, F.scr, 2048, 4096u, 4096u, (size_t)128 * 4096, S, E);
        }
        {
            LAS unsigned* scr = (LAS unsigned*)(F.lds + F.wave * 16384);
            constexpr int NMOE = 64 * I_SQ + 64 * I_DN - TAIL_ITEMS; static_assert(NMOE % 16 == 0 && TAIL_PER0 % 16 == 0, "tickets of 16 items");
            const int NTK = (NMOE + (F.G >= EARLY_PLAIN_MIN_G ? TAIL_PER0 : 0)) / 16;
#define CONV_DESC(d_, it_) do { const int ci_ = (it_); if (ci_ < NMOE) TR_DECODE(d_, NSMALL + ci_); else TAIL_DESC(d_, TAIL_PER0 + ci_ - NMOE); } while (0)
            unsigned* q = ctl + CW_CONVQ; volatile LAS unsigned* tk = MISC + 16; TrDesc dA, dB; f32x4 vA[16], vB[16];
            __syncthreads(); if (F.tid == 0) tk[0] = xb_add(q, 1u); __syncthreads();
            unsigned b = tk[0]; int par = 1;
            while (b < (unsigned)NTK) { unsigned nt = 0u; if (F.tid == 0) nt = xb_add(q, 1u);
                const int iA = (int)b * 16 + F.wave;
                CONV_DESC(dA, iA); tr_load(dA, vA, F.lane); CONV_DESC(dB, iA + 8); tr_load(dB, vB, F.lane);
                tr_finish(dA, vA, scr, F.lane); tr_finish(dB, vB, scr, F.lane);
                if (F.tid == 0) tk[par] = nt; __syncthreads(); b = tk[par]; par ^= 1; }
        }
#undef CONV_DESC
#undef TR_RUN
#undef TR_ID

#undef TR_DECODE
    }
    SEAM(1);
    PHASE(2) { REPBAR();
        for (int i = gt; i < 2 * 2048 * 128; i += NGT) { const int b = i >> 18, n = (i >> 7) & 2047, c = i & 127;
            const u32x4 w = *(const u32x4*)(WOUT + (size_t)D * D + (size_t)n * D + c * 8); u32x4 o;
            u32x2 o8; o8.x = pk4_fp8(bflo(w.x) * WO_S, bfhi(w.x) * WO_S, bflo(w.y) * WO_S, bfhi(w.y) * WO_S); o8.y = pk4_fp8(bflo(w.z) * WO_S, bfhi(w.z) * WO_S, bflo(w.w) * WO_S, bfhi(w.w) * WO_S);
            *(u32x2*)((unsigned char*)(BTO + (size_t)(2 + b) * (2048 * 1536) + (size_t)n * 1536) + 1024 + c * 8) = o8; }
        { SchedFold S{F.G, F.bid, (const char*)WOUT, (const char*)KVN, (const char*)GRPW, (char*)BTO, (const char*)WQN, (char*)WINQ, 0};
          EpiPlain E{0, F_S};
          pg8::gemm_phase<EpiPlain, SchedFold, false>(F.lds, F.scr, 256, 4096u, 4096u, (size_t)128 * 4096, S, E); }
        { SchedFold S{F.G, F.bid, (const char*)WOUT, (const char*)KVN, (const char*)GRPW, (char*)BTO, (const char*)WQN, (char*)WINQ, 1};
          EpiFp8 E{VW_S, 3072, WQ_S, 2048};
          pg8::gemm_phase<EpiFp8, SchedFold, false>(F.lds, F.scr, 256, 4096u, 4096u, (size_t)128 * 4096, S, E); }
    }
    SEAM(2);

    layer_phases<0>(args, F, bar, ctl, lo, hi, gw, NGW, gt, NGT);
    layer_phases<1>(args, F, bar, ctl, lo, hi, gw, NGW, gt, NGT);
    PHASE(23) { REPBAR();
        f32x4 gv[4][2];
#pragma unroll
        for (int j = 0; j < 4; ++j) { gv[j][0] = ((const f32x4*)final_norm_g)[F.lane * 2 + 128 * j]; gv[j][1] = ((const f32x4*)final_norm_g)[F.lane * 2 + 128 * j + 1]; }
        for (int m0 = gw; m0 < T; m0 += 2 * NGW) {
            u32x4 xw[2][4]; u32x2 ya[2][4], yb[2][4]; const int m1 = m0 + NGW; const bool has1 = m1 < T;
#pragma unroll
            for (int rr = 0; rr < 2; ++rr) { const int m = (rr == 0 || has1) ? (rr ? m1 : m0) : m0;
                const u32x4* xr = (const u32x4*)(XB + (size_t)m * D) + F.lane; const u32x2* y0r = (const u32x2*)(YB0 + (size_t)m * D) + F.lane; const u32x2* y1r = (const u32x2*)(YB1 + (size_t)m * D) + F.lane;
#pragma unroll
                for (int j = 0; j < 4; ++j) { xw[rr][j] = xr[64 * j]; ya[rr][j] = y0r[64 * j]; yb[rr][j] = y1r[64 * j]; } }
#pragma unroll
            for (int rr = 0; rr < 2; ++rr) { if (rr == 1 && !has1) break; const int m = rr ? m1 : m0;
                float xv[4][8]; float s = 0.f;
#pragma unroll
                for (int j = 0; j < 4; ++j) { const u32x4 v = xw[rr][j]; float fa[8], fb[8]; fp8x8_to_f32(ya[rr][j], fa); fp8x8_to_f32(yb[rr][j], fb);
                    const float xx[8] = {bflo(v.x), bfhi(v.x), bflo(v.y), bfhi(v.y), bflo(v.z), bfhi(v.z), bflo(v.w), bfhi(v.w)};
#pragma unroll
                    for (int e = 0; e < 8; ++e) { xv[j][e] = xx[e] + (fa[e] + fb[e]) * (1.0f / Y_S); s += xv[j][e] * xv[j][e]; } }
                const float rstd = __builtin_amdgcn_rsqf(wave_sum(s) * (1.0f / D) + EPS);
                f32x4* o = (f32x4*)(args.out + (size_t)m * D) + F.lane * 2;
#pragma unroll
                for (int j = 0; j < 4; ++j) { const f32x4 ga = gv[j][0], gb = gv[j][1];
                    o[128 * j] = (f32x4){xv[j][0] * rstd * ga[0], xv[j][1] * rstd * ga[1], xv[j][2] * rstd * ga[2], xv[j][3] * rstd * ga[3]};
                    o[128 * j + 1] = (f32x4){xv[j][4] * rstd * gb[0], xv[j][5] * rstd * gb[1], xv[j][6] * rstd * gb[2], xv[j][7] * rstd * gb[3]}; } }
        }
    }
#undef IN
#undef SEAM
}

extern "C" void kernel_launch(void* const* d_in, const int* in_sizes, int n_in, void* d_out, int out_size, void* d_ws, size_t ws_size, hipStream_t stream) {
    static int grid = 0;
    if (grid == 0) {
        if (n_in != 22 || out_size != T * D || ws_size < WS_END) { fprintf(stderr, "kernel_launch: unexpected shapes (n_in %d, out %d, ws %zu)\n", n_in, out_size, ws_size); grid = -1; return; }
        int dev = 0, cus = 0, per_cu = 0;
        if (hipGetDevice(&dev) != hipSuccess || hipDeviceGetAttribute(&cus, hipDeviceAttributeMultiprocessorCount, dev) != hipSuccess) { grid = -1; return; }
        if (hipFuncSetAttribute((const void*)fwd, hipFuncAttributeMaxDynamicSharedMemorySize, LDS_BYTES) != hipSuccess) { fprintf(stderr, "kernel_launch: hipFuncSetAttribute failed\n"); grid = -1; return; }
        if (hipOccupancyMaxActiveBlocksPerMultiprocessor(&per_cu, (const void*)fwd, NWAVES * 64, LDS_BYTES) != hipSuccess || per_cu < 1) { fprintf(stderr, "kernel_launch: occupancy query says %d\n", per_cu); }
        (void)hipGetLastError();
        grid = cus;
    }
    if (grid < 0) return;
    (void)hipMemsetAsync((char*)d_ws + WS_CTL, 0, CTL_ZERO_BYTES, stream);
    Args a{};
    for (int i = 0; i < 22; ++i) a.in[i] = (const float*)d_in[i];
    a.out = (float*)d_out; a.ws = (unsigned char*)d_ws;
#if MK_PER_PHASE
    for (int p = 0; p < NPHASE; ++p) { a.ph_lo = p; a.ph_hi = p + 1; hipLaunchKernelGGL(fwd, dim3(grid), dim3(NWAVES * 64), LDS_BYTES, stream, a); }
#else
    a.ph_lo = 0; a.ph_hi = NPHASE; hipLaunchKernelGGL(fwd, dim3(grid), dim3(NWAVES * 64), LDS_BYTES, stream, a);
#endif
}
```

```cpp
#include <hip/hip_runtime.h>
#include <cstdio>
#include <cstdint>

#ifndef MK_PER_PHASE
#define MK_PER_PHASE 0
#endif

#define GAS __attribute__((address_space(1)))
#define LAS __attribute__((address_space(3)))
typedef unsigned short bf16_t;
typedef short bf16x8 __attribute__((ext_vector_type(8)));
typedef float f32x4 __attribute__((ext_vector_type(4)));
typedef float f32x2 __attribute__((ext_vector_type(2)));
typedef unsigned u32x4 __attribute__((ext_vector_type(4)));
typedef unsigned u32x2 __attribute__((ext_vector_type(2)));
typedef int i32x4 __attribute__((ext_vector_type(4)));
typedef int i32x8 __attribute__((ext_vector_type(8)));

constexpr int T = 32768, SEQ = 16384, D = 2048, NMEM = 256, NEXP = 32, DEXP = 1024;
constexpr float EPS = 1e-6f;
constexpr int NWAVES = 8;
constexpr int NPHASE = 24;
constexpr float GU_WS = 64.f, DN_WS = 32.f, HID_S = 8.f, Y_S = 16.f, WQ_S = 64.f, WIN_S = 64.f, MX_S = 8.f, WO_S = 128.f, P_S = 256.f, VW_S = 4.f, F_S = P_S * VW_S;

constexpr size_t MiB = 1u << 20;
constexpr size_t WS_CTL = 0, CTL_ZERO_BYTES = 1 * MiB;
constexpr size_t WS_RSTD = 1 * MiB;
constexpr size_t RSTD_STRIDE = 320 * 1024;
constexpr size_t WS_PART1 = 2 * MiB;
constexpr size_t WS_PART2 = 10 * MiB;
constexpr size_t WS_SSQV = 14 * MiB;
constexpr size_t WS_LOGITS = 16 * MiB;
constexpr size_t WS_LIST = 32 * MiB;
constexpr size_t WS_GATEW = 40 * MiB;
constexpr size_t WS_KMAT = 48 * MiB;
constexpr size_t WS_VT = 50 * MiB;
constexpr size_t WS_MEMN = 52 * MiB;
constexpr size_t WS_WIN0 = 56 * MiB;
constexpr size_t WS_WIN1 = 64 * MiB;
constexpr size_t WS_WOUT = 76 * MiB;
constexpr size_t WS_WKV = 92 * MiB;
constexpr size_t WS_GRP = 108 * MiB;
constexpr size_t WS_W2 = 109 * MiB;
constexpr size_t WS_CNT = 108 * MiB + 512 * 1024;
constexpr size_t WS_TOKREC = 109 * MiB + 512 * 1024;
constexpr size_t WS_RT = 110 * MiB;
constexpr size_t WS_GUT = 112 * MiB;
constexpr size_t WS_DOWNT = 624 * MiB;
constexpr size_t WS_XB = 880 * MiB;
constexpr size_t WS_PROJ = 1010 * MiB;
constexpr size_t WS_POOLED = 1202 * MiB;
constexpr size_t WS_PBUF = 1266 * MiB;
constexpr size_t WS_CONCAT = 1330 * MiB;
constexpr size_t WS_HIDDEN = 1458 * MiB;
constexpr size_t WS_XB8 = 1618 * MiB;
constexpr size_t WS_BTO = 1684 * MiB;
constexpr size_t WS_GRPW = 1716 * MiB;
constexpr size_t WS_WQN = 1718 * MiB;
constexpr size_t WS_WINQ = 1734 * MiB;
constexpr size_t WS_END = 1750 * MiB;
constexpr int CW_BAR = 4096;
constexpr int CW_CONVQ = 2048;
constexpr int EARLY_PLAIN_MIN_G = 176;
constexpr int CW_CURSOR = 16384;

constexpr int RING_BYTES = 131072;
constexpr int SCR_OFF = RING_BYTES;
constexpr int SCR_IDX = 8192, SCR_TAB = 20480, SCR_BYTES = 22528;
constexpr int MISC_OFF = SCR_OFF + SCR_BYTES;
constexpr int LDS_BYTES = MISC_OFF + 128;
constexpr int MAX_MOE_UNITS = 12;

#define RLX_AGENT __ATOMIC_RELAXED, __HIP_MEMORY_SCOPE_AGENT
#define LDS_WAIT() asm volatile("s_waitcnt lgkmcnt(0)" ::: "memory")
#define VM_WAIT() asm volatile("s_waitcnt vmcnt(0)" ::: "memory")
__device__ __forceinline__ int rfl(int v) { return __builtin_amdgcn_readfirstlane(v); }
__device__ __forceinline__ unsigned f2bf(float f) { unsigned u = __builtin_bit_cast(unsigned, f); return (u + 0x7fffu + ((u >> 16) & 1u)) >> 16; }
__device__ __forceinline__ unsigned pk2(float lo, float hi) { return f2bf(lo) | (f2bf(hi) << 16); }
__device__ __forceinline__ unsigned cvt_pk_bf16(float lo, float hi) { unsigned r; asm volatile("v_cvt_pk_bf16_f32 %0, %1, %2" : "=v"(r) : "v"(lo), "v"(hi)); return r; }
__device__ __forceinline__ unsigned pk4_fp8(float a, float b, float c, float d) {
    a = __builtin_amdgcn_fmed3f(a, -448.f, 448.f); b = __builtin_amdgcn_fmed3f(b, -448.f, 448.f); c = __builtin_amdgcn_fmed3f(c, -448.f, 448.f); d = __builtin_amdgcn_fmed3f(d, -448.f, 448.f);
    int w = 0; w = __builtin_amdgcn_cvt_pk_fp8_f32(a, b, w, false); w = __builtin_amdgcn_cvt_pk_fp8_f32(c, d, w, true); return (unsigned)w; }
typedef float f32x2v __attribute__((ext_vector_type(2)));
__device__ __forceinline__ void fp8x8_to_f32(const u32x2 w, float (&o)[8]) { const f32x2v a = __builtin_amdgcn_cvt_pk_f32_fp8((int)w.x, false), b = __builtin_amdgcn_cvt_pk_f32_fp8((int)w.x, true), c = __builtin_amdgcn_cvt_pk_f32_fp8((int)w.y, false), d = __builtin_amdgcn_cvt_pk_f32_fp8((int)w.y, true);
    o[0] = a.x; o[1] = a.y; o[2] = b.x; o[3] = b.y; o[4] = c.x; o[5] = c.y; o[6] = d.x; o[7] = d.y; }
__device__ __forceinline__ float bflo(unsigned w) { return __uint_as_float(w << 16); }
__device__ __forceinline__ float bfhi(unsigned w) { return __uint_as_float(w & 0xffff0000u); }
__device__ __forceinline__ float wave_sum(float v) {
#pragma unroll
    for (int o = 1; o < 64; o <<= 1) v += __shfl_xor(v, o);
    return v;
}
__device__ __forceinline__ float gelu_tanh(float x) {
    const float e = __builtin_amdgcn_exp2f(x * (-2.302208198f - 0.1029432396f * x * x));
    return x * __builtin_amdgcn_rcpf(1.0f + e);
}
__device__ __forceinline__ float silu_f(float x) { return x * __builtin_amdgcn_rcpf(1.0f + __builtin_amdgcn_exp2f(-1.442695041f * x)); }

#define XB_TMO      128
#define XB_XCNT(j)  (256  + 64 * (j))
#define XB_XSUB(j)  (1280 + 64 * (j))
#define XB_XGEN(j)  (2304 + 64 * (j))
#define XB_TOP      3328
#define XB_TOPGEN   3392
#define XCD_BAR_WORDS 3456
#define XB_SPIN_CAP (1u << 20)

__device__ __forceinline__ unsigned xb_ld(unsigned* p)              { return __hip_atomic_load(p, __ATOMIC_RELAXED, __HIP_MEMORY_SCOPE_AGENT); }
__device__ __forceinline__ unsigned xb_add(unsigned* p, unsigned v) { return __hip_atomic_fetch_add(p, v, __ATOMIC_RELAXED, __HIP_MEMORY_SCOPE_AGENT); }
__device__ __forceinline__ unsigned xb_xcc_id() { return (unsigned)__builtin_amdgcn_s_getreg((3 << 11) | 20) & 0xFu; }
#define XB_SPIN(cond, bar) do { unsigned _sp = 0; while (cond) { __builtin_amdgcn_s_sleep(1); \
    if ((++_sp & 255u) == 0u) { if (xb_ld(&(bar)[XB_TMO])) break; if (_sp > XB_SPIN_CAP) { atomicAdd(&(bar)[XB_TMO], 1u); break; } } } } while (0)

struct XcdBarrier { unsigned* bar; unsigned x; volatile LAS unsigned* st; };
__device__ __forceinline__ XcdBarrier xcd_barrier_post(unsigned* bar, volatile LAS unsigned* st) {
    XcdBarrier b; b.bar = bar; b.x = xb_xcc_id(); b.st = st;
    if (threadIdx.x == 0) (void)xb_add(&bar[XB_XCNT(b.x)], 1u);
    return b;
}
__device__ __forceinline__ void xcd_barrier_complete(unsigned* bar, unsigned x, unsigned& nloc, unsigned& nx) {
    const unsigned G = gridDim.x * gridDim.y * gridDim.z;
    unsigned sum, cnt, mine, sp = 0u;
    for (;;) {
        sum = 0u; cnt = 0u; mine = 0u;
#pragma unroll
        for (unsigned j = 0; j < 16; ++j) { const unsigned c = xb_ld(&bar[XB_XCNT(j)]); sum += c; cnt += (c > 0u) ? 1u : 0u; mine = (j == x) ? c : mine; }
        if (sum == G) break;
        __builtin_amdgcn_s_sleep(1);
        if ((++sp & 255u) == 0u) { if (xb_ld(&bar[XB_TMO])) break; if (sp > XB_SPIN_CAP) { atomicAdd(&bar[XB_TMO], 1u); break; } }
    }
    nloc = mine > 0u ? mine : 1u; nx = cnt > 0u ? cnt : 1u;
}
__device__ __forceinline__ void xcd_barrier(const XcdBarrier& b) {
    asm volatile("s_waitcnt vmcnt(0)" ::: "memory");
    __syncthreads();
    if (threadIdx.x == 0) {
        unsigned* bar = b.bar;
        __builtin_amdgcn_s_waitcnt(0);
        unsigned nloc = b.st[0], nx = b.st[1];
        if (nloc == 0u) { xcd_barrier_complete(bar, b.x, nloc, nx); b.st[0] = nloc; b.st[1] = nx; }
        const unsigned old = xb_add(&bar[XB_XSUB(b.x)], 1u);
        const unsigned gen = old / nloc;
        if (old + 1u == (gen + 1u) * nloc) {
            __builtin_amdgcn_fence(__ATOMIC_RELEASE, "agent");
            asm volatile("s_waitcnt vmcnt(0)" ::: "memory");
            const unsigned og = xb_add(&bar[XB_TOP], 1u);
            const unsigned tg = og / nx;
            if (og + 1u == (tg + 1u) * nx) xb_add(&bar[XB_TOPGEN], 1u);
            else XB_SPIN(xb_ld(&bar[XB_TOPGEN]) == tg, bar);
            __builtin_amdgcn_fence(__ATOMIC_ACQUIRE, "agent");
            xb_add(&bar[XB_XGEN(b.x)], 1u);
            asm volatile("s_waitcnt vmcnt(0)" ::: "memory");
        } else {
            XB_SPIN(xb_ld(&bar[XB_XGEN(b.x)]) == gen, bar);
            __builtin_amdgcn_fence(__ATOMIC_ACQUIRE, "agent");
            asm volatile("s_waitcnt vmcnt(0)" ::: "memory");
        }
    }
    __syncthreads();
}

namespace pg8 {
constexpr int BM = 256, BK = 64, HALF = 128, HTB = HALF * BK * 2, NXCD = 8, WGM = 4;
__device__ __forceinline__ int lds_byte(int r, int c) { const int st = (r >> 4) * 2 + (c >> 5), rr = r & 15, cc = c & 31, ob = rr * 64 + cc * 2; return st * 1024 + (ob ^ (((ob >> 9) & 1) << 5)); }
__device__ __forceinline__ void stage_rc(int b, int& R, int& C) { const int st = b / 1024, sb = b % 1024, swz = sb ^ (((sb >> 9) & 1) << 5); R = (st >> 1) * 16 + swz / 64; C = (st & 1) * 32 + (swz % 64) / 2; }
__device__ __forceinline__ int perm32(int rho) { const int n = rho >> 4, i = rho & 15; return 8 * (i >> 2) + 4 * n + (i & 3); }

struct Unit { const char* A; const char* B; char* C; int pm, pn, aux, nvalid; };

__device__ __forceinline__ bool grid_order(int i, int G, int c, int nM, int nN, int& pm, int& pn) {
    const int nwg = nM * nN; const long L = (long)i * G + c; if (L >= nwg) return false;
    int wgid = (int)L; { const int q = nwg / NXCD, r = nwg % NXCD, xcd = wgid % NXCD, off = wgid / NXCD; wgid = (xcd < r ? xcd * (q + 1) : r * (q + 1) + (xcd - r) * q) + off; }
    const int nig = WGM * nN, gid = wgid / nig, fm = gid * WGM, gsz = (nM - fm) < WGM ? (nM - fm) : WGM;
    pm = fm + ((wgid % nig) % gsz); pn = (wgid % nig) / gsz; return true;
}
struct SchedGrid {
    int nM, nN, G, c; const char* A0; size_t a_pm, a_pn; const char* B0; size_t b_bt, b_pn; char* C0; size_t c_pm, c_pn;
    __device__ __forceinline__ bool next(int i, Unit& u) const {
        int pm, pn; if (!grid_order(i, G, c, nM, nN, pm, pn)) return false;
        u.pm = pm; u.pn = pn; u.aux = 0; u.nvalid = 256;
        u.A = A0 + (size_t)pm * a_pm + (size_t)pn * a_pn; u.B = B0 + (size_t)(pm >> 6) * b_bt + (size_t)pn * b_pn; u.C = C0 + (size_t)pm * c_pm + (size_t)pn * c_pn; return true;
    }
    __device__ __forceinline__ int row(int, int) const { return 0; }
};

template <bool F8> struct FragSel { struct A { i32x4 v[4][2]; }; struct B { i32x4 v[2][2]; }; };
template <> struct FragSel<true> { struct A { i32x8 v[4]; }; struct B { i32x8 v[2]; }; };
template <class Epi, class Sched, bool GATHER, bool FP8 = false, bool HALFSKIP = false, bool EPI2 = false, int MIXSW = 0>
__device__ __forceinline__ void gemm_phase(LAS unsigned char* lds, LAS unsigned char* scr, const int K, const unsigned lda2, const unsigned ldb2, const size_t hstepB, const Sched& S, const Epi& E) {
    const int tid = threadIdx.x, wid = __builtin_amdgcn_readfirstlane(tid >> 6), lane = tid & 63, wr = wid >> 2, wc = wid & 3, fr = lane & 15, fq = lane >> 4;
    const int nt = K / BK;
    unsigned voffB[2], vAc[2][2], vAn[2][2]; int Rr[2], Cc[2];
#pragma unroll
    for (int i = 0; i < 2; ++i) { int R, C; stage_rc(tid * 16 + i * 8192, R, C); const int Rb = (R & ~31) + perm32(R & 31); Rr[i] = R; Cc[i] = C;
        voffB[i] = (unsigned)Rb * ldb2 + (unsigned)C * 2u; vAc[0][i] = (unsigned)R * lda2 + (unsigned)C * 2u; vAc[1][i] = vAc[0][i]; vAn[0][i] = vAc[0][i]; vAn[1][i] = vAc[0][i]; }
    const size_t kstep = (size_t)(BK * 2);
    const size_t hstepA = GATHER ? (size_t)0 : (size_t)HALF * lda2;
    const unsigned ldsw = (unsigned)wid * 1024u;
    const int aoff = lds_byte(wr * 64 + fr, fq * 8), boff = lds_byte(wc * 32 + fr, fq * 8);
#define PG8_SA(b, h) (((b) * 2 + (h)) * HTB)
#define PG8_SB(b, h) ((4 + (b) * 2 + (h)) * HTB)
#define PG8_STG(bufoff, gptr, v0, v1) do { \
        __builtin_amdgcn_global_load_lds((const unsigned*)((const char*)(gptr) + (v0)), (LAS unsigned*)(lds + (bufoff) + ldsw), 16, 0, 0); \
        __builtin_amdgcn_global_load_lds((const unsigned*)((const char*)(gptr) + (v1)), (LAS unsigned*)(lds + (bufoff) + ldsw + 8192), 16, 0, 0); } while (0)
#define PG8_STG_B(b, h, bp) PG8_STG(PG8_SB(b, h), (bp) + (h) * hstepB, voffB[0], voffB[1])
#define PG8_STG_A(b, h, ap, nx) do { if constexpr (GATHER) { const unsigned _o0 = (nx) ? vAn[h][0] : vAc[h][0], _o1 = (nx) ? vAn[h][1] : vAc[h][1]; PG8_STG(PG8_SA(b, h), (ap), _o0, _o1); } \
        else { PG8_STG(PG8_SA(b, h), (ap) + (h) * hstepA, vAc[0][0], vAc[0][1]); } } while (0)
#define PG8_LDA(KIND, b, h) do { _Pragma("unroll") for (int m = 0; m < 4; ++m) { const i32x4 _l0 = *(const LAS i32x4*)(lds + PG8_SA(b, h) + aoff + m * 2048), _l1 = *(const LAS i32x4*)(lds + PG8_SA(b, h) + aoff + m * 2048 + 1024); \
        if constexpr (KIND) AtQ.v[m] = __builtin_shufflevector(_l0, _l1, 0, 1, 2, 3, 4, 5, 6, 7); else { AtH.v[m][0] = _l0; AtH.v[m][1] = _l1; } } } while (0)
#define PG8_LDB(KIND, W, b, h) do { _Pragma("unroll") for (int n = 0; n < 2; ++n) { const i32x4 _l0 = *(const LAS i32x4*)(lds + PG8_SB(b, h) + boff + n * 2048), _l1 = *(const LAS i32x4*)(lds + PG8_SB(b, h) + boff + n * 2048 + 1024); \
        if constexpr (KIND) B##W##Q.v[n] = __builtin_shufflevector(_l0, _l1, 0, 1, 2, 3, 4, 5, 6, 7); else { B##W##H.v[n][0] = _l0; B##W##H.v[n][1] = _l1; } } } while (0)
#define PG8_MMA(KIND, ai, bj, W) do { __builtin_amdgcn_s_setprio(1); _Pragma("unroll") for (int m = 0; m < 4; ++m) _Pragma("unroll") for (int n = 0; n < 2; ++n) { \
        if constexpr (KIND) asm volatile("v_mfma_scale_f32_16x16x128_f8f6f4 %0, %1, %2, %0, %3, %3 op_sel_hi:[0,0,0]" : "+v"(acc[ai][bj][m][n]) : "v"(B##W##Q.v[n]), "v"(AtQ.v[m]), "v"(scl1)); \
        else { _Pragma("unroll") for (int k = 0; k < 2; ++k) acc[ai][bj][m][n] = __builtin_amdgcn_mfma_f32_16x16x32_bf16(__builtin_bit_cast(bf16x8, B##W##H.v[n][k]), __builtin_bit_cast(bf16x8, AtH.v[m][k]), acc[ai][bj][m][n], 0, 0, 0); } } \
        __builtin_amdgcn_s_setprio(0); } while (0)
#define PG8_WAIT_V(n) asm volatile("s_waitcnt vmcnt(" #n ")" ::: "memory")
#define PG8_WAIT_L(n) asm volatile("s_waitcnt lgkmcnt(" #n ")" ::: "memory")
#define PG8_BAR __builtin_amdgcn_s_barrier()
#define PG8_SCHED __builtin_amdgcn_sched_barrier(0)
    Unit cur, nxt; int ui = 0;
    if (!S.next(0, cur)) return;
    int scl1 = 0x7f7f7f7f; asm volatile("" : "+v"(scl1));
    if constexpr (GATHER) {
#pragma unroll
        for (int h = 0; h < 2; ++h)
#pragma unroll
            for (int i = 0; i < 2; ++i) vAc[h][i] = (unsigned)S.row(0, Rr[i] + HALF * h) * lda2 + (unsigned)Cc[i] * 2u;
    }
    f32x4 acc[2][2][4][2];
#pragma unroll
    for (int a = 0; a < 2; ++a)
#pragma unroll
        for (int b = 0; b < 2; ++b)
#pragma unroll
            for (int m = 0; m < 4; ++m)
#pragma unroll
                for (int n = 0; n < 2; ++n) acc[a][b][m][n] = (f32x4){0.f, 0.f, 0.f, 0.f};
    typename FragSel<false>::A AtH; typename FragSel<false>::B B0H, B1H; typename FragSel<true>::A AtQ; typename FragSel<true>::B B0Q, B1Q;
    const char* cA = cur.A; const char* cB = cur.B;
    PG8_STG_B(0, 0, cB); PG8_STG_B(0, 1, cB); PG8_STG_A(0, 0, cA, false); PG8_STG_A(0, 1, cA, false);
    if (wr == 1) PG8_BAR;
    PG8_WAIT_V(2); PG8_BAR;
    PG8_STG_B(1, 0, cB + kstep); PG8_STG_A(1, 0, cA + kstep, false); PG8_STG_B(1, 1, cB + kstep);
    PG8_WAIT_V(6); PG8_BAR;
    for (;;) {
        const bool has_next = S.next(ui + 1, nxt);
        const char* nA = has_next ? nxt.A : cA; const char* nB = has_next ? nxt.B : cB;
        if constexpr (GATHER) {
#pragma unroll
            for (int h = 0; h < 2; ++h)
#pragma unroll
                for (int i = 0; i < 2; ++i) vAn[h][i] = has_next ? (unsigned)S.row(ui + 1, Rr[i] + HALF * h) * lda2 + (unsigned)Cc[i] * 2u : vAc[h][i];
        }
#define PG8_KLOOP(KIND, MMA1, TBEG, TEND, FINAL) _Pragma("unroll 1") for (int t = (TBEG); t < (TEND); t += 2) { \
            const bool last = (FINAL) && (t == nt - 2); \
            const char* a1 = cA + (size_t)(t + 1) * kstep; \
            const char* a2 = last ? nA : cA + (size_t)(t + 2) * kstep; const char* b2 = last ? nB : cB + (size_t)(t + 2) * kstep; \
            const char* a3 = a2 + kstep; const char* b3 = b2 + kstep; \
              \
            PG8_LDB(KIND, 0, 0, 0); PG8_LDB(KIND, 1, 0, 1); PG8_SCHED; PG8_LDA(KIND, 0, 0); PG8_STG_A(1, 1, a1, false); \
            PG8_WAIT_V(8); PG8_WAIT_L(0); PG8_BAR; PG8_MMA(KIND, 0, 0, 0); PG8_MMA(KIND, 0, 1, 1); PG8_BAR; PG8_SCHED; \
              \
            PG8_LDA(KIND, 0, 1); PG8_STG_B(0, 0, b2); PG8_STG_B(0, 1, b2); PG8_STG_A(0, 0, a2, last); \
            PG8_WAIT_V(8); PG8_WAIT_L(0); PG8_BAR; if (MMA1) { PG8_MMA(KIND, 1, 0, 0); PG8_MMA(KIND, 1, 1, 1); } PG8_BAR; PG8_SCHED; \
              \
            PG8_LDB(KIND, 0, 1, 0); PG8_LDB(KIND, 1, 1, 1); PG8_SCHED; PG8_LDA(KIND, 1, 0); PG8_STG_A(0, 1, a2, last); \
            PG8_WAIT_V(8); PG8_WAIT_L(0); PG8_BAR; PG8_MMA(KIND, 0, 0, 0); PG8_MMA(KIND, 0, 1, 1); PG8_BAR; PG8_SCHED; \
              \
            PG8_LDA(KIND, 1, 1); PG8_STG_B(1, 0, b3); PG8_STG_B(1, 1, b3); PG8_STG_A(1, 0, a3, last); \
            PG8_WAIT_V(8); PG8_WAIT_L(0); PG8_BAR; if (MMA1) { PG8_MMA(KIND, 1, 0, 0); PG8_MMA(KIND, 1, 1, 1); } PG8_BAR; PG8_SCHED; \
        }
#define PG8_KLOOPS(KIND, TBEG, TEND, FINAL) do { if (HALFSKIP && cur.nvalid <= 128) { PG8_KLOOP(KIND, false, TBEG, TEND, FINAL) } else { PG8_KLOOP(KIND, true, TBEG, TEND, FINAL) } } while (0)
        if constexpr (MIXSW > 0) { PG8_KLOOPS(0, 0, MIXSW, false); PG8_KLOOPS(1, MIXSW, nt, true); }
        else if constexpr (FP8) { PG8_KLOOPS(1, 0, nt, true); }
        else { PG8_KLOOPS(0, 0, nt, true); }
        if constexpr (FP8 || MIXSW > 0) asm volatile("s_nop 15\n\ts_nop 15" ::: "memory");
        if (wr == 0) PG8_BAR;
        E(acc, cur, ui, wr, wc, fr, fq, scr);
        if constexpr (EPI2) { asm volatile("" ::: "memory"); E(acc, cur, ui, wr, wc, fr, fq, scr); }
        if (!has_next) break;
#pragma unroll
        for (int a = 0; a < 2; ++a)
#pragma unroll
            for (int b = 0; b < 2; ++b)
#pragma unroll
                for (int m = 0; m < 4; ++m)
#pragma unroll
                    for (int n = 0; n < 2; ++n) acc[a][b][m][n] = (f32x4){0.f, 0.f, 0.f, 0.f};
        cur = nxt; cA = nA; cB = nB; ++ui;
        if constexpr (GATHER) {
#pragma unroll
            for (int h = 0; h < 2; ++h)
#pragma unroll
                for (int i = 0; i < 2; ++i) vAc[h][i] = vAn[h][i];
        }
        if (wr == 1) PG8_BAR;
    }
    PG8_WAIT_V(0);
    PG8_BAR;
#undef PG8_KLOOPS
#undef PG8_KLOOP
#undef PG8_SA
#undef PG8_SB
#undef PG8_STG
#undef PG8_STG_A
#undef PG8_STG_B
#undef PG8_LDA
#undef PG8_LDB
#undef PG8_MMA
#undef PG8_WAIT_V
#undef PG8_WAIT_L
#undef PG8_BAR
#undef PG8_SCHED
}
}
using pg8::Unit;

typedef f32x4 Acc[2][2][4][2];
#define EPI_ROWS(ai, m) (128 * (ai) + 64 * wr + 16 * (m) + fr)
#define EPI_COL0 (32 * wc + 8 * fq)
__device__ __forceinline__ u32x4 pack8(const f32x4 a, const f32x4 b) { u32x4 w; w.x = cvt_pk_bf16(a[0], a[1]); w.y = cvt_pk_bf16(a[2], a[3]); w.z = cvt_pk_bf16(b[0], b[1]); w.w = cvt_pk_bf16(b[2], b[3]); return w; }

struct EpiPlain {
    int ldc; float scale;
    __device__ __forceinline__ void operator()(Acc& acc, const Unit& u, int, int wr, int wc, int fr, int fq, LAS unsigned char*) const {
        asm volatile("" : "+v"(fr), "+v"(fq));
        const int ld = ldc ? ldc : u.aux; bf16_t* base = (bf16_t*)u.C + EPI_COL0;
#pragma unroll
        for (int ai = 0; ai < 2; ++ai)
#pragma unroll
            for (int m = 0; m < 4; ++m) { bf16_t* rowp = base + (size_t)EPI_ROWS(ai, m) * ld;
#pragma unroll
                for (int bj = 0; bj < 2; ++bj) *(u32x4*)(rowp + bj * 128) = pack8(acc[ai][bj][m][0] * scale, acc[ai][bj][m][1] * scale); }
    }
};
__device__ __forceinline__ void epi_softmax(Acc& acc, const Unit& u, int wr, int wc, int fr, int fq, LAS unsigned char* scr, int ldc, float c) {
    LAS float* XA = (LAS float*)scr; LAS float* XB = (LAS float*)(scr + 4096);
#pragma unroll
    for (int ai = 0; ai < 2; ++ai)
#pragma unroll
        for (int m = 0; m < 4; ++m) { float mx = -3.0e38f;
#pragma unroll
            for (int bj = 0; bj < 2; ++bj)
#pragma unroll
                for (int n = 0; n < 2; ++n) { const f32x4 x = acc[ai][bj][m][n]; mx = fmaxf(mx, fmaxf(fmaxf(x[0], x[1]), fmaxf(x[2], x[3]))); }
            mx = fmaxf(mx, __shfl_xor(mx, 16)); mx = fmaxf(mx, __shfl_xor(mx, 32));
            if (fq == 0) XA[EPI_ROWS(ai, m) * 4 + wc] = mx; }
    LDS_WAIT(); __builtin_amdgcn_s_barrier(); asm volatile("" ::: "memory");
#pragma unroll
    for (int ai = 0; ai < 2; ++ai)
#pragma unroll
        for (int m = 0; m < 4; ++m) { const f32x4 q = *(const LAS f32x4*)(XA + EPI_ROWS(ai, m) * 4); const float mx = fmaxf(fmaxf(q[0], q[1]), fmaxf(q[2], q[3])) * c; float s = 0.f;
#pragma unroll
            for (int bj = 0; bj < 2; ++bj)
#pragma unroll
                for (int n = 0; n < 2; ++n) { f32x4 x = acc[ai][bj][m][n];
#pragma unroll
                    for (int j = 0; j < 4; ++j) { x[j] = __builtin_amdgcn_exp2f(x[j] * c - mx); s += x[j]; }
                    acc[ai][bj][m][n] = x; }
            s += __shfl_xor(s, 16); s += __shfl_xor(s, 32);
            if (fq == 0) XB[EPI_ROWS(ai, m) * 4 + wc] = s; asm volatile("" ::: "memory"); }
    LDS_WAIT(); __builtin_amdgcn_s_barrier(); asm volatile("" ::: "memory");
    unsigned char* base = (unsigned char*)u.C + 32 * wc + 8 * (fq & ~1); const bool odd = fq & 1;
#pragma unroll
    for (int ai = 0; ai < 2; ++ai) {
        u32x2 w8[4][2];
#pragma unroll
        for (int m = 0; m < 4; ++m) { const int r = EPI_ROWS(ai, m); const f32x4 q = *(const LAS f32x4*)(XB + r * 4); const float inv = P_S * __builtin_amdgcn_rcpf((q[0] + q[1]) + (q[2] + q[3]));
#pragma unroll
            for (int bj = 0; bj < 2; ++bj) { const f32x4 v0 = acc[ai][bj][m][0] * inv, v1 = acc[ai][bj][m][1] * inv; w8[m][bj].x = pk4_fp8(v0[0], v0[1], v0[2], v0[3]); w8[m][bj].y = pk4_fp8(v1[0], v1[1], v1[2], v1[3]); } }
#pragma unroll
        for (int mp = 0; mp < 4; mp += 2)
#pragma unroll
            for (int bj = 0; bj < 2; ++bj) { const u32x2 mine = odd ? w8[mp + 1][bj] : w8[mp][bj], send = odd ? w8[mp][bj] : w8[mp + 1][bj];
                u32x2 recv; recv.x = (unsigned)__shfl_xor((int)send.x, 16); recv.y = (unsigned)__shfl_xor((int)send.y, 16);
                u32x4 o; if (odd) { o.x = recv.x; o.y = recv.y; o.z = mine.x; o.w = mine.y; } else { o.x = mine.x; o.y = mine.y; o.z = recv.x; o.w = recv.y; }
                *(u32x4*)(base + (size_t)EPI_ROWS(ai, mp + (odd ? 1 : 0)) * ldc + bj * 128) = o; }
        asm volatile("" ::: "memory"); }
}
struct EpiFp8 {
    float scale0; int ldc0; float scale1; int ldc1;
    __device__ __forceinline__ void operator()(Acc& acc, const Unit& u, int, int wr, int wc, int fr, int fq, LAS unsigned char*) const {
        asm volatile("" : "+v"(fr), "+v"(fq));
        unsigned char* base = (unsigned char*)u.C + EPI_COL0; const float scale = u.aux ? scale1 : scale0; const int ldc = u.aux ? ldc1 : ldc0;
#pragma unroll
        for (int ai = 0; ai < 2; ++ai)
#pragma unroll
            for (int m = 0; m < 4; ++m)
#pragma unroll
                for (int bj = 0; bj < 2; ++bj) { const f32x4 v0 = acc[ai][bj][m][0] * scale, v1 = acc[ai][bj][m][1] * scale; u32x2 w; w.x = pk4_fp8(v0[0], v0[1], v0[2], v0[3]); w.y = pk4_fp8(v1[0], v1[1], v1[2], v1[3]);
                    *(u32x2*)(base + (size_t)EPI_ROWS(ai, m) * ldc + bj * 128) = w; }
    }
};
template <int MODE> struct EpiProj {
    int ldc; const float* rs; float* ssqv; int qt;
    LAS float* rtab; float sc;
    __device__ __forceinline__ void operator()(Acc& acc, const Unit& u, int ui, int wr, int wc, int fr, int fq, LAS unsigned char* scr) const {
        asm volatile("" : "+v"(fr), "+v"(fq));
        bf16_t* base = (bf16_t*)u.C + EPI_COL0;
#pragma unroll
        for (int ai = 0; ai < 2; ++ai)
#pragma unroll
            for (int m = 0; m < 4; ++m) {
                const int r = EPI_ROWS(ai, m), t = u.pm * 256 + r; const float rstd = rtab[ui * 256 + r] * sc;
                float sq = 0.f;
#pragma unroll
                for (int bj = 0; bj < 2; ++bj) { f32x4 v0 = acc[ai][bj][m][0] * rstd, v1 = acc[ai][bj][m][1] * rstd;
                    if (MODE == 1 && u.pn < 8) {
#pragma unroll
                        for (int j = 0; j < 4; ++j) { v0[j] = gelu_tanh(v0[j]); v1[j] = gelu_tanh(v1[j]); } }
                    const u32x4 w = pack8(v0, v1);
                    if (MODE == 1) { const float a0 = bflo(w.x), a1 = bfhi(w.x), a2 = bflo(w.y), a3 = bfhi(w.y), a4 = bflo(w.z), a5 = bfhi(w.z), a6 = bflo(w.w), a7 = bfhi(w.w);
                        sq += (a0 * a0 + a1 * a1) + (a2 * a2 + a3 * a3) + (a4 * a4 + a5 * a5) + (a6 * a6 + a7 * a7); }
                    *(u32x4*)(base + (size_t)r * ldc + bj * 128) = w; }
                if (MODE == 1 && u.pn >= 4 && u.pn < 8) { sq += __shfl_xor(sq, 16); sq += __shfl_xor(sq, 32); if (fq == 0) ssqv[(size_t)t * 16 + (u.pn - 4) * 4 + wc] = sq; }
            }
    }
};
template <int MODE> struct EpiScore {
    LAS float* rtab;
    __device__ __forceinline__ void operator()(Acc& acc, const Unit& u, int ui, int wr, int wc, int fr, int fq, LAS unsigned char* scr) const {
        asm volatile("" : "+v"(fr), "+v"(fq));
#pragma unroll
        for (int ai = 0; ai < 2; ++ai)
#pragma unroll
            for (int m = 0; m < 4; ++m) { const float rstd = rtab[ui * 256 + EPI_ROWS(ai, m)];
#pragma unroll
                for (int bj = 0; bj < 2; ++bj) { acc[ai][bj][m][0] = acc[ai][bj][m][0] * rstd; acc[ai][bj][m][1] = acc[ai][bj][m][1] * rstd; } }
        epi_softmax(acc, u, wr, wc, fr, fq, scr, 3072, 1.442695041f / WQ_S);
    }
};
struct EpiSpatial {
    const bf16_t* uproj; const float* bs;
    __device__ __forceinline__ void operator()(Acc& acc, const Unit& u, int, int wr, int wc, int fr, int fq, LAS unsigned char*) const {
        asm volatile("" : "+v"(fr), "+v"(fq));
        unsigned char* base = (unsigned char*)u.C + EPI_COL0; const bf16_t* ub = uproj + (size_t)u.pm * 256 * 3072 + u.pn * 256 + EPI_COL0;
#pragma unroll
        for (int ai = 0; ai < 2; ++ai)
#pragma unroll
            for (int m = 0; m < 4; ++m) { const int r = EPI_ROWS(ai, m); const float b = bs[u.pn * 128 + (r & 127)];
#pragma unroll
                for (int bj = 0; bj < 2; ++bj) { const u32x4 uw = *(const u32x4*)(ub + (size_t)r * 3072 + bj * 128); f32x4 v0 = acc[ai][bj][m][0] + b, v1 = acc[ai][bj][m][1] + b;
                    v0[0] *= bflo(uw.x); v0[1] *= bfhi(uw.x); v0[2] *= bflo(uw.y); v0[3] *= bfhi(uw.y); v1[0] *= bflo(uw.z); v1[1] *= bfhi(uw.z); v1[2] *= bflo(uw.w); v1[3] *= bfhi(uw.w);
                    v0 = v0 * MX_S; v1 = v1 * MX_S; u32x2 w8; w8.x = pk4_fp8(v0[0], v0[1], v0[2], v0[3]); w8.y = pk4_fp8(v1[0], v1[1], v1[2], v1[3]);
                    *(u32x2*)(base + (size_t)r * 3072 + bj * 128) = w8; }
                asm volatile("" ::: "memory"); }
    }
};
struct EpiOut {
    float* part; unsigned char* xb8; float rsc;
    __device__ __forceinline__ void operator()(Acc& acc, const Unit& u, int, int wr, int wc, int fr, int fq, LAS unsigned char* scr) const {
        asm volatile("" : "+v"(fr), "+v"(fq));
        bf16_t* base = (bf16_t*)u.C + EPI_COL0; LAS float* XA = (LAS float*)scr;
        const bool odd = fq & 1;
#pragma unroll
        for (int ai = 0; ai < 2; ++ai) {
            u32x4 xw[4][2];
#pragma unroll
            for (int m = 0; m < 4; ++m)
#pragma unroll
                for (int bj = 0; bj < 2; ++bj) xw[m][bj] = *(const u32x4*)(base + (size_t)EPI_ROWS(ai, m) * D + bj * 128);
            u32x2 w8[4][2];
#pragma unroll
            for (int m = 0; m < 4; ++m) { const int r = EPI_ROWS(ai, m); float sq = 0.f;
#pragma unroll
                for (int bj = 0; bj < 2; ++bj) { u32x4* p = (u32x4*)(base + (size_t)r * D + bj * 128); const u32x4 x = xw[m][bj]; f32x4 v0 = acc[ai][bj][m][0] * rsc, v1 = acc[ai][bj][m][1] * rsc;
                    v0[0] += bflo(x.x); v0[1] += bfhi(x.x); v0[2] += bflo(x.y); v0[3] += bfhi(x.y); v1[0] += bflo(x.z); v1[1] += bfhi(x.z); v1[2] += bflo(x.w); v1[3] += bfhi(x.w);
                    const u32x4 w = pack8(v0, v1); *p = w;
                    const float a0 = bflo(w.x), a1 = bfhi(w.x), a2 = bflo(w.y), a3 = bfhi(w.y), a4 = bflo(w.z), a5 = bfhi(w.z), a6 = bflo(w.w), a7 = bfhi(w.w);
                    w8[m][bj].x = pk4_fp8(a0, a1, a2, a3); w8[m][bj].y = pk4_fp8(a4, a5, a6, a7);
                    sq += (a0 * a0 + a1 * a1) + (a2 * a2 + a3 * a3) + (a4 * a4 + a5 * a5) + (a6 * a6 + a7 * a7); }
                sq += __shfl_xor(sq, 16); sq += __shfl_xor(sq, 32);
                if (fq == 0) XA[r * 4 + wc] = sq; }
#pragma unroll
            for (int mp = 0; mp < 4; mp += 2)
#pragma unroll
                for (int bj = 0; bj < 2; ++bj) { const u32x2 mine = odd ? w8[mp + 1][bj] : w8[mp][bj], send = odd ? w8[mp][bj] : w8[mp + 1][bj];
                    u32x2 recv; recv.x = (unsigned)__shfl_xor((int)send.x, 16); recv.y = (unsigned)__shfl_xor((int)send.y, 16);
                    u32x4 o; if (odd) { o.x = recv.x; o.y = recv.y; o.z = mine.x; o.w = mine.y; } else { o.x = mine.x; o.y = mine.y; o.z = recv.x; o.w = recv.y; }
                    const int r = EPI_ROWS(ai, mp + (odd ? 1 : 0));
                    *(u32x4*)(xb8 + (size_t)(u.pm * 256 + r) * D + u.pn * 256 + bj * 128 + 32 * wc + 8 * (fq & ~1)) = o; }
            asm volatile("" ::: "memory"); }
        LDS_WAIT(); __builtin_amdgcn_s_barrier(); asm volatile("" ::: "memory");
        { int tid = threadIdx.x; asm volatile("" : "+v"(tid));
          if (tid < 256) { const f32x4 q = *(const LAS f32x4*)(XA + tid * 4); part[(size_t)(u.pm * 256 + tid) * 8 + u.pn] = (q[0] + q[1]) + (q[2] + q[3]); } }
    }
};
struct EpiRoute {
    float* lg;
    __device__ __forceinline__ void operator()(Acc& acc, const Unit& u, int, int wr, int wc, int fr, int fq, LAS unsigned char*) const {
        asm volatile("" : "+v"(fr), "+v"(fq));
        if (wc >= 2) return;
        float* base = lg + (size_t)u.pn * T * 64 + (size_t)u.pm * 256 * 64 + EPI_COL0;
#pragma unroll
        for (int ai = 0; ai < 2; ++ai)
#pragma unroll
            for (int m = 0; m < 4; ++m) { float* rowp = base + (size_t)EPI_ROWS(ai, m) * 64;
                if (wc == 0) { *(f32x4*)rowp = acc[ai][0][m][0] + acc[ai][1][m][0]; *(f32x4*)(rowp + 4) = acc[ai][0][m][1] + acc[ai][1][m][1]; }
                else if (fq == 0) *(f32x4*)rowp = acc[ai][0][m][0] + acc[ai][1][m][0]; }
    }
};
struct SchedMoe {
    LAS int* pre; LAS int* cnt; LAS int* idx; LAS int* preB; LAS int* preS; int lo, hi, G, c, nbu, nunits; int mode;
    int perm;
    __device__ __forceinline__ int plist(int p) const { return perm ? ((p & 1) * 32 + (p >> 1)) : p; }
    LAS int* ul; int nmy;
    const char* A0; const char* B0; char* C0;
    __device__ __forceinline__ bool decode(int i, int& l, int& rt, int& pn, int& tile) const {
        const long L = (long)i * G + c; if (L >= nunits) return false;
        int wgid = (int)L, q; LAS int* px; bool small = wgid >= nbu;
        if (!small) { const int qq = nbu / 8, r = nbu % 8, xcd = wgid % 8, off = wgid / 8; wgid = (xcd < r ? xcd * (qq + 1) : r * (qq + 1) + (xcd - r) * qq) + off; q = wgid >> 3; px = preB; }
        else { wgid -= nbu; q = wgid >> 3; px = preS; }
        pn = wgid & 7;
        const int base = rfl(px[lo]); int a = lo, b = hi;
        while (b - a > 1) { const int mid = (a + b) >> 1; if (rfl(px[mid]) - base <= q) a = mid; else b = mid; }
        l = a; rt = small ? ((rfl(cnt[l]) + 255) >> 8) - 1 : q - (rfl(px[l]) - base); tile = rfl(pre[l]) + rt; return true;
    }
    __device__ __forceinline__ void decode_t(int i, int& l, int& rt, int& pn, int& tile) const {
        int wgid = i * G + c, q; LAS int* px; const bool small = wgid >= nbu;
        if (!small) { const int qq = nbu / 8, r = nbu % 8, xcd = wgid % 8, off = wgid / 8; wgid = (xcd < r ? xcd * (qq + 1) : r * (qq + 1) + (xcd - r) * qq) + off; q = wgid >> 3; px = preB; }
        else { wgid -= nbu; q = wgid >> 3; px = preS; }
        pn = wgid & 7;
        const int base = px[lo]; int a = lo, b = hi;
        while (b - a > 1) { const int mid = (a + b) >> 1; if (px[mid] - base <= q) a = mid; else b = mid; }
        l = plist(a); rt = small ? ((cnt[l] + 255) >> 8) - 1 : q - (px[a] - base); tile = pre[l] + rt;
    }
    __device__ __forceinline__ bool next(int i, Unit& u) const {
        if (i >= nmy) return false;
        const int w0 = rfl(ul[2 * i]), w1 = rfl(ul[2 * i + 1]); const int l = w0 & 255, rt = (w0 >> 8) & 4095, pn = w0 >> 20, tile = w1 & 0xffff;
        const int e = l & 31;
        u.pm = rt; u.pn = pn; u.aux = l; u.nvalid = w1 >> 16;
        if (mode == 0) { u.A = A0; u.B = B0 + (size_t)e * (2048 * 2048) + (size_t)pn * (128 * 2048); u.C = C0 + (size_t)tile * (256 * 1024) + (size_t)pn * 128; }
        else { u.A = A0 + (size_t)tile * (256 * 1024); u.B = B0 + (size_t)e * (2048 * 1024) + (size_t)pn * (256 * 1024); u.C = C0; }
        return true;
    }
    __device__ __forceinline__ int row(int j, int r) const { return idx[j * 256 + r] & 0x1ffff; }
};
template <int KIND  >
__device__ __forceinline__ void moe_setup(SchedMoe& S, const int* totals, const int* listp, const float* vals) {
    int tid = threadIdx.x; LAS int* cnt = S.cnt;
    if (tid < 64) { const int c_ = totals[tid]; cnt[tid] = c_; int a = (c_ + 255) >> 8;
        const int cp = totals[S.plist(tid)], nt_ = (cp + 255) >> 8, sm = (nt_ > 0 && cp - (nt_ - 1) * 256 <= 128) ? 1 : 0; int ab = nt_ - sm, as = sm;
#pragma unroll
        for (int o = 1; o < 64; o <<= 1) { const int ta = __shfl_up(a, o), tb = __shfl_up(ab, o), ts = __shfl_up(as, o); if (tid >= o) { a += ta; ab += tb; as += ts; } }
        S.pre[tid + 1] = a; S.preB[tid + 1] = ab; S.preS[tid + 1] = as; if (tid == 0) { S.pre[0] = 0; S.preB[0] = 0; S.preS[0] = 0; } }
    __syncthreads();
    S.nbu = (rfl(S.preB[S.hi]) - rfl(S.preB[S.lo])) * 8; S.nunits = S.nbu + (rfl(S.preS[S.hi]) - rfl(S.preS[S.lo])) * 8;
    { const int n_ = S.c < S.nunits ? (S.nunits - S.c + S.G - 1) / S.G : 0; S.nmy = n_ < MAX_MOE_UNITS ? n_ : MAX_MOE_UNITS; }
    if (tid < S.nmy) { int li, rt, pn, tile; S.decode_t(tid, li, rt, pn, tile); const int nv_ = cnt[li] - rt * 256; S.ul[2 * tid] = li | (rt << 8) | (pn << 20); S.ul[2 * tid + 1] = tile | ((nv_ < 256 ? nv_ : 256) << 16); }
    __syncthreads();
    const int j2 = tid >> 8, r = tid & 255; int tk[6]; float vv[6]; size_t off[6];
#pragma unroll
    for (int q = 0; q < 6; ++q) { const int j = j2 + 2 * q; tk[q] = T; vv[q] = 0.f; off[q] = 0;
        if (j < S.nmy) { const int w0 = S.ul[2 * j], w1 = S.ul[2 * j + 1]; const int li = w0 & 255, rt = (w0 >> 8) & 4095, nv = w1 >> 16;
            if (r < nv) { off[q] = (size_t)li * T + rt * 256 + r; tk[q] = listp[off[q]]; if (KIND == 1) vv[q] = vals[off[q]]; } } }
    if (KIND == 0) {
#pragma unroll
        for (int q = 0; q < 6; ++q) vv[q] = vals[tk[q]]; }
#pragma unroll
    for (int q = 0; q < 6; ++q) { const int j = j2 + 2 * q; if (j < S.nmy) S.idx[j * 256 + r] = tk[q] | (int)(((__float_as_uint(vv[q]) + 0x8000u) >> 16) << 17); }
    __syncthreads();
}
struct EpiGu {
    const float* rstd; LAS int* idx;
    __device__ __forceinline__ void operator()(Acc& acc, const Unit& u, int ui, int wr, int wc, int fr, int fq, LAS unsigned char*) const {
        asm volatile("" : "+v"(fr), "+v"(fq));
        unsigned char* base = (unsigned char*)u.C + EPI_COL0;
#pragma unroll
        for (int ai = 0; ai < 2; ++ai)
#pragma unroll
            for (int m = 0; m < 4; ++m) { const int r = EPI_ROWS(ai, m); const float rs = __uint_as_float(((unsigned)idx[ui * 256 + r] >> 17) << 16) * (1.0f / GU_WS);
                f32x4 h0, h1;
#pragma unroll
                for (int j = 0; j < 4; ++j) { h0[j] = silu_f(acc[ai][0][m][0][j] * rs) * (acc[ai][1][m][0][j] * (rs * HID_S)); h1[j] = silu_f(acc[ai][0][m][1][j] * rs) * (acc[ai][1][m][1][j] * (rs * HID_S)); }
                u32x2 w; w.x = pk4_fp8(h0[0], h0[1], h0[2], h0[3]); w.y = pk4_fp8(h1[0], h1[1], h1[2], h1[3]);
                *(u32x2*)(base + (size_t)r * DEXP) = w; }
    }
};
template <int MODE> struct EpiDown {
    bf16_t* xb; unsigned char* y0; unsigned char* y1; LAS int* idx; float* part; float rsc, ysc; unsigned char* x8;
    __device__ __forceinline__ void operator()(Acc& acc, const Unit& u, int ui, int wr, int wc, int fr, int fq, LAS unsigned char*) const {
        asm volatile("" : "+v"(fr), "+v"(fq));
        int tok[2][4]; float gt[2][4];
#pragma unroll
        for (int ai = 0; ai < 2; ++ai)
#pragma unroll
            for (int m = 0; m < 4; ++m) { const unsigned e = (unsigned)idx[ui * 256 + EPI_ROWS(ai, m)]; tok[ai][m] = (int)(e & 0x1ffffu); gt[ai][m] = __uint_as_float((e >> 17) << 16) * rsc; }
        if constexpr (MODE == 0) {
            unsigned char* yb = (u.aux >> 5) ? y1 : y0; const bool odd = fq & 1;
#pragma unroll
            for (int ai = 0; ai < 2; ++ai) {
                u32x2 w8[4][2];
#pragma unroll
                for (int m = 0; m < 4; ++m) { const float g = gt[ai][m] * Y_S;
#pragma unroll
                    for (int bj = 0; bj < 2; ++bj) { const f32x4 v0 = acc[ai][bj][m][0] * g, v1 = acc[ai][bj][m][1] * g; w8[m][bj].x = pk4_fp8(v0[0], v0[1], v0[2], v0[3]); w8[m][bj].y = pk4_fp8(v1[0], v1[1], v1[2], v1[3]); } }
#pragma unroll
                for (int mp = 0; mp < 4; mp += 2) { const int msk = -(int)(fq & 1); const int tk = (tok[ai][mp] & ~msk) | (tok[ai][mp + 1] & msk); const int ts = tk + (tk >= T ? 1 : 0);
#pragma unroll
                    for (int bj = 0; bj < 2; ++bj) { const u32x2 mine = odd ? w8[mp + 1][bj] : w8[mp][bj], send = odd ? w8[mp][bj] : w8[mp + 1][bj];
                        u32x2 recv; recv.x = (unsigned)__shfl_xor((int)send.x, 16); recv.y = (unsigned)__shfl_xor((int)send.y, 16);
                        u32x4 o; if (odd) { o.x = recv.x; o.y = recv.y; o.z = mine.x; o.w = mine.y; } else { o.x = mine.x; o.y = mine.y; o.z = recv.x; o.w = recv.y; }
                        *(u32x4*)(yb + (size_t)ts * D + u.pn * 256 + bj * 128 + 32 * wc + 8 * (fq & ~1)) = o; } }
                asm volatile("" ::: "memory"); }
        } else {
#pragma unroll
            for (int ai = 0; ai < 2; ++ai) {
                u32x4 xw[4][2]; u32x2 yw[4][2]; u32x2 w8[4][2];
#pragma unroll
                for (int m = 0; m < 4; ++m)
#pragma unroll
                    for (int bj = 0; bj < 2; ++bj) { xw[m][bj] = *(const u32x4*)(xb + (size_t)tok[ai][m] * D + u.pn * 256 + EPI_COL0 + bj * 128); yw[m][bj] = *(const u32x2*)(y0 + (size_t)tok[ai][m] * D + u.pn * 256 + EPI_COL0 + bj * 128); }
#pragma unroll
                for (int m = 0; m < 4; ++m) { const float g = gt[ai][m]; float sq = 0.f; const int ts = tok[ai][m] + (tok[ai][m] >= T ? 1 : 0); bf16_t* rowp = xb + (size_t)ts * D + u.pn * 256 + EPI_COL0;
#pragma unroll
                    for (int bj = 0; bj < 2; ++bj) { const u32x4 x = xw[m][bj]; float y[8]; fp8x8_to_f32(yw[m][bj], y); f32x4 v0 = acc[ai][bj][m][0] * g, v1 = acc[ai][bj][m][1] * g;
                        v0[0] += bflo(x.x) + y[0] * ysc; v0[1] += bfhi(x.x) + y[1] * ysc; v0[2] += bflo(x.y) + y[2] * ysc; v0[3] += bfhi(x.y) + y[3] * ysc;
                        v1[0] += bflo(x.z) + y[4] * ysc; v1[1] += bfhi(x.z) + y[5] * ysc; v1[2] += bflo(x.w) + y[6] * ysc; v1[3] += bfhi(x.w) + y[7] * ysc;
                        const u32x4 w = pack8(v0, v1); *(u32x4*)(rowp + bj * 128) = w;
                        const float a0 = bflo(w.x), a1 = bfhi(w.x), a2 = bflo(w.y), a3 = bfhi(w.y), a4 = bflo(w.z), a5 = bfhi(w.z), a6 = bflo(w.w), a7 = bfhi(w.w);
                        w8[m][bj].x = pk4_fp8(a0, a1, a2, a3); w8[m][bj].y = pk4_fp8(a4, a5, a6, a7);
                        sq += (a0 * a0 + a1 * a1) + (a2 * a2 + a3 * a3) + (a4 * a4 + a5 * a5) + (a6 * a6 + a7 * a7); }
                    if (part) { sq += __shfl_xor(sq, 16); sq += __shfl_xor(sq, 32); if (fq == 0 && ts < T) part[(size_t)ts * 32 + u.pn * 4 + wc] = sq; } }
#pragma unroll
                for (int mp = 0; mp < 4; mp += 2) { const int msk = -(int)(fq & 1); const int tk = (tok[ai][mp] & ~msk) | (tok[ai][mp + 1] & msk); const int ts = tk + (tk >= T ? 1 : 0); const bool odd = fq & 1;
#pragma unroll
                    for (int bj = 0; bj < 2; ++bj) { const u32x2 mine = odd ? w8[mp + 1][bj] : w8[mp][bj], send = odd ? w8[mp][bj] : w8[mp + 1][bj];
                        u32x2 recv; recv.x = (unsigned)__shfl_xor((int)send.x, 16); recv.y = (unsigned)__shfl_xor((int)send.y, 16);
                        u32x4 o; if (odd) { o.x = recv.x; o.y = recv.y; o.z = mine.x; o.w = mine.y; } else { o.x = mine.x; o.y = mine.y; o.z = recv.x; o.w = recv.y; }
                        *(u32x4*)(x8 + (size_t)ts * D + u.pn * 256 + bj * 128 + 32 * wc + 8 * (fq & ~1)) = o; } }
                asm volatile("" ::: "memory"); }
        }
    }
};
struct SchedSp { pg8::SchedGrid g; __device__ __forceinline__ bool next(int i, Unit& u) const { if (!g.next(i, u)) return false; u.B = g.B0 + ((size_t)u.pm * 4 + u.pn) * (256 * 512); return true; } __device__ __forceinline__ int row(int, int) const { return 0; } };
struct SchedProj {
    int nN, qt, G, c; const char* A0; const char* B0; const char* BQ; char* C0; size_t c_pm; char* CQ; int rb;
    __device__ __forceinline__ bool next(int i, Unit& u) const {
        int pm, pn; if (!pg8::grid_order(i, G, c, T / 256, nN, pm, pn)) return false;
        u.pm = pm; u.pn = pn; u.aux = 0; u.nvalid = 256;
        if (qt) { u.A = A0 + (size_t)pm * 256 * rb; u.B = B0 + (size_t)pn * 256 * rb; u.C = C0 + (size_t)pm * c_pm + (size_t)pn * 512; }
        else { u.A = A0 + (size_t)pm * (256 * 2048); u.B = BQ + (size_t)(pm >> 6) * (1024 * 2048) + (size_t)pn * (256 * 2048); u.C = CQ + (size_t)pm * (256 * 3072) + (size_t)(2048 + pn * 256); }
        return true;
    }
    __device__ __forceinline__ int row(int, int) const { return 0; }
};
template <int MODE, class Sched> __device__ __forceinline__ void proj_fill_rstd(const Sched& S, const float* rs, LAS float* rtab) {
    Unit u; int tid = threadIdx.x;
    for (int j = 0; j < 6 && S.next(j, u); ++j)
        if (tid < 256) { const int t = u.pm * 256 + tid; float v;
            if (MODE == 0) v = rs[t];
            else { const f32x4* pp = (const f32x4*)(rs + (size_t)t * 32); float sm = 0.f;
#pragma unroll
                for (int q = 0; q < 8; ++q) { const f32x4 p = pp[q]; sm += (p[0] + p[1]) + (p[2] + p[3]); }
                v = __builtin_amdgcn_rsqf(sm * (1.0f / D) + EPS); }
            rtab[j * 256 + tid] = v; }
    __syncthreads();
}
struct SchedKV {
    int G, c; const char* memn; const char* wkv; char* kvn;
    __device__ __forceinline__ bool next(int i, Unit& u) const {
        const int id = i * G + c; if (id >= 32) return false;
        const int l = id >> 4, b = (id >> 3) & 1, j = id & 7;
        u.pm = 0; u.pn = 0; u.nvalid = 256; u.aux = 2048;
        u.A = memn + (size_t)l * (512 * 4096) + (size_t)b * (256 * 4096); u.B = wkv + (size_t)l * (2048 * 4096) + (size_t)j * (256 * 4096);
        u.C = kvn + (size_t)l * (512 * 4096) + (size_t)b * (256 * 4096) + (size_t)j * 512; return true;
    }
    __device__ __forceinline__ int row(int, int) const { return 0; }
};
struct SchedFold {
    int G, c; const char* woutT; const char* kvn; const char* grpn; char* bto; const char* wqn; char* winq; int mode; int nmax;
    __device__ __forceinline__ bool next(int i, Unit& u) const {
        const int id = i * G + c; if (id >= (mode ? 256 : 64) || (nmax && i >= nmax)) return false;
        u.pm = 0; u.pn = 0; u.nvalid = 256; u.aux = 0;
        if (mode == 0) { const int b = id >> 5, g = (id >> 3) & 3, rt = id & 7;
            u.A = woutT + (size_t)rt * (256 * 4096) + (size_t)g * 512; u.B = grpn + (size_t)g * 512;
            u.C = bto + (size_t)b * (2048 * 3072) + (size_t)rt * (256 * 3072) + (size_t)g * 512; u.aux = 1536; }
        else if (id < 128) { const int l = id >> 6, b = (id >> 5) & 1, h = (id >> 3) & 3, rt = id & 7;
            u.A = woutT + (size_t)l * (2048 * 4096) + (size_t)rt * (256 * 4096) + (size_t)(1024 + h * 256) * 2;
            u.B = kvn + (size_t)l * (512 * 4096) + (size_t)b * (256 * 4096) + (size_t)(1024 + h * 256) * 2;
            u.C = bto + (size_t)(l * 2 + b) * (2048 * 3072) + (size_t)rt * (256 * 3072) + (size_t)(2048 + h * 256); }
        else { const int r = id - 128, l = r >> 6, b = (r >> 5) & 1, h = (r >> 3) & 3, ct = r & 7;
            u.A = kvn + (size_t)l * (512 * 4096) + (size_t)b * (256 * 4096) + (size_t)h * 512;
            u.B = wqn + (size_t)l * (2048 * 4096) + (size_t)ct * (256 * 4096) + (size_t)h * 512;
            u.C = winq + (size_t)(l * 2 + b) * (1024 * 2048) + (size_t)h * (256 * 2048) + (size_t)ct * 256; u.aux = 1; }
        return true;
    }
    __device__ __forceinline__ int row(int, int) const { return 0; }
};

struct Args { const float* in[22]; float* out; unsigned char* ws; int ph_lo, ph_hi; };
struct Frame { LAS unsigned char* lds; LAS unsigned char* scr; int tid, lane, wave, G, bid; };

struct TrDesc { const float* W; void* WT; const float* ks; const float* ns; float cs; int ldw, kd, k0, n0; bool f8; };
__device__ __forceinline__ void tr_load(const TrDesc& d, f32x4 (&v)[16], int lane) {
    const int kq = lane >> 4, n4 = (lane & 15) * 4;
#pragma unroll
    for (int i = 0; i < 16; ++i) v[i] = *(const f32x4*)(d.W + (size_t)(d.k0 + 16 * kq + i) * d.ldw + d.n0 + n4);
}
__device__ __forceinline__ void tr_finish(const TrDesc& d, f32x4 (&v)[16], LAS unsigned* s32, int lane) {
    const int kq = lane >> 4, n4 = (lane & 15) * 4;
    f32x4 ns = (f32x4){d.cs, d.cs, d.cs, d.cs}; if (d.ns) ns = *(const f32x4*)(d.ns + d.n0 + n4) * d.cs;
    if (d.ks) {
#pragma unroll
        for (int q = 0; q < 4; ++q) { const f32x4 ks = *(const f32x4*)(d.ks + d.k0 + 16 * kq + 4 * q);
#pragma unroll
            for (int e = 0; e < 4; ++e) v[4 * q + e] = v[4 * q + e] * ks[e]; } }
#pragma unroll
    for (int i = 0; i < 16; ++i) v[i] = v[i] * ns;
    if (!d.f8) {
#pragma unroll
        for (int j = 0; j < 4; ++j)
#pragma unroll
            for (int p = 0; p < 8; ++p) s32[(n4 + j) * 33 + 8 * kq + p] = cvt_pk_bf16(v[2 * p][j], v[2 * p + 1][j]);
        LDS_WAIT(); asm volatile("" ::: "memory");
        const int c = lane & 7; bf16_t* WT = (bf16_t*)d.WT;
#pragma unroll
        for (int j = 0; j < 8; ++j) { const int n = (lane >> 3) + 8 * j; const LAS unsigned* sp = s32 + n * 33 + 4 * c;
            u32x4 o; o.x = sp[0]; o.y = sp[1]; o.z = sp[2]; o.w = sp[3];
            *(u32x4*)(WT + (size_t)(d.n0 + n) * d.kd + d.k0 + 8 * c) = o; }
    } else {
#pragma unroll
        for (int j = 0; j < 4; ++j)
#pragma unroll
            for (int p = 0; p < 4; ++p) s32[(n4 + j) * 17 + 4 * kq + p] = pk4_fp8(v[4 * p][j], v[4 * p + 1][j], v[4 * p + 2][j], v[4 * p + 3][j]);
        LDS_WAIT(); asm volatile("" ::: "memory");
        const int c = lane & 3; unsigned char* WT = (unsigned char*)d.WT;
#pragma unroll
        for (int j = 0; j < 4; ++j) { const int n = (lane >> 2) + 16 * j; const LAS unsigned* sp = s32 + n * 17 + 4 * c;
            u32x4 o; o.x = sp[0]; o.y = sp[1]; o.z = sp[2]; o.w = sp[3];
            *(u32x4*)(WT + (size_t)(d.n0 + n) * d.kd + d.k0 + 16 * c) = o; }
    }
    LDS_WAIT(); asm volatile("" ::: "memory");
}
__device__ __forceinline__ void tr_desc(TrDesc& d, const float* W, int K, int N, void* WT, const float* ks, const float* ns, float cs, bool f8, int item) {
    const int nblk = N / 64, kb = item / nblk, nb = item % nblk;
    d.W = W; d.WT = WT; d.ks = ks; d.ns = ns; d.cs = cs; d.ldw = N; d.kd = K; d.k0 = 64 * kb; d.n0 = 64 * nb; d.f8 = f8;
}

#define x_in (args.in[0])
#define mem_in (args.in[1])
#define norm_mix_g (args.in[2])
#define norm_mem_g (args.in[3])
#define norm_ffn_g (args.in[4])
#define pool_w_in (args.in[5])
#define pool_w_grp (args.in[6])
#define pool_scale (args.in[7])
#define pool_w_out (args.in[8])
#define sgu_w_in (args.in[9])
#define sgu_norm_g (args.in[10])
#define sgu_w_s (args.in[11])
#define sgu_b_s (args.in[12])
#define sgu_w_out (args.in[13])
#define xa_w_kv (args.in[14])
#define moe_w_group (args.in[15])
#define moe_b_group (args.in[16])
#define moe_w_expert (args.in[17])
#define moe_b_expert (args.in[18])
#define moe_w_gu (args.in[19])
#define moe_w_down (args.in[20])
#define final_norm_g (args.in[21])
#define WSP(type, off) ((type*)(args.ws + (off)))
#define RSTD0 WSP(float, WS_RSTD)
#define RSTD1 WSP(float, WS_RSTD + RSTD_STRIDE)
#define PART1 WSP(float, WS_PART1)
#define PART2 WSP(float, WS_PART2)
#define SSQV WSP(float, WS_SSQV)
#define LOGITS WSP(float, WS_LOGITS)
#define LIST WSP(int, WS_LIST)
#define GATEW WSP(float, WS_GATEW)
#define KMAT WSP(bf16_t, WS_KMAT)
#define VT WSP(bf16_t, WS_VT)
#define MEMN WSP(bf16_t, WS_MEMN)
#define WIN0 WSP(bf16_t, WS_WIN0)
#define WIN1 WSP(bf16_t, WS_WIN1)
#define WOUT WSP(bf16_t, WS_WOUT)
#define WKV WSP(bf16_t, WS_WKV)
#define GRP WSP(bf16_t, WS_GRP)
#define W2 WSP(bf16_t, WS_W2)
#define RT WSP(bf16_t, WS_RT)
#define GUT WSP(unsigned char, WS_GUT)
#define DOWNT WSP(unsigned char, WS_DOWNT)
#define XB WSP(bf16_t, WS_XB)
#define PROJ WSP(bf16_t, WS_PROJ)
#define POOLED WSP(bf16_t, WS_POOLED)
#define PBUF WSP(bf16_t, WS_PBUF)
#define CONCAT WSP(bf16_t, WS_CONCAT)
#define HIDDEN WSP(unsigned char, WS_HIDDEN)
#define CNTM WSP(int, WS_CNT)
#define TOTALS WSP(int, WS_CNT + 128 * 1024)
#define TOKREC WSP(u32x4, WS_TOKREC)
#define XB8 WSP(unsigned char, WS_XB8)
#define BTO WSP(bf16_t, WS_BTO)
#define GRPW WSP(bf16_t, WS_GRPW)
#define WQN WSP(bf16_t, WS_WQN)
#define WINQ WSP(unsigned char, WS_WINQ)
#define KVN WSP(bf16_t, WS_KMAT)
#define YB0 WSP(unsigned char, WS_PROJ)
#define YB1 WSP(unsigned char, WS_PROJ + 96 * MiB)

#ifndef PHMASK
#define PHMASK 0xffffffffu
#endif
#define IN(k) (((PHMASK >> (((k) < 3) ? (k) : ((k) == 23 ? 13 : 3 + ((k) - 3) % 10))) & 1u) && lo <= (k) && (k) < hi)
#ifndef PROBE_EPI2
#define PROBE_EPI2 false
#endif
#ifndef RMASK
#define RMASK 0u
#endif
#define PHASE(k) if (IN(k)) _Pragma("unroll") for (int rep_ = 0; rep_ < 1 + (int)((RMASK >> (k)) & 1u); ++rep_)
#define REPBAR() do { if (rep_) xcd_barrier(bar); } while (0)
#define SEAM(k) do { if (IN(k) && IN((k) + 1)) xcd_barrier(bar); } while (0)

constexpr int TAIL_PER0 = 4096, TAIL_PER1 = 2048, TAIL_WIN0 = 9, TAIL_WIN1 = 6, TAIL_ITEMS = TAIL_WIN0 * TAIL_PER0 + TAIL_WIN1 * TAIL_PER1;
constexpr int TAIL_HG = TAIL_ITEMS < 32768 ? TAIL_ITEMS : 32768, TAIL_HD = TAIL_ITEMS - TAIL_HG;
#define TAIL_DESC(d_, h_) do { const int hh_ = (h_); if (hh_ < 32768) { const int le_ = 32 + (hh_ >> 10); tr_desc(d_, moe_w_gu + (size_t)le_ * D * D, 2048, 2048, GUT + (size_t)le_ * D * D, norm_ffn_g + D, nullptr, GU_WS, true, hh_ & 1023); } \
        else { const int q_ = hh_ - 32768, le_ = 32 + (q_ >> 9); tr_desc(d_, moe_w_down + (size_t)le_ * DEXP * D, 1024, 2048, DOWNT + (size_t)le_ * DEXP * D, nullptr, nullptr, DN_WS, true, q_ & 511); } } while (0)
#define TAIL_CONVERT(w_) do { if ((l == 0) || (w_) < TAIL_WIN1) { const int tb_ = l == 0 ? (w_) * TAIL_PER0 : TAIL_WIN0 * TAIL_PER0 + (w_) * TAIL_PER1, tn_ = l == 0 ? TAIL_PER0 : TAIL_PER1; \
        __syncthreads(); LAS unsigned* tscr_ = (LAS unsigned*)(F.lds + F.wave * 16384); TrDesc dA_, dB_; f32x4 vA_[16], vB_[16]; \
        for (int j_ = gw; j_ < tn_; j_ += 2 * NGW) { const bool hasB_ = j_ + NGW < tn_; \
            TAIL_DESC(dA_, tb_ + j_); tr_load(dA_, vA_, F.lane); if (hasB_) { TAIL_DESC(dB_, tb_ + j_ + NGW); tr_load(dB_, vB_, F.lane); } \
            tr_finish(dA_, vA_, tscr_, F.lane); if (hasB_) tr_finish(dB_, vB_, tscr_, F.lane); } } } while (0)
template <int l> __device__ __forceinline__ void layer_phases(const Args& args, const Frame& F, const XcdBarrier& bar, unsigned* ctl, const int lo, const int hi, const int gw, const int NGW, const int gt, const int NGT) {
#ifdef LMASK
        if (!((LMASK >> l) & 1)) return;
#endif
        constexpr int pb = 3 + 10 * l;
        const int ldp = l ? 3072 : 2048, qoff = l ? 2048 : 1024;
        float* RS1 = (float*)((char*)RSTD1 + (size_t)l * RSTD_STRIDE); float* P1 = PART1 + (size_t)l * T * 32;
        PHASE(pb + 0) { REPBAR();
            if (l == 0) {
                if (F.G < EARLY_PLAIN_MIN_G)
                { SchedProj S{4, 4, F.G, F.bid, (const char*)XB, (const char*)WIN0, nullptr, (char*)PROJ, (size_t)256 * 2048 * 2, nullptr, 4096};
                  LAS float* rtab = (LAS float*)(F.scr + SCR_IDX); proj_fill_rstd<0>(S, RSTD0, rtab); EpiProj<0> E{2048, RSTD0, nullptr, 4, rtab, 1.f};
                  pg8::gemm_phase<EpiProj<0>, SchedProj, false>(F.lds, F.scr, 2048, 4096u, 4096u, (size_t)128 * 4096, S, E); }
                const bool early = F.G >= EARLY_PLAIN_MIN_G, poolfirst = early && (F.bid & 1);
                if (poolfirst) {
                for (int it = gt; it < (T / 32) * 128; it += NGT) {
                    const int chunk = it & 127, rb = it >> 7, c0 = chunk * 8, g = c0 >> 8, w = 2 << g, t0 = rb * 32, tl0 = t0 & (SEQ - 1);
                    const bf16_t* pp = PROJ + (size_t)t0 * 2048 + c0; bf16_t* op = CONCAT + (size_t)t0 * 1536 + c0; float s[8];
#pragma unroll
                    for (int j = 0; j < 8; ++j) s[j] = 0.f;
                    for (int j = 1; j < w; ++j) if (tl0 - j >= 0) { const u32x4 v = *(const u32x4*)(pp - (size_t)j * 2048);
                        s[0] += bflo(v.x); s[1] += bfhi(v.x); s[2] += bflo(v.y); s[3] += bfhi(v.y); s[4] += bflo(v.z); s[5] += bfhi(v.z); s[6] += bflo(v.w); s[7] += bfhi(v.w); }
#pragma unroll 8
                    for (int r = 0; r < 32; ++r) { const int tl = tl0 + r; const u32x4 v = *(const u32x4*)(pp + (size_t)r * 2048); float p[8] = {bflo(v.x), bfhi(v.x), bflo(v.y), bfhi(v.y), bflo(v.z), bfhi(v.z), bflo(v.w), bfhi(v.w)};
                        const float inv = 1.0f / (float)(tl + 1 < w ? tl + 1 : w); float o[8];
#pragma unroll
                        for (int j = 0; j < 8; ++j) { s[j] += p[j]; o[j] = s[j] * inv - p[j]; }
                        u32x4 ow; ow.x = pk2(o[0], o[1]); ow.y = pk2(o[2], o[3]); ow.z = pk2(o[4], o[5]); ow.w = pk2(o[6], o[7]); *(u32x4*)(op + (size_t)r * 1536) = ow;
                        if (tl - (w - 1) >= 0) { const u32x4 q = *(const u32x4*)(pp + (size_t)(r - (w - 1)) * 2048);
                            s[0] -= bflo(q.x); s[1] -= bfhi(q.x); s[2] -= bflo(q.y); s[3] -= bfhi(q.y); s[4] -= bflo(q.z); s[5] -= bfhi(q.z); s[6] -= bflo(q.w); s[7] -= bfhi(q.w); } }
                }
                                }
                { SchedProj S{4, 0, F.G, F.bid, (const char*)XB8, nullptr, (const char*)WINQ, nullptr, 0, (char*)CONCAT};
                  LAS float* rtab = (LAS float*)(F.scr + SCR_IDX); proj_fill_rstd<0>(S, RSTD0, rtab); EpiScore<0> E{rtab};
                  pg8::gemm_phase<EpiScore<0>, SchedProj, false, true>(F.lds, F.scr, 1024, 2048u, 2048u, (size_t)128 * 2048, S, E); }
                if (early && !poolfirst) {
                for (int it = gt; it < (T / 32) * 128; it += NGT) {
                    const int chunk = it & 127, rb = it >> 7, c0 = chunk * 8, g = c0 >> 8, w = 2 << g, t0 = rb * 32, tl0 = t0 & (SEQ - 1);
                    const bf16_t* pp = PROJ + (size_t)t0 * 2048 + c0; bf16_t* op = CONCAT + (size_t)t0 * 1536 + c0; float s[8];
#pragma unroll
                    for (int j = 0; j < 8; ++j) s[j] = 0.f;
                    for (int j = 1; j < w; ++j) if (tl0 - j >= 0) { const u32x4 v = *(const u32x4*)(pp - (size_t)j * 2048);
                        s[0] += bflo(v.x); s[1] += bfhi(v.x); s[2] += bflo(v.y); s[3] += bfhi(v.y); s[4] += bflo(v.z); s[5] += bfhi(v.z); s[6] += bflo(v.w); s[7] += bfhi(v.w); }
#pragma unroll 8
                    for (int r = 0; r < 32; ++r) { const int tl = tl0 + r; const u32x4 v = *(const u32x4*)(pp + (size_t)r * 2048); float p[8] = {bflo(v.x), bfhi(v.x), bflo(v.y), bfhi(v.y), bflo(v.z), bfhi(v.z), bflo(v.w), bfhi(v.w)};
                        const float inv = 1.0f / (float)(tl + 1 < w ? tl + 1 : w); float o[8];
#pragma unroll
                        for (int j = 0; j < 8; ++j) { s[j] += p[j]; o[j] = s[j] * inv - p[j]; }
                        u32x4 ow; ow.x = pk2(o[0], o[1]); ow.y = pk2(o[2], o[3]); ow.z = pk2(o[4], o[5]); ow.w = pk2(o[6], o[7]); *(u32x4*)(op + (size_t)r * 1536) = ow;
                        if (tl - (w - 1) >= 0) { const u32x4 q = *(const u32x4*)(pp + (size_t)(r - (w - 1)) * 2048);
                            s[0] -= bflo(q.x); s[1] -= bfhi(q.x); s[2] -= bflo(q.y); s[3] -= bfhi(q.y); s[4] -= bflo(q.z); s[5] -= bfhi(q.z); s[6] -= bflo(q.w); s[7] -= bfhi(q.w); } }
                }
                                }
            } else {
                { SchedProj S{8, 8, F.G, F.bid, (const char*)XB8, (const char*)WIN1, nullptr, (char*)PROJ, (size_t)256 * 3072 * 2, nullptr, 2048};
                  LAS float* rtab = (LAS float*)(F.scr + SCR_IDX); proj_fill_rstd<1>(S, PART2, rtab); EpiProj<1> E{3072, PART2, SSQV, 8, rtab, 1.f / WIN_S};
                  pg8::gemm_phase<EpiProj<1>, SchedProj, false, true>(F.lds, F.scr, 1024, 2048u, 2048u, (size_t)128 * 2048, S, E); }
            }
            TAIL_CONVERT(0);
        }
        SEAM(pb + 0);
        PHASE(pb + 1) { REPBAR();
            if (l == 0) {
                if (F.G < EARLY_PLAIN_MIN_G) {
                for (int it = gt; it < (T / 32) * 128; it += NGT) {
                    const int chunk = it & 127, rb = it >> 7, c0 = chunk * 8, g = c0 >> 8, w = 2 << g, t0 = rb * 32, tl0 = t0 & (SEQ - 1);
                    const bf16_t* pp = PROJ + (size_t)t0 * 2048 + c0; bf16_t* op = CONCAT + (size_t)t0 * 1536 + c0; float s[8];
#pragma unroll
                    for (int j = 0; j < 8; ++j) s[j] = 0.f;
                    for (int j = 1; j < w; ++j) if (tl0 - j >= 0) { const u32x4 v = *(const u32x4*)(pp - (size_t)j * 2048);
                        s[0] += bflo(v.x); s[1] += bfhi(v.x); s[2] += bflo(v.y); s[3] += bfhi(v.y); s[4] += bflo(v.z); s[5] += bfhi(v.z); s[6] += bflo(v.w); s[7] += bfhi(v.w); }
#pragma unroll 8
                    for (int r = 0; r < 32; ++r) { const int tl = tl0 + r; const u32x4 v = *(const u32x4*)(pp + (size_t)r * 2048); float p[8] = {bflo(v.x), bfhi(v.x), bflo(v.y), bfhi(v.y), bflo(v.z), bfhi(v.z), bflo(v.w), bfhi(v.w)};
                        const float inv = 1.0f / (float)(tl + 1 < w ? tl + 1 : w); float o[8];
#pragma unroll
                        for (int j = 0; j < 8; ++j) { s[j] += p[j]; o[j] = s[j] * inv - p[j]; }
                        u32x4 ow; ow.x = pk2(o[0], o[1]); ow.y = pk2(o[2], o[3]); ow.z = pk2(o[4], o[5]); ow.w = pk2(o[6], o[7]); *(u32x4*)(op + (size_t)r * 1536) = ow;
                        if (tl - (w - 1) >= 0) { const u32x4 q = *(const u32x4*)(pp + (size_t)(r - (w - 1)) * 2048);
                            s[0] -= bflo(q.x); s[1] -= bfhi(q.x); s[2] -= bflo(q.y); s[3] -= bfhi(q.y); s[4] -= bflo(q.z); s[5] -= bfhi(q.z); s[6] -= bflo(q.w); s[7] -= bfhi(q.w); } }
                }
                }
            } else {
                const bool sfirst = !(F.bid & 1);
                if (sfirst) {
                { SchedProj S{4, 0, F.G, F.bid, (const char*)XB8, nullptr, (const char*)(WINQ + (size_t)2 * 1024 * D), nullptr, 0, (char*)CONCAT};
                  LAS float* rtab = (LAS float*)(F.scr + SCR_IDX); proj_fill_rstd<1>(S, PART2, rtab); EpiScore<1> E{rtab};
                  pg8::gemm_phase<EpiScore<1>, SchedProj, false, true>(F.lds, F.scr, 1024, 2048u, 2048u, (size_t)128 * 2048, S, E); }
                  __syncthreads(); }
                pg8::SchedGrid S{T / 256, 4, F.G, F.bid, (const char*)W2, 0, (size_t)256 * 512, (const char*)POOLED, 0, (size_t)256 * 512, (char*)CONCAT + 1024, (size_t)256 * 3072, 256};
                SchedSp S2{S};
                LAS bf16_t* Ts = (LAS bf16_t*)F.lds; LAS float* rsv = (LAS float*)(F.lds + 128 * 264 * 2);
                Unit uu;
                for (int it = 0; S2.next(it >> 1, uu); ++it) { const int win = uu.pm, g = uu.pn, half = it & 1;
                    if (F.tid < 256) { const f32x4* pp = (const f32x4*)(SSQV + (size_t)(win * 256 + F.tid) * 16); const f32x4 a = pp[0], b = pp[1], c = pp[2], d = pp[3];
                        const float s = ((a[0] + a[1]) + (a[2] + a[3])) + ((b[0] + b[1]) + (b[2] + b[3])) + ((c[0] + c[1]) + (c[2] + c[3])) + ((d[0] + d[1]) + (d[2] + d[3]));
                        rsv[F.tid] = __builtin_amdgcn_rsqf(s * (1.0f / 1024.0f) + EPS); }
                    __syncthreads();
                    { const int r8 = F.tid >> 4, ch = F.tid & 15, cg = g * 256 + half * 128 + ch * 8; float ng[8];
#pragma unroll
                      for (int j = 0; j < 8; ++j) ng[j] = sgu_norm_g[cg + j];
#pragma unroll
                      for (int st = 0; st < 8; ++st) { const int s = st * 32 + r8; const u32x4 v = *(const u32x4*)(PROJ + (size_t)(win * 256 + s) * 3072 + 1024 + cg); const float rs = rsv[s];
                          const float p[8] = {bflo(v.x), bfhi(v.x), bflo(v.y), bfhi(v.y), bflo(v.z), bfhi(v.z), bflo(v.w), bfhi(v.w)};
#pragma unroll
                          for (int j = 0; j < 8; ++j) Ts[(ch * 8 + j) * 264 + s] = (bf16_t)f2bf(p[j] * rs * ng[j]); } }
                    __syncthreads();
                    { const int c = F.tid >> 5, sc = F.tid & 31; bf16_t* ob = POOLED + ((size_t)(win * 4 + g) * 256 + half * 128) * 256;
#pragma unroll
                      for (int st = 0; st < 8; ++st) { const int cc = st * 16 + c; *(u32x4*)(ob + (size_t)cc * 256 + sc * 8) = *(const LAS u32x4*)(Ts + cc * 264 + sc * 8); } }
                    __syncthreads();
                }
                __syncthreads();
                EpiSpatial E{PROJ, sgu_b_s};
                pg8::gemm_phase<EpiSpatial, SchedSp, false>(F.lds, F.scr, 256, 512u, 512u, (size_t)128 * 512, S2, E);
                if (!sfirst) {
                { SchedProj S{4, 0, F.G, F.bid, (const char*)XB8, nullptr, (const char*)(WINQ + (size_t)2 * 1024 * D), nullptr, 0, (char*)CONCAT};
                  LAS float* rtab = (LAS float*)(F.scr + SCR_IDX); proj_fill_rstd<1>(S, PART2, rtab); EpiScore<1> E{rtab};
                  pg8::gemm_phase<EpiScore<1>, SchedProj, false, true>(F.lds, F.scr, 1024, 2048u, 2048u, (size_t)128 * 2048, S, E); }
                }
            }
            if (!(l == 0 && F.G >= EARLY_PLAIN_MIN_G)) TAIL_CONVERT(1);
        }
        if (!(l == 0 && F.G >= EARLY_PLAIN_MIN_G)) SEAM(pb + 1);
        PHASE(pb + 3) { REPBAR();
            pg8::SchedGrid S{T / 256, 8, F.G, F.bid, (const char*)CONCAT + (l ? 1024 : 0), (size_t)256 * 3072, 0, (const char*)(BTO + (size_t)l * 2 * (2048 * 1536)) + (l ? 1024 : 0), (size_t)2048 * 3072, (size_t)256 * 3072, (char*)XB, (size_t)256 * 4096, 512};
            EpiOut E{P1, XB8, rep_ ? 0.f : 1.0f / F_S};
            if constexpr (l == 1) pg8::gemm_phase<EpiOut, pg8::SchedGrid, false, true>(F.lds, F.scr, 1024, 3072u, 3072u, (size_t)128 * 3072, S, E);
            else pg8::gemm_phase<EpiOut, pg8::SchedGrid, false, false, false, false, 16>(F.lds, F.scr, 1536, 3072u, 3072u, (size_t)128 * 3072, S, E);
            TAIL_CONVERT(2);
        }
        SEAM(pb + 3);
        PHASE(pb + 4) { REPBAR();
            pg8::SchedGrid S{T / 256, 2, F.G, F.bid, (const char*)XB, (size_t)256 * 4096, 2048, (const char*)(RT + (size_t)l * 256 * 2048), 0, 2048, (char*)LOGITS, 0, 0};
            EpiRoute E{LOGITS};
            pg8::gemm_phase<EpiRoute, pg8::SchedGrid, false>(F.lds, F.scr, 1024, 4096u, 4096u, (size_t)128 * 4096, S, E);
            TAIL_CONVERT(3);
        }
        SEAM(pb + 4);
        PHASE(pb + 5) { REPBAR();
            LAS int* hc = (LAS int*)(F.scr + SCR_TAB);
            for (int t0 = F.bid * 128; t0 < T; t0 += F.G * 128) {
                if (F.tid < 64) hc[F.tid] = 0;
                __syncthreads();
                const int t = t0 + F.tid;
                if (F.tid < 128) {
                    const f32x4* pp = (const f32x4*)(P1 + (size_t)t * 8); const f32x4 pa = pp[0], pb_ = pp[1]; const float s = ((pa[0] + pa[1]) + (pa[2] + pa[3])) + ((pb_[0] + pb_[1]) + (pb_[2] + pb_[3]));
                    const float rstd = __builtin_amdgcn_rsqf(s * (1.0f / D) + EPS); RS1[t] = rstd;
                    const float* la = LOGITS + (size_t)t * 64; const float* lb = la + (size_t)T * 64;
                    float gl[4]; int gi = 0;
#pragma unroll
                    for (int j = 0; j < 4; ++j) gl[j] = (la[j] + lb[j]) * rstd + moe_b_group[l * 4 + j];
#pragma unroll
                    for (int j = 1; j < 4; ++j) if (gl[j] > gl[gi]) gi = j;
                    float gs = 0.f;
#pragma unroll
                    for (int j = 0; j < 4; ++j) gs += __expf(gl[j] - gl[gi]);
                    const float pg = 1.0f / gs;
                    float el[8];
#pragma unroll
                    for (int j = 0; j < 8; ++j) el[j] = (la[4 + gi * 8 + j] + lb[4 + gi * 8 + j]) * rstd + moe_b_expert[l * 32 + gi * 8 + j];
                    int i0 = 0;
#pragma unroll
                    for (int j = 1; j < 8; ++j) if (el[j] > el[i0]) i0 = j;
                    int i1 = (i0 == 0) ? 1 : 0;
#pragma unroll
                    for (int j = 0; j < 8; ++j) if (j != i0 && el[j] > el[i1]) i1 = j;
                    const float x1 = __expf(el[i1] - el[i0]); const float tp0 = 1.0f / (1.0f + x1), tp1 = x1 / (1.0f + x1);
                    const int e0 = gi * 8 + i0, e1 = gi * 8 + i1;
                    const int r0 = __hip_atomic_fetch_add(&hc[e0], 1, __ATOMIC_RELAXED, __HIP_MEMORY_SCOPE_WORKGROUP), r1 = __hip_atomic_fetch_add(&hc[32 + e1], 1, __ATOMIC_RELAXED, __HIP_MEMORY_SCOPE_WORKGROUP);
                    u32x4 rec; rec.x = (unsigned)e0 | ((unsigned)e1 << 8) | ((unsigned)r0 << 16) | ((unsigned)r1 << 24); rec.y = __float_as_uint(pg * tp0); rec.z = __float_as_uint(pg * tp1); rec.w = 0u;
                    TOKREC[t] = rec;
                }
                __syncthreads();
                if (F.tid < 64) CNTM[(t0 >> 7) * 64 + F.tid] = hc[F.tid];
                __syncthreads();
            }
            TAIL_CONVERT(4);
        }
        SEAM(pb + 5);
        PHASE(pb + 6) { REPBAR();
            LAS int* ps = (LAS int*)(F.scr + SCR_IDX);
            LAS int* hb = (LAS int*)(F.scr + SCR_TAB);
            for (int t0 = F.bid * 128; t0 < T; t0 += F.G * 128) {
                const int blk = t0 >> 7, li = F.tid & 63, part = F.tid >> 6; int full = 0, upto = 0;
                for (int w = part * 32; w < part * 32 + 32; ++w) { const int c = CNTM[w * 64 + li]; full += c; upto += (w < blk) ? c : 0; }
                ps[part * 64 + li] = full; ps[512 + part * 64 + li] = upto;
                __syncthreads();
                if (F.tid < 64) { int base = 0, tot = 0;
#pragma unroll
                    for (int p = 0; p < 8; ++p) { tot += ps[p * 64 + F.tid]; base += ps[512 + p * 64 + F.tid]; }
                    hb[F.tid] = base; if (blk == 0) TOTALS[l * 64 + F.tid] = tot; }
                __syncthreads();
                if (F.tid < 128) { const int t = t0 + F.tid; const u32x4 rec = TOKREC[t]; const int e0 = rec.x & 255, e1 = (rec.x >> 8) & 255, r0 = (rec.x >> 16) & 255, r1 = rec.x >> 24;
                    const int p0 = hb[e0] + r0, p1 = hb[32 + e1] + r1;
                    LIST[(size_t)e0 * T + p0] = t; GATEW[(size_t)e0 * T + p0] = __uint_as_float(rec.y); LIST[(size_t)(32 + e1) * T + p1] = t; GATEW[(size_t)(32 + e1) * T + p1] = __uint_as_float(rec.z); }
                __syncthreads();
            }
            TAIL_CONVERT(5);
        }
        SEAM(pb + 6);
        { constexpr int ph = 0;
            if (!(l == 1 && ph == 2)) PHASE(pb + 7 + ph) { REPBAR();
                LAS int* cnt = (LAS int*)(F.scr + SCR_TAB); LAS int* pre = cnt + 64; LAS int* preB = cnt + 130; LAS int* preS = cnt + 196; LAS int* idx = (LAS int*)(F.scr + SCR_IDX);
                SchedMoe S; S.pre = pre; S.cnt = cnt; S.idx = idx; S.preB = preB; S.preS = preS; S.G = F.G; S.c = F.bid; S.ul = cnt + 264; S.nmy = 0; S.perm = 0;
                if (ph == 0) { S.lo = 0; S.hi = 64; S.mode = 0; S.perm = 1; S.A0 = (const char*)XB8; S.B0 = (const char*)(GUT + (size_t)l * 32 * D * D); S.C0 = (char*)HIDDEN; }
                else { S.lo = (ph == 1) ? 0 : 32; S.hi = (ph == 1 && l == 0) ? 32 : 64; S.mode = 1; S.perm = (ph == 1 && l == 1) ? 1 : 0; S.A0 = (const char*)HIDDEN; S.B0 = (const char*)(DOWNT + (size_t)l * 32 * DEXP * D); S.C0 = nullptr; }
                if (ph == 0) {
                    moe_setup<0>(S, TOTALS + l * 64, LIST, RS1);
                    EpiGu E{RS1, idx};
                    pg8::gemm_phase<EpiGu, SchedMoe, true, true, true>(F.lds, F.scr, 1024, 2048u, 2048u, (size_t)1024 * 2048, S, E);
                } else if (ph == 1) {
                    moe_setup<1>(S, TOTALS + l * 64, LIST, GATEW);
                    EpiDown<0> E{XB, YB0, YB1, idx, nullptr, 1.0f / (HID_S * DN_WS), 0.f, nullptr};
                    pg8::gemm_phase<EpiDown<0>, SchedMoe, false, true, true>(F.lds, F.scr, 512, 1024u, 1024u, (size_t)128 * 1024, S, E);
                } else {
                    moe_setup<1>(S, TOTALS + l * 64, LIST, GATEW);
                    EpiDown<1> E{XB, YB0, YB1, idx, PART2, rep_ ? 0.f : 1.0f / (HID_S * DN_WS), rep_ ? 0.f : 1.0f / Y_S, XB8};
                    pg8::gemm_phase<EpiDown<1>, SchedMoe, false, true, true>(F.lds, F.scr, 512, 1024u, 1024u, (size_t)128 * 1024, S, E);
                }
                __syncthreads();
                TAIL_CONVERT(6 + ph);
            }
            if (!(l == 1 && ph == 2)) SEAM(pb + 7 + ph);
        }
        { constexpr int ph = 1;
            if (!(l == 1 && ph == 2)) PHASE(pb + 7 + ph) { REPBAR();
                LAS int* cnt = (LAS int*)(F.scr + SCR_TAB); LAS int* pre = cnt + 64; LAS int* preB = cnt + 130; LAS int* preS = cnt + 196; LAS int* idx = (LAS int*)(F.scr + SCR_IDX);
                SchedMoe S; S.pre = pre; S.cnt = cnt; S.idx = idx; S.preB = preB; S.preS = preS; S.G = F.G; S.c = F.bid; S.ul = cnt + 264; S.nmy = 0; S.perm = 0;
                if (ph == 0) { S.lo = 0; S.hi = 64; S.mode = 0; S.perm = 1; S.A0 = (const char*)XB8; S.B0 = (const char*)(GUT + (size_t)l * 32 * D * D); S.C0 = (char*)HIDDEN; }
                else { S.lo = (ph == 1) ? 0 : 32; S.hi = (ph == 1 && l == 0) ? 32 : 64; S.mode = 1; S.perm = (ph == 1 && l == 1) ? 1 : 0; S.A0 = (const char*)HIDDEN; S.B0 = (const char*)(DOWNT + (size_t)l * 32 * DEXP * D); S.C0 = nullptr; }
                if (ph == 0) {
                    moe_setup<0>(S, TOTALS + l * 64, LIST, RS1);
                    EpiGu E{RS1, idx};
                    pg8::gemm_phase<EpiGu, SchedMoe, true, true, true>(F.lds, F.scr, 1024, 2048u, 2048u, (size_t)1024 * 2048, S, E);
                } else if (ph == 1) {
                    moe_setup<1>(S, TOTALS + l * 64, LIST, GATEW);
                    EpiDown<0> E{XB, YB0, YB1, idx, nullptr, 1.0f / (HID_S * DN_WS), 0.f, nullptr};
                    pg8::gemm_phase<EpiDown<0>, SchedMoe, false, true, true>(F.lds, F.scr, 512, 1024u, 1024u, (size_t)128 * 1024, S, E);
                } else {
                    moe_setup<1>(S, TOTALS + l * 64, LIST, GATEW);
                    EpiDown<1> E{XB, YB0, YB1, idx, PART2, rep_ ? 0.f : 1.0f / (HID_S * DN_WS), rep_ ? 0.f : 1.0f / Y_S, XB8};
                    pg8::gemm_phase<EpiDown<1>, SchedMoe, false, true, true>(F.lds, F.scr, 512, 1024u, 1024u, (size_t)128 * 1024, S, E);
                }
                __syncthreads();
                TAIL_CONVERT(6 + ph);
            }
            if (!(l == 1 && ph == 2)) SEAM(pb + 7 + ph);
        }
        { constexpr int ph = 2;
            if (!(l == 1 && ph == 2)) PHASE(pb + 7 + ph) { REPBAR();
                LAS int* cnt = (LAS int*)(F.scr + SCR_TAB); LAS int* pre = cnt + 64; LAS int* preB = cnt + 130; LAS int* preS = cnt + 196; LAS int* idx = (LAS int*)(F.scr + SCR_IDX);
                SchedMoe S; S.pre = pre; S.cnt = cnt; S.idx = idx; S.preB = preB; S.preS = preS; S.G = F.G; S.c = F.bid; S.ul = cnt + 264; S.nmy = 0; S.perm = 0;
                if (ph == 0) { S.lo = 0; S.hi = 64; S.mode = 0; S.perm = 1; S.A0 = (const char*)XB8; S.B0 = (const char*)(GUT + (size_t)l * 32 * D * D); S.C0 = (char*)HIDDEN; }
                else { S.lo = (ph == 1) ? 0 : 32; S.hi = (ph == 1 && l == 0) ? 32 : 64; S.mode = 1; S.perm = (ph == 1 && l == 1) ? 1 : 0; S.A0 = (const char*)HIDDEN; S.B0 = (const char*)(DOWNT + (size_t)l * 32 * DEXP * D); S.C0 = nullptr; }
                if (ph == 0) {
                    moe_setup<0>(S, TOTALS + l * 64, LIST, RS1);
                    EpiGu E{RS1, idx};
                    pg8::gemm_phase<EpiGu, SchedMoe, true, true, true>(F.lds, F.scr, 1024, 2048u, 2048u, (size_t)1024 * 2048, S, E);
                } else if (ph == 1) {
                    moe_setup<1>(S, TOTALS + l * 64, LIST, GATEW);
                    EpiDown<0> E{XB, YB0, YB1, idx, nullptr, 1.0f / (HID_S * DN_WS), 0.f, nullptr};
                    pg8::gemm_phase<EpiDown<0>, SchedMoe, false, true, true>(F.lds, F.scr, 512, 1024u, 1024u, (size_t)128 * 1024, S, E);
                } else {
                    moe_setup<1>(S, TOTALS + l * 64, LIST, GATEW);
                    EpiDown<1> E{XB, YB0, YB1, idx, PART2, rep_ ? 0.f : 1.0f / (HID_S * DN_WS), rep_ ? 0.f : 1.0f / Y_S, XB8};
                    pg8::gemm_phase<EpiDown<1>, SchedMoe, false, true, true>(F.lds, F.scr, 512, 1024u, 1024u, (size_t)128 * 1024, S, E);
                }
                __syncthreads();
                TAIL_CONVERT(6 + ph);
            }
            if (!(l == 1 && ph == 2)) SEAM(pb + 7 + ph);
        }
}
__global__ void __launch_bounds__(NWAVES * 64, 2) fwd(Args args) {
    extern __shared__ __attribute__((aligned(16))) unsigned char lds_raw[];
    Frame F; F.lds = (LAS unsigned char*)lds_raw; F.scr = F.lds + SCR_OFF;
    F.tid = threadIdx.x; F.lane = F.tid & 63; F.wave = rfl(F.tid >> 6); F.G = gridDim.x; F.bid = blockIdx.x;
    volatile LAS unsigned* MISC = (volatile LAS unsigned*)(F.lds + MISC_OFF);
    unsigned* ctl = (unsigned*)(args.ws + WS_CTL);
    if (F.tid < 32) MISC[F.tid] = 0u;
    __syncthreads();
    XcdBarrier bar; bar.bar = ctl + CW_BAR; bar.x = 0; bar.st = nullptr;
    if (!MK_PER_PHASE) bar = xcd_barrier_post(ctl + CW_BAR, MISC + 8);
    const int lo = args.ph_lo, hi = args.ph_hi;

    const int gw = F.bid * NWAVES + F.wave, NGW = F.G * NWAVES;
    const int gt = F.bid * (NWAVES * 64) + F.tid, NGT = F.G * NWAVES * 64;
    constexpr int I_SQ = (2048 / 64) * (2048 / 64), I_IN1 = (2048 / 64) * (3072 / 64), I_DN = (1024 / 64) * (2048 / 64);
    constexpr int NSMALL = I_SQ + I_IN1 + 2 * I_SQ + 2 * I_SQ;
    PHASE(0) { REPBAR();
        LAS unsigned* scr = (LAS unsigned*)(F.lds + F.wave * 16384);
        for (int m = gw; m < T; m += NGW) {
            const f32x4* xr = (const f32x4*)(x_in + (size_t)m * D) + F.lane * 2; unsigned* o = (unsigned*)(XB + (size_t)m * D) + F.lane * 4; float s = 0.f;
#pragma unroll
            for (int j = 0; j < 4; ++j) { const f32x4 a = xr[128 * j], b = xr[128 * j + 1]; u32x4 w; w.x = pk2(a[0], a[1]); w.y = pk2(a[2], a[3]); w.z = pk2(b[0], b[1]); w.w = pk2(b[2], b[3]);
                const float a0 = bflo(w.x), a1 = bfhi(w.x), a2 = bflo(w.y), a3 = bfhi(w.y), a4 = bflo(w.z), a5 = bfhi(w.z), a6 = bflo(w.w), a7 = bfhi(w.w);
                s += (a0 * a0 + a1 * a1) + (a2 * a2 + a3 * a3) + (a4 * a4 + a5 * a5) + (a6 * a6 + a7 * a7);
                u32x2 w8; w8.x = pk4_fp8(a0, a1, a2, a3); w8.y = pk4_fp8(a4, a5, a6, a7); *(u32x2*)(XB8 + (size_t)m * D + 512 * j + 8 * F.lane) = w8;
                *(u32x4*)(o + 256 * j) = w; }
            s = wave_sum(s); if (F.lane == 0) RSTD0[m] = __builtin_amdgcn_rsqf(s * (1.0f / D) + EPS);
        }
        if (gt < D / 2) ((unsigned*)(XB + (size_t)T * D))[gt] = 0u;
        if (gt < D / 4) ((unsigned*)(XB8 + (size_t)T * D))[gt] = 0u;
        if (gt == 0) { RSTD0[T] = 0.f; RSTD1[T] = 0.f; ((float*)((char*)RSTD1 + RSTD_STRIDE))[T] = 0.f; }
        for (int m = gw; m < 2 * 512; m += NGW) { const int l = m >> 9, r = m & 511;
            const f32x4* xr = (const f32x4*)(mem_in + (size_t)r * D) + F.lane * 2; const f32x4* gr = (const f32x4*)(norm_mem_g + (size_t)l * D) + F.lane * 2; f32x4 a[4], b[4]; float s = 0.f;
#pragma unroll
            for (int j = 0; j < 4; ++j) { a[j] = xr[128 * j]; b[j] = xr[128 * j + 1]; s += (a[j][0] * a[j][0] + a[j][1] * a[j][1]) + (a[j][2] * a[j][2] + a[j][3] * a[j][3]) + (b[j][0] * b[j][0] + b[j][1] * b[j][1]) + (b[j][2] * b[j][2] + b[j][3] * b[j][3]); }
            const float rstd = __builtin_amdgcn_rsqf(wave_sum(s) * (1.0f / D) + EPS); unsigned* o = (unsigned*)(MEMN + (size_t)m * D) + F.lane * 4;
#pragma unroll
            for (int j = 0; j < 4; ++j) { const f32x4 ga = gr[128 * j], gb = gr[128 * j + 1]; u32x4 w; w.x = pk2(a[j][0] * rstd * ga[0], a[j][1] * rstd * ga[1]); w.y = pk2(a[j][2] * rstd * ga[2], a[j][3] * rstd * ga[3]);
                w.z = pk2(b[j][0] * rstd * gb[0], b[j][1] * rstd * gb[1]); w.w = pk2(b[j][2] * rstd * gb[2], b[j][3] * rstd * gb[3]); *(u32x4*)(o + 256 * j) = w; }
        }
        for (int i = gt; i < 2 * 256 * 2048; i += NGT) { const int l = i >> 19, n = (i >> 11) & 255, k = i & 2047, j = n & 127; float w = 0.f;
            if (j < 4) w = moe_w_group[((size_t)l * D + k) * 4 + j]; else if (j < 36) w = moe_w_expert[((size_t)l * D + k) * 32 + (j - 4)];
            w *= norm_ffn_g[l * D + k]; const unsigned hi16 = f2bf(w); const float lof = w - __uint_as_float(hi16 << 16);
            RT[i] = (bf16_t)(n < 128 ? hi16 : f2bf(lof)); }
        for (int i = gt; i < 4 * 256 * 256; i += NGT) { const int g = i >> 16, t = (i >> 8) & 255, s = i & 255; float w = 0.f;
            if ((t >> 7) == (s >> 7) && (s & 127) <= (t & 127)) w = sgu_w_s[((size_t)g * 128 + (t & 127)) * 128 + (s & 127)];
            W2[i] = (bf16_t)f2bf(w); }
        for (int i = gt; i < 2 * 2048 * 256; i += NGT) { const int l = i >> 19, kk = (i >> 8) & 2047, c4 = (i & 255) * 4;
            const float* src = l ? sgu_w_in + (size_t)kk * 3072 + 2048 + c4 : pool_w_in + (size_t)kk * 2048 + 1024 + c4; const f32x4 w = *(const f32x4*)src; const float gs = norm_mix_g[l * D + kk] * 0.0625f;
            u32x2 o; o.x = pk2(w[0] * gs, w[1] * gs); o.y = pk2(w[2] * gs, w[3] * gs); *(u32x2*)(WQN + (size_t)l * D * D + (size_t)kk * D + c4) = o; }
        for (int i = gt; i < 4 * 256 * 256; i += NGT) { const int g = i >> 16, c = (i >> 8) & 255, d = i & 255; GRPW[(size_t)c * 2048 + g * 256 + d] = (bf16_t)f2bf(pool_w_grp[i] * pool_scale[g * 256 + d]); }
#define TR_DECODE(d, it_) do { int r = (it_); \
            if (r < I_SQ) { tr_desc(d, pool_w_in, 2048, 2048, WIN0, norm_mix_g, nullptr, 1.f, false, r); break; } r -= I_SQ; \
            if (r < I_IN1) { tr_desc(d, sgu_w_in, 2048, 3072, WIN1, norm_mix_g + D, nullptr, WIN_S, true, r); break; } r -= I_IN1; \
            if (r < 2 * I_SQ) { const int l_ = r / I_SQ; tr_desc(d, l_ ? sgu_w_out : pool_w_out, 2048, 2048, WOUT + (size_t)l_ * D * D, nullptr, nullptr, 1.f, false, r % I_SQ); break; } r -= 2 * I_SQ; \
            if (r < 2 * I_SQ) { const int l_ = r / I_SQ; tr_desc(d, xa_w_kv + (size_t)l_ * D * D, 2048, 2048, WKV + (size_t)l_ * D * D, nullptr, nullptr, 1.f, false, r % I_SQ); break; } r -= 2 * I_SQ; \
            if (r >= 32 * I_SQ) { r += TAIL_HG; if (r >= 64 * I_SQ + 32 * I_DN) r += TAIL_HD; }     \
            if (r < 64 * I_SQ) { const int le = r / I_SQ; tr_desc(d, moe_w_gu + (size_t)le * D * D, 2048, 2048, GUT + (size_t)le * D * D, norm_ffn_g + (le >> 5) * D, nullptr, GU_WS, true, r % I_SQ); break; } r -= 64 * I_SQ; \
            { const int le = r / I_DN; tr_desc(d, moe_w_down + (size_t)le * DEXP * D, 1024, 2048, DOWNT + (size_t)le * DEXP * D, nullptr, nullptr, DN_WS, true, r % I_DN); } } while (0)
#define TR_ID(j) ((j) < nj1 ? id1 + (j) * st1 : id2 + ((j) - nj1) * st2)
#define TR_RUN() do {   \
            TrDesc dA, dB; f32x4 vA[16], vB[16]; const int nj = nj1 + nj2; int j = 0; \
            if (nj > 0) { TR_DECODE(dA, TR_ID(0)); tr_load(dA, vA, F.lane); \
                for (;;) { \
                    const bool hasB = j + 1 < nj; if (hasB) { TR_DECODE(dB, TR_ID(j + 1)); tr_load(dB, vB, F.lane); } \
                    tr_finish(dA, vA, scr, F.lane); \
                    if (!hasB) break; \
                    const bool hasA = j + 2 < nj; if (hasA) { TR_DECODE(dA, TR_ID(j + 2)); tr_load(dA, vA, F.lane); } \
                    tr_finish(dB, vB, scr, F.lane); \
                    if (!hasA) break; \
                    j += 2; \
                } } } while (0)
        {
            const int id1 = gw, st1 = NGW, nj1 = (NSMALL - gw + NGW - 1) / NGW > 0 ? (NSMALL - gw + NGW - 1) / NGW : 0, id2 = 0, st2 = 1, nj2 = 0;
            TR_RUN();
        }
    }
    SEAM(0);
    PHASE(1) { REPBAR();
        {
            SchedKV S{F.G, F.bid, (const char*)MEMN, (const char*)WKV, (char*)KVN};
            EpiPlain E{0, 1.f};
            pg8::gemm_phase<EpiPlain, SchedKV, false>(F.lds, F.scr, 2048, 4096u, 4096u, (size_t)128 * 4096, S, E);
        }
        if (F.G >= EARLY_PLAIN_MIN_G && F.bid >= 32 && F.bid < 160) {
            SchedProj S{4, 4, 128, F.bid - 32, (const char*)XB, (const char*)WIN0, nullptr, (char*)PROJ, (size_t)256 * 2048 * 2, nullptr, 4096};
            LAS float* rtab = (LAS float*)(F.scr + SCR_IDX); proj_fill_rstd<0>(S, RSTD0, rtab); EpiProj<0> E{2048, RSTD0, nullptr, 4, rtab, 1.f};
            pg8::gemm_phase<EpiProj<0>, SchedProj, false>(F.lds, F.scr, 2048, 4096u, 4096u, (size_t)128 * 4096, S, E);
        }
        if (F.G >= EARLY_PLAIN_MIN_G && F.bid < 32) {
            asm volatile("s_waitcnt vmcnt(0)" ::: "memory"); __syncthreads();
            const int l_ = F.bid >> 4, b_ = (F.bid >> 3) & 1, j_ = F.bid & 7, h_ = j_ & 3;
            SchedFold S{1, (j_ >= 4 ? 0 : 128) + l_ * 64 + b_ * 32 + h_ * 8, (const char*)WOUT, (const char*)KVN, (const char*)GRPW, (char*)BTO, (const char*)WQN, (char*)WINQ, 1, 8};
            EpiFp8 E{VW_S, 3072, WQ_S, 2048};
            pg8::gemm_phase<EpiFp8, SchedFold, false>(F.lds, F.scr, 256, 4096u, 4096u, (size_t)128 * 4096, S, E);
        }
        if (F.G >= EARLY_PLAIN_MIN_G && F.bid >= 160) {
        for (int i = (F.bid - 160) * (NWAVES * 64) + F.tid; i < 2 * 2048 * 128; i += (F.G - 160) * (NWAVES * 64)) { const int b = i >> 18, n = (i >> 7) & 2047, c = i & 127;
            const u32x4 w = *(const u32x4*)(WOUT + (size_t)D * D + (size_t)n * D + c * 8); u32x4 o;
            u32x2 o8; o8.x = pk4_fp8(bflo(w.x) * WO_S, bfhi(w.x) * WO_S, bflo(w.y) * WO_S, bfhi(w.y) * WO_S); o8.y = pk4_fp8(bflo(w.z) * WO_S, bfhi(w.z) * WO_S, bflo(w.w) * WO_S, bfhi(w.w) * WO_S);
            *(u32x2*)((unsigned char*)(BTO + (size_t)(2 + b) * (2048 * 1536) + (size_t)n * 1536) + 1024 + c * 8) = o8; }
        { SchedFold S{F.G - 160, F.bid - 160, (const char*)WOUT, (const char*)KVN, (const char*)GRPW, (char*)BTO, (const char*)WQN, (char*)WINQ, 0};
          EpiPlain E{0, F_S};
          pg8::gemm_phase<EpiPlain, SchedFold, false>(F.lds, F.scr, 256, 4096u, 4096u, (size_t)128 * 4096, S, E); }
        }
        {
            LAS unsigned* scr = (LAS unsigned*)(F.lds + F.wave * 16384);
            constexpr int NMOE = 64 * I_SQ + 64 * I_DN - TAIL_ITEMS; static_assert(NMOE % 16 == 0 && TAIL_PER0 % 16 == 0, "tickets of 16 items");
            const int NTK = (NMOE + (F.G >= EARLY_PLAIN_MIN_G ? TAIL_PER0 : 0)) / 16;
#define CONV_DESC(d_, it_) do { const int ci_ = (it_); if (ci_ < NMOE) TR_DECODE(d_, NSMALL + ci_); else TAIL_DESC(d_, TAIL_PER0 + ci_ - NMOE); } while (0)
            unsigned* q = ctl + CW_CONVQ; volatile LAS unsigned* tk = MISC + 16; TrDesc dA, dB; f32x4 vA[16], vB[16];
            __syncthreads(); if (F.tid == 0) tk[0] = xb_add(q, 1u); __syncthreads();
            unsigned b = tk[0]; int par = 1;
            while (b < (unsigned)NTK) { unsigned nt = 0u; if (F.tid == 0) nt = xb_add(q, 1u);
                const int iA = (int)b * 16 + F.wave;
                CONV_DESC(dA, iA); tr_load(dA, vA, F.lane); CONV_DESC(dB, iA + 8); tr_load(dB, vB, F.lane);
                tr_finish(dA, vA, scr, F.lane); tr_finish(dB, vB, scr, F.lane);
                if (F.tid == 0) tk[par] = nt; __syncthreads(); b = tk[par]; par ^= 1; }
        }
#undef CONV_DESC
#undef TR_RUN
#undef TR_ID

#undef TR_DECODE
    }
    SEAM(1);
    PHASE(2) { REPBAR();
        if (F.G < EARLY_PLAIN_MIN_G) {
        for (int i = gt; i < 2 * 2048 * 128; i += NGT) { const int b = i >> 18, n = (i >> 7) & 2047, c = i & 127;
            const u32x4 w = *(const u32x4*)(WOUT + (size_t)D * D + (size_t)n * D + c * 8); u32x4 o;
            u32x2 o8; o8.x = pk4_fp8(bflo(w.x) * WO_S, bfhi(w.x) * WO_S, bflo(w.y) * WO_S, bfhi(w.y) * WO_S); o8.y = pk4_fp8(bflo(w.z) * WO_S, bfhi(w.z) * WO_S, bflo(w.w) * WO_S, bfhi(w.w) * WO_S);
            *(u32x2*)((unsigned char*)(BTO + (size_t)(2 + b) * (2048 * 1536) + (size_t)n * 1536) + 1024 + c * 8) = o8; }
        { SchedFold S{F.G, F.bid, (const char*)WOUT, (const char*)KVN, (const char*)GRPW, (char*)BTO, (const char*)WQN, (char*)WINQ, 0};
          EpiPlain E{0, F_S};
          pg8::gemm_phase<EpiPlain, SchedFold, false>(F.lds, F.scr, 256, 4096u, 4096u, (size_t)128 * 4096, S, E); }
        { SchedFold S{F.G, F.bid, (const char*)WOUT, (const char*)KVN, (const char*)GRPW, (char*)BTO, (const char*)WQN, (char*)WINQ, 1};
          EpiFp8 E{VW_S, 3072, WQ_S, 2048};
          pg8::gemm_phase<EpiFp8, SchedFold, false>(F.lds, F.scr, 256, 4096u, 4096u, (size_t)128 * 4096, S, E); }
        }
    }
    if (F.G < EARLY_PLAIN_MIN_G) SEAM(2);

    layer_phases<0>(args, F, bar, ctl, lo, hi, gw, NGW, gt, NGT);
    layer_phases<1>(args, F, bar, ctl, lo, hi, gw, NGW, gt, NGT);
    PHASE(23) { REPBAR();
        f32x4 gv[4][2];
#pragma unroll
        for (int j = 0; j < 4; ++j) { gv[j][0] = ((const f32x4*)final_norm_g)[F.lane * 2 + 128 * j]; gv[j][1] = ((const f32x4*)final_norm_g)[F.lane * 2 + 128 * j + 1]; }
        for (int m0 = gw; m0 < T; m0 += 2 * NGW) {
            u32x4 xw[2][4]; u32x2 ya[2][4], yb[2][4]; const int m1 = m0 + NGW; const bool has1 = m1 < T;
#pragma unroll
            for (int rr = 0; rr < 2; ++rr) { const int m = (rr == 0 || has1) ? (rr ? m1 : m0) : m0;
                const u32x4* xr = (const u32x4*)(XB + (size_t)m * D) + F.lane; const u32x2* y0r = (const u32x2*)(YB0 + (size_t)m * D) + F.lane; const u32x2* y1r = (const u32x2*)(YB1 + (size_t)m * D) + F.lane;
#pragma unroll
                for (int j = 0; j < 4; ++j) { xw[rr][j] = xr[64 * j]; ya[rr][j] = y0r[64 * j]; yb[rr][j] = y1r[64 * j]; } }
#pragma unroll
            for (int rr = 0; rr < 2; ++rr) { if (rr == 1 && !has1) break; const int m = rr ? m1 : m0;
                float xv[4][8]; float s = 0.f;
#pragma unroll
                for (int j = 0; j < 4; ++j) { const u32x4 v = xw[rr][j]; float fa[8], fb[8]; fp8x8_to_f32(ya[rr][j], fa); fp8x8_to_f32(yb[rr][j], fb);
                    const float xx[8] = {bflo(v.x), bfhi(v.x), bflo(v.y), bfhi(v.y), bflo(v.z), bfhi(v.z), bflo(v.w), bfhi(v.w)};
#pragma unroll
                    for (int e = 0; e < 8; ++e) { xv[j][e] = xx[e] + (fa[e] + fb[e]) * (1.0f / Y_S); s += xv[j][e] * xv[j][e]; } }
                const float rstd = __builtin_amdgcn_rsqf(wave_sum(s) * (1.0f / D) + EPS);
                f32x4* o = (f32x4*)(args.out + (size_t)m * D) + F.lane * 2;
#pragma unroll
                for (int j = 0; j < 4; ++j) { const f32x4 ga = gv[j][0], gb = gv[j][1];
                    o[128 * j] = (f32x4){xv[j][0] * rstd * ga[0], xv[j][1] * rstd * ga[1], xv[j][2] * rstd * ga[2], xv[j][3] * rstd * ga[3]};
                    o[128 * j + 1] = (f32x4){xv[j][4] * rstd * gb[0], xv[j][5] * rstd * gb[1], xv[j][6] * rstd * gb[2], xv[j][7] * rstd * gb[3]}; } }
        }
    }
#undef IN
#undef SEAM
}

extern "C" void kernel_launch(void* const* d_in, const int* in_sizes, int n_in, void* d_out, int out_size, void* d_ws, size_t ws_size, hipStream_t stream) {
    static int grid = 0;
    if (grid == 0) {
        if (n_in != 22 || out_size != T * D || ws_size < WS_END) { fprintf(stderr, "kernel_launch: unexpected shapes (n_in %d, out %d, ws %zu)\n", n_in, out_size, ws_size); grid = -1; return; }
        int dev = 0, cus = 0, per_cu = 0;
        if (hipGetDevice(&dev) != hipSuccess || hipDeviceGetAttribute(&cus, hipDeviceAttributeMultiprocessorCount, dev) != hipSuccess) { grid = -1; return; }
        if (hipFuncSetAttribute((const void*)fwd, hipFuncAttributeMaxDynamicSharedMemorySize, LDS_BYTES) != hipSuccess) { fprintf(stderr, "kernel_launch: hipFuncSetAttribute failed\n"); grid = -1; return; }
        if (hipOccupancyMaxActiveBlocksPerMultiprocessor(&per_cu, (const void*)fwd, NWAVES * 64, LDS_BYTES) != hipSuccess || per_cu < 1) { fprintf(stderr, "kernel_launch: occupancy query says %d\n", per_cu); }
        (void)hipGetLastError();
        grid = cus;
    }
    if (grid < 0) return;
    (void)hipMemsetAsync((char*)d_ws + WS_CTL, 0, CTL_ZERO_BYTES, stream);
    Args a{};
    for (int i = 0; i < 22; ++i) a.in[i] = (const float*)d_in[i];
    a.out = (float*)d_out; a.ws = (unsigned char*)d_ws;
#if MK_PER_PHASE
    for (int p = 0; p < NPHASE; ++p) { a.ph_lo = p; a.ph_hi = p + 1; hipLaunchKernelGGL(fwd, dim3(grid), dim3(NWAVES * 64), LDS_BYTES, stream, a); }
#else
    a.ph_lo = 0; a.ph_hi = NPHASE; hipLaunchKernelGGL(fwd, dim3(grid), dim3(NWAVES * 64), LDS_BYTES, stream, a);
#endif
}
```

```cpp
#include <hip/hip_runtime.h>
#include <cstdio>
#include <cstdint>

#ifndef MK_PER_PHASE
#define MK_PER_PHASE 0
#endif

#define GAS __attribute__((address_space(1)))
#define LAS __attribute__((address_space(3)))
typedef unsigned short bf16_t;
typedef short bf16x8 __attribute__((ext_vector_type(8)));
typedef float f32x4 __attribute__((ext_vector_type(4)));
typedef float f32x2 __attribute__((ext_vector_type(2)));
typedef unsigned u32x4 __attribute__((ext_vector_type(4)));
typedef unsigned u32x2 __attribute__((ext_vector_type(2)));
typedef int i32x4 __attribute__((ext_vector_type(4)));
typedef int i32x8 __attribute__((ext_vector_type(8)));

constexpr int T = 32768, SEQ = 16384, D = 2048, NMEM = 256, NEXP = 32, DEXP = 1024;
constexpr float EPS = 1e-6f;
constexpr int NWAVES = 8;
constexpr int NPHASE = 24;
constexpr float GU_WS = 64.f, DN_WS = 32.f, HID_S = 8.f, Y_S = 16.f, WQ_S = 64.f, WIN_S = 64.f, MX_S = 8.f, WO_S = 128.f, P_S = 256.f, VW_S = 4.f, F_S = P_S * VW_S;

constexpr size_t MiB = 1u << 20;
constexpr size_t WS_CTL = 0, CTL_ZERO_BYTES = 1 * MiB;
constexpr size_t WS_RSTD = 1 * MiB;
constexpr size_t RSTD_STRIDE = 320 * 1024;
constexpr size_t WS_PART1 = 2 * MiB;
constexpr size_t WS_PART2 = 10 * MiB;
constexpr size_t WS_SSQV = 14 * MiB;
constexpr size_t WS_LOGITS = 16 * MiB;
constexpr size_t WS_LIST = 32 * MiB;
constexpr size_t WS_GATEW = 40 * MiB;
constexpr size_t WS_KMAT = 48 * MiB;
constexpr size_t WS_VT = 50 * MiB;
constexpr size_t WS_MEMN = 52 * MiB;
constexpr size_t WS_WIN0 = 56 * MiB;
constexpr size_t WS_WIN1 = 64 * MiB;
constexpr size_t WS_WOUT = 76 * MiB;
constexpr size_t WS_WKV = 92 * MiB;
constexpr size_t WS_GRP = 108 * MiB;
constexpr size_t WS_W2 = 109 * MiB;
constexpr size_t WS_CNT = 108 * MiB + 512 * 1024;
constexpr size_t WS_TOKREC = 109 * MiB + 512 * 1024;
constexpr size_t WS_RT = 110 * MiB;
constexpr size_t WS_GUT = 112 * MiB;
constexpr size_t WS_DOWNT = 624 * MiB;
constexpr size_t WS_XB = 880 * MiB;
constexpr size_t WS_PROJ = 1010 * MiB;
constexpr size_t WS_POOLED = 1202 * MiB;
constexpr size_t WS_PBUF = 1266 * MiB;
constexpr size_t WS_CONCAT = 1330 * MiB;
constexpr size_t WS_HIDDEN = 1458 * MiB;
constexpr size_t WS_XB8 = 1618 * MiB;
constexpr size_t WS_BTO = 1684 * MiB;
constexpr size_t WS_GRPW = 1716 * MiB;
constexpr size_t WS_WQN = 1718 * MiB;
constexpr size_t WS_WINQ = 1734 * MiB;
constexpr size_t WS_END = 1750 * MiB;
constexpr int CW_BAR = 4096;
constexpr int CW_CONVQ = 2048;
constexpr int EARLY_PLAIN_MIN_G = 176;
constexpr int CW_CURSOR = 16384;

constexpr int RING_BYTES = 131072;
constexpr int SCR_OFF = RING_BYTES;
constexpr int SCR_IDX = 8192, SCR_TAB = 20480, SCR_BYTES = 22528;
constexpr int MISC_OFF = SCR_OFF + SCR_BYTES;
constexpr int LDS_BYTES = MISC_OFF + 128;
constexpr int MAX_MOE_UNITS = 12;

#define RLX_AGENT __ATOMIC_RELAXED, __HIP_MEMORY_SCOPE_AGENT
#define LDS_WAIT() asm volatile("s_waitcnt lgkmcnt(0)" ::: "memory")
#define VM_WAIT() asm volatile("s_waitcnt vmcnt(0)" ::: "memory")
__device__ __forceinline__ int rfl(int v) { return __builtin_amdgcn_readfirstlane(v); }
__device__ __forceinline__ unsigned f2bf(float f) { unsigned u = __builtin_bit_cast(unsigned, f); return (u + 0x7fffu + ((u >> 16) & 1u)) >> 16; }
__device__ __forceinline__ unsigned pk2(float lo, float hi) { return f2bf(lo) | (f2bf(hi) << 16); }
__device__ __forceinline__ unsigned cvt_pk_bf16(float lo, float hi) { unsigned r; asm volatile("v_cvt_pk_bf16_f32 %0, %1, %2" : "=v"(r) : "v"(lo), "v"(hi)); return r; }
__device__ __forceinline__ unsigned pk4_fp8(float a, float b, float c, float d) {
    a = __builtin_amdgcn_fmed3f(a, -448.f, 448.f); b = __builtin_amdgcn_fmed3f(b, -448.f, 448.f); c = __builtin_amdgcn_fmed3f(c, -448.f, 448.f); d = __builtin_amdgcn_fmed3f(d, -448.f, 448.f);
    int w = 0; w = __builtin_amdgcn_cvt_pk_fp8_f32(a, b, w, false); w = __builtin_amdgcn_cvt_pk_fp8_f32(c, d, w, true); return (unsigned)w; }
typedef float f32x2v __attribute__((ext_vector_type(2)));
__device__ __forceinline__ void fp8x8_to_f32(const u32x2 w, float (&o)[8]) { const f32x2v a = __builtin_amdgcn_cvt_pk_f32_fp8((int)w.x, false), b = __builtin_amdgcn_cvt_pk_f32_fp8((int)w.x, true), c = __builtin_amdgcn_cvt_pk_f32_fp8((int)w.y, false), d = __builtin_amdgcn_cvt_pk_f32_fp8((int)w.y, true);
    o[0] = a.x; o[1] = a.y; o[2] = b.x; o[3] = b.y; o[4] = c.x; o[5] = c.y; o[6] = d.x; o[7] = d.y; }
__device__ __forceinline__ float bflo(unsigned w) { return __uint_as_float(w << 16); }
__device__ __forceinline__ float bfhi(unsigned w) { return __uint_as_float(w & 0xffff0000u); }
__device__ __forceinline__ float wave_sum(float v) {
#pragma unroll
    for (int o = 1; o < 64; o <<= 1) v += __shfl_xor(v, o);
    return v;
}
__device__ __forceinline__ float gelu_tanh(float x) {
    const float e = __builtin_amdgcn_exp2f(x * (-2.302208198f - 0.1029432396f * x * x));
    return x * __builtin_amdgcn_rcpf(1.0f + e);
}
__device__ __forceinline__ float silu_f(float x) { return x * __builtin_amdgcn_rcpf(1.0f + __builtin_amdgcn_exp2f(-1.442695041f * x)); }

#define XB_TMO      128
#define XB_XCNT(j)  (256  + 64 * (j))
#define XB_XSUB(j)  (1280 + 64 * (j))
#define XB_XGEN(j)  (2304 + 64 * (j))
#define XB_TOP      3328
#define XB_TOPGEN   3392
#define XCD_BAR_WORDS 3456
#define XB_SPIN_CAP (1u << 20)

__device__ __forceinline__ unsigned xb_ld(unsigned* p)              { return __hip_atomic_load(p, __ATOMIC_RELAXED, __HIP_MEMORY_SCOPE_AGENT); }
__device__ __forceinline__ unsigned xb_add(unsigned* p, unsigned v) { return __hip_atomic_fetch_add(p, v, __ATOMIC_RELAXED, __HIP_MEMORY_SCOPE_AGENT); }
__device__ __forceinline__ unsigned xb_xcc_id() { return (unsigned)__builtin_amdgcn_s_getreg((3 << 11) | 20) & 0xFu; }
#define XB_SPIN(cond, bar) do { unsigned _sp = 0; while (cond) { __builtin_amdgcn_s_sleep(1); \
    if ((++_sp & 255u) == 0u) { if (xb_ld(&(bar)[XB_TMO])) break; if (_sp > XB_SPIN_CAP) { atomicAdd(&(bar)[XB_TMO], 1u); break; } } } } while (0)

struct XcdBarrier { unsigned* bar; unsigned x; volatile LAS unsigned* st; };
__device__ __forceinline__ XcdBarrier xcd_barrier_post(unsigned* bar, volatile LAS unsigned* st) {
    XcdBarrier b; b.bar = bar; b.x = xb_xcc_id(); b.st = st;
    if (threadIdx.x == 0) (void)xb_add(&bar[XB_XCNT(b.x)], 1u);
    return b;
}
__device__ __forceinline__ void xcd_barrier_complete(unsigned* bar, unsigned x, unsigned& nloc, unsigned& nx) {
    const unsigned G = gridDim.x * gridDim.y * gridDim.z;
    unsigned sum, cnt, mine, sp = 0u;
    for (;;) {
        sum = 0u; cnt = 0u; mine = 0u;
#pragma unroll
        for (unsigned j = 0; j < 16; ++j) { const unsigned c = xb_ld(&bar[XB_XCNT(j)]); sum += c; cnt += (c > 0u) ? 1u : 0u; mine = (j == x) ? c : mine; }
        if (sum == G) break;
        __builtin_amdgcn_s_sleep(1);
        if ((++sp & 255u) == 0u) { if (xb_ld(&bar[XB_TMO])) break; if (sp > XB_SPIN_CAP) { atomicAdd(&bar[XB_TMO], 1u); break; } }
    }
    nloc = mine > 0u ? mine : 1u; nx = cnt > 0u ? cnt : 1u;
}
__device__ __forceinline__ void xcd_barrier(const XcdBarrier& b) {
    asm volatile("s_waitcnt vmcnt(0)" ::: "memory");
    __syncthreads();
    if (threadIdx.x == 0) {
        unsigned* bar = b.bar;
        __builtin_amdgcn_s_waitcnt(0);
        unsigned nloc = b.st[0], nx = b.st[1];
        if (nloc == 0u) { xcd_barrier_complete(bar, b.x, nloc, nx); b.st[0] = nloc; b.st[1] = nx; }
        const unsigned old = xb_add(&bar[XB_XSUB(b.x)], 1u);
        const unsigned gen = old / nloc;
        if (old + 1u == (gen + 1u) * nloc) {
            __builtin_amdgcn_fence(__ATOMIC_RELEASE, "agent");
            asm volatile("s_waitcnt vmcnt(0)" ::: "memory");
            const unsigned og = xb_add(&bar[XB_TOP], 1u);
            const unsigned tg = og / nx;
            if (og + 1u == (tg + 1u) * nx) xb_add(&bar[XB_TOPGEN], 1u);
            else XB_SPIN(xb_ld(&bar[XB_TOPGEN]) == tg, bar);
            __builtin_amdgcn_fence(__ATOMIC_ACQUIRE, "agent");
            xb_add(&bar[XB_XGEN(b.x)], 1u);
            asm volatile("s_waitcnt vmcnt(0)" ::: "memory");
        } else {
            XB_SPIN(xb_ld(&bar[XB_XGEN(b.x)]) == gen, bar);
            __builtin_amdgcn_fence(__ATOMIC_ACQUIRE, "agent");
            asm volatile("s_waitcnt vmcnt(0)" ::: "memory");
        }
    }
    __syncthreads();
}

namespace pg8 {
constexpr int BM = 256, BK = 64, HALF = 128, HTB = HALF * BK * 2, NXCD = 8, WGM = 4;
__device__ __forceinline__ int lds_byte(int r, int c) { const int st = (r >> 4) * 2 + (c >> 5), rr = r & 15, cc = c & 31, ob = rr * 64 + cc * 2; return st * 1024 + (ob ^ (((ob >> 9) & 1) << 5)); }
__device__ __forceinline__ void stage_rc(int b, int& R, int& C) { const int st = b / 1024, sb = b % 1024, swz = sb ^ (((sb >> 9) & 1) << 5); R = (st >> 1) * 16 + swz / 64; C = (st & 1) * 32 + (swz % 64) / 2; }
__device__ __forceinline__ int perm32(int rho) { const int n = rho >> 4, i = rho & 15; return 8 * (i >> 2) + 4 * n + (i & 3); }

struct Unit { const char* A; const char* B; char* C; int pm, pn, aux, nvalid; };

__device__ __forceinline__ bool grid_order(int i, int G, int c, int nM, int nN, int& pm, int& pn) {
    const int nwg = nM * nN; const long L = (long)i * G + c; if (L >= nwg) return false;
    int wgid = (int)L; { const int q = nwg / NXCD, r = nwg % NXCD, xcd = wgid % NXCD, off = wgid / NXCD; wgid = (xcd < r ? xcd * (q + 1) : r * (q + 1) + (xcd - r) * q) + off; }
    const int nig = WGM * nN, gid = wgid / nig, fm = gid * WGM, gsz = (nM - fm) < WGM ? (nM - fm) : WGM;
    pm = fm + ((wgid % nig) % gsz); pn = (wgid % nig) / gsz; return true;
}
struct SchedGrid {
    int nM, nN, G, c; const char* A0; size_t a_pm, a_pn; const char* B0; size_t b_bt, b_pn; char* C0; size_t c_pm, c_pn;
    __device__ __forceinline__ bool next(int i, Unit& u) const {
        int pm, pn; if (!grid_order(i, G, c, nM, nN, pm, pn)) return false;
        u.pm = pm; u.pn = pn; u.aux = 0; u.nvalid = 256;
        u.A = A0 + (size_t)pm * a_pm + (size_t)pn * a_pn; u.B = B0 + (size_t)(pm >> 6) * b_bt + (size_t)pn * b_pn; u.C = C0 + (size_t)pm * c_pm + (size_t)pn * c_pn; return true;
    }
    __device__ __forceinline__ int row(int, int) const { return 0; }
};

template <bool F8> struct FragSel { struct A { i32x4 v[4][2]; }; struct B { i32x4 v[2][2]; }; };
template <> struct FragSel<true> { struct A { i32x8 v[4]; }; struct B { i32x8 v[2]; }; };
template <class Epi, class Sched, bool GATHER, bool FP8 = false, bool HALFSKIP = false, bool EPI2 = false, int MIXSW = 0>
__device__ __forceinline__ void gemm_phase(LAS unsigned char* lds, LAS unsigned char* scr, const int K, const unsigned lda2, const unsigned ldb2, const size_t hstepB, const Sched& S, const Epi& E) {
    const int tid = threadIdx.x, wid = __builtin_amdgcn_readfirstlane(tid >> 6), lane = tid & 63, wr = wid >> 2, wc = wid & 3, fr = lane & 15, fq = lane >> 4;
    const int nt = K / BK;
    unsigned voffB[2], vAc[2][2], vAn[2][2]; int Rr[2], Cc[2];
#pragma unroll
    for (int i = 0; i < 2; ++i) { int R, C; stage_rc(tid * 16 + i * 8192, R, C); const int Rb = (R & ~31) + perm32(R & 31); Rr[i] = R; Cc[i] = C;
        voffB[i] = (unsigned)Rb * ldb2 + (unsigned)C * 2u; vAc[0][i] = (unsigned)R * lda2 + (unsigned)C * 2u; vAc[1][i] = vAc[0][i]; vAn[0][i] = vAc[0][i]; vAn[1][i] = vAc[0][i]; }
    const size_t kstep = (size_t)(BK * 2);
    const size_t hstepA = GATHER ? (size_t)0 : (size_t)HALF * lda2;
    const unsigned ldsw = (unsigned)wid * 1024u;
    const int aoff = lds_byte(wr * 64 + fr, fq * 8), boff = lds_byte(wc * 32 + fr, fq * 8);
#define PG8_SA(b, h) (((b) * 2 + (h)) * HTB)
#define PG8_SB(b, h) ((4 + (b) * 2 + (h)) * HTB)
#define PG8_STG(bufoff, gptr, v0, v1) do { \
        __builtin_amdgcn_global_load_lds((const unsigned*)((const char*)(gptr) + (v0)), (LAS unsigned*)(lds + (bufoff) + ldsw), 16, 0, 0); \
        __builtin_amdgcn_global_load_lds((const unsigned*)((const char*)(gptr) + (v1)), (LAS unsigned*)(lds + (bufoff) + ldsw + 8192), 16, 0, 0); } while (0)
#define PG8_STG_B(b, h, bp) PG8_STG(PG8_SB(b, h), (bp) + (h) * hstepB, voffB[0], voffB[1])
#define PG8_STG_A(b, h, ap, nx) do { if constexpr (GATHER) { const unsigned _o0 = (nx) ? vAn[h][0] : vAc[h][0], _o1 = (nx) ? vAn[h][1] : vAc[h][1]; PG8_STG(PG8_SA(b, h), (ap), _o0, _o1); } \
        else { PG8_STG(PG8_SA(b, h), (ap) + (h) * hstepA, vAc[0][0], vAc[0][1]); } } while (0)
#define PG8_LDA(KIND, b, h) do { _Pragma("unroll") for (int m = 0; m < 4; ++m) { const i32x4 _l0 = *(const LAS i32x4*)(lds + PG8_SA(b, h) + aoff + m * 2048), _l1 = *(const LAS i32x4*)(lds + PG8_SA(b, h) + aoff + m * 2048 + 1024); \
        if constexpr (KIND) AtQ.v[m] = __builtin_shufflevector(_l0, _l1, 0, 1, 2, 3, 4, 5, 6, 7); else { AtH.v[m][0] = _l0; AtH.v[m][1] = _l1; } } } while (0)
#define PG8_LDB(KIND, W, b, h) do { _Pragma("unroll") for (int n = 0; n < 2; ++n) { const i32x4 _l0 = *(const LAS i32x4*)(lds + PG8_SB(b, h) + boff + n * 2048), _l1 = *(const LAS i32x4*)(lds + PG8_SB(b, h) + boff + n * 2048 + 1024); \
        if constexpr (KIND) B##W##Q.v[n] = __builtin_shufflevector(_l0, _l1, 0, 1, 2, 3, 4, 5, 6, 7); else { B##W##H.v[n][0] = _l0; B##W##H.v[n][1] = _l1; } } } while (0)
#define PG8_MMA(KIND, ai, bj, W) do { __builtin_amdgcn_s_setprio(1); _Pragma("unroll") for (int m = 0; m < 4; ++m) _Pragma("unroll") for (int n = 0; n < 2; ++n) { \
        if constexpr (KIND) asm volatile("v_mfma_scale_f32_16x16x128_f8f6f4 %0, %1, %2, %0, %3, %3 op_sel_hi:[0,0,0]" : "+v"(acc[ai][bj][m][n]) : "v"(B##W##Q.v[n]), "v"(AtQ.v[m]), "v"(scl1)); \
        else { _Pragma("unroll") for (int k = 0; k < 2; ++k) acc[ai][bj][m][n] = __builtin_amdgcn_mfma_f32_16x16x32_bf16(__builtin_bit_cast(bf16x8, B##W##H.v[n][k]), __builtin_bit_cast(bf16x8, AtH.v[m][k]), acc[ai][bj][m][n], 0, 0, 0); } } \
        __builtin_amdgcn_s_setprio(0); } while (0)
#define PG8_WAIT_V(n) asm volatile("s_waitcnt vmcnt(" #n ")" ::: "memory")
#define PG8_WAIT_L(n) asm volatile("s_waitcnt lgkmcnt(" #n ")" ::: "memory")
#define PG8_BAR __builtin_amdgcn_s_barrier()
#define PG8_SCHED __builtin_amdgcn_sched_barrier(0)
    Unit cur, nxt; int ui = 0;
    if (!S.next(0, cur)) return;
    int scl1 = 0x7f7f7f7f; asm volatile("" : "+v"(scl1));
    if constexpr (GATHER) {
#pragma unroll
        for (int h = 0; h < 2; ++h)
#pragma unroll
            for (int i = 0; i < 2; ++i) vAc[h][i] = (unsigned)S.row(0, Rr[i] + HALF * h) * lda2 + (unsigned)Cc[i] * 2u;
    }
    f32x4 acc[2][2][4][2];
#pragma unroll
    for (int a = 0; a < 2; ++a)
#pragma unroll
        for (int b = 0; b < 2; ++b)
#pragma unroll
            for (int m = 0; m < 4; ++m)
#pragma unroll
                for (int n = 0; n < 2; ++n) acc[a][b][m][n] = (f32x4){0.f, 0.f, 0.f, 0.f};
    typename FragSel<false>::A AtH; typename FragSel<false>::B B0H, B1H; typename FragSel<true>::A AtQ; typename FragSel<true>::B B0Q, B1Q;
    const char* cA = cur.A; const char* cB = cur.B;
    PG8_STG_B(0, 0, cB); PG8_STG_B(0, 1, cB); PG8_STG_A(0, 0, cA, false); PG8_STG_A(0, 1, cA, false);
    if (wr == 1) PG8_BAR;
    PG8_WAIT_V(2); PG8_BAR;
    PG8_STG_B(1, 0, cB + kstep); PG8_STG_A(1, 0, cA + kstep, false); PG8_STG_B(1, 1, cB + kstep);
    PG8_WAIT_V(6); PG8_BAR;
    for (;;) {
        const bool has_next = S.next(ui + 1, nxt);
        const char* nA = has_next ? nxt.A : cA; const char* nB = has_next ? nxt.B : cB;
        if constexpr (GATHER) {
#pragma unroll
            for (int h = 0; h < 2; ++h)
#pragma unroll
                for (int i = 0; i < 2; ++i) vAn[h][i] = has_next ? (unsigned)S.row(ui + 1, Rr[i] + HALF * h) * lda2 + (unsigned)Cc[i] * 2u : vAc[h][i];
        }
#define PG8_KLOOP(KIND, MMA1, TBEG, TEND, FINAL) _Pragma("unroll 1") for (int t = (TBEG); t < (TEND); t += 2) { \
            const bool last = (FINAL) && (t == nt - 2); \
            const char* a1 = cA + (size_t)(t + 1) * kstep; \
            const char* a2 = last ? nA : cA + (size_t)(t + 2) * kstep; const char* b2 = last ? nB : cB + (size_t)(t + 2) * kstep; \
            const char* a3 = a2 + kstep; const char* b3 = b2 + kstep; \
              \
            PG8_LDB(KIND, 0, 0, 0); PG8_LDB(KIND, 1, 0, 1); PG8_SCHED; PG8_LDA(KIND, 0, 0); PG8_STG_A(1, 1, a1, false); \
            PG8_WAIT_V(8); PG8_WAIT_L(0); PG8_BAR; PG8_MMA(KIND, 0, 0, 0); PG8_MMA(KIND, 0, 1, 1); PG8_BAR; PG8_SCHED; \
              \
            PG8_LDA(KIND, 0, 1); PG8_STG_B(0, 0, b2); PG8_STG_B(0, 1, b2); PG8_STG_A(0, 0, a2, last); \
            PG8_WAIT_V(8); PG8_WAIT_L(0); PG8_BAR; if (MMA1) { PG8_MMA(KIND, 1, 0, 0); PG8_MMA(KIND, 1, 1, 1); } PG8_BAR; PG8_SCHED; \
              \
            PG8_LDB(KIND, 0, 1, 0); PG8_LDB(KIND, 1, 1, 1); PG8_SCHED; PG8_LDA(KIND, 1, 0); PG8_STG_A(0, 1, a2, last); \
            PG8_WAIT_V(8); PG8_WAIT_L(0); PG8_BAR; PG8_MMA(KIND, 0, 0, 0); PG8_MMA(KIND, 0, 1, 1); PG8_BAR; PG8_SCHED; \
              \
            PG8_LDA(KIND, 1, 1); PG8_STG_B(1, 0, b3); PG8_STG_B(1, 1, b3); PG8_STG_A(1, 0, a3, last); \
            PG8_WAIT_V(8); PG8_WAIT_L(0); PG8_BAR; if (MMA1) { PG8_MMA(KIND, 1, 0, 0); PG8_MMA(KIND, 1, 1, 1); } PG8_BAR; PG8_SCHED; \
        }
#define PG8_KLOOPS(KIND, TBEG, TEND, FINAL) do { if (HALFSKIP && cur.nvalid <= 128) { PG8_KLOOP(KIND, false, TBEG, TEND, FINAL) } else { PG8_KLOOP(KIND, true, TBEG, TEND, FINAL) } } while (0)
        if constexpr (MIXSW > 0) { PG8_KLOOPS(0, 0, MIXSW, false); PG8_KLOOPS(1, MIXSW, nt, true); }
        else if constexpr (FP8) { PG8_KLOOPS(1, 0, nt, true); }
        else { PG8_KLOOPS(0, 0, nt, true); }
        if constexpr (FP8 || MIXSW > 0) asm volatile("s_nop 15\n\ts_nop 15" ::: "memory");
        if (wr == 0) PG8_BAR;
        E(acc, cur, ui, wr, wc, fr, fq, scr);
        if constexpr (EPI2) { asm volatile("" ::: "memory"); E(acc, cur, ui, wr, wc, fr, fq, scr); }
        if (!has_next) break;
#pragma unroll
        for (int a = 0; a < 2; ++a)
#pragma unroll
            for (int b = 0; b < 2; ++b)
#pragma unroll
                for (int m = 0; m < 4; ++m)
#pragma unroll
                    for (int n = 0; n < 2; ++n) acc[a][b][m][n] = (f32x4){0.f, 0.f, 0.f, 0.f};
        cur = nxt; cA = nA; cB = nB; ++ui;
        if constexpr (GATHER) {
#pragma unroll
            for (int h = 0; h < 2; ++h)
#pragma unroll
                for (int i = 0; i < 2; ++i) vAc[h][i] = vAn[h][i];
        }
        if (wr == 1) PG8_BAR;
    }
    PG8_WAIT_V(0);
    PG8_BAR;
#undef PG8_KLOOPS
#undef PG8_KLOOP
#undef PG8_SA
#undef PG8_SB
#undef PG8_STG
#undef PG8_STG_A
#undef PG8_STG_B
#undef PG8_LDA
#undef PG8_LDB
#undef PG8_MMA
#undef PG8_WAIT_V
#undef PG8_WAIT_L
#undef PG8_BAR
#undef PG8_SCHED
}
}
using pg8::Unit;

typedef f32x4 Acc[2][2][4][2];
#define EPI_ROWS(ai, m) (128 * (ai) + 64 * wr + 16 * (m) + fr)
#define EPI_COL0 (32 * wc + 8 * fq)
__device__ __forceinline__ u32x4 pack8(const f32x4 a, const f32x4 b) { u32x4 w; w.x = cvt_pk_bf16(a[0], a[1]); w.y = cvt_pk_bf16(a[2], a[3]); w.z = cvt_pk_bf16(b[0], b[1]); w.w = cvt_pk_bf16(b[2], b[3]); return w; }

struct EpiPlain {
    int ldc; float scale;
    __device__ __forceinline__ void operator()(Acc& acc, const Unit& u, int, int wr, int wc, int fr, int fq, LAS unsigned char*) const {
        asm volatile("" : "+v"(fr), "+v"(fq));
        const int ld = ldc ? ldc : u.aux; bf16_t* base = (bf16_t*)u.C + EPI_COL0;
#pragma unroll
        for (int ai = 0; ai < 2; ++ai)
#pragma unroll
            for (int m = 0; m < 4; ++m) { bf16_t* rowp = base + (size_t)EPI_ROWS(ai, m) * ld;
#pragma unroll
                for (int bj = 0; bj < 2; ++bj) *(u32x4*)(rowp + bj * 128) = pack8(acc[ai][bj][m][0] * scale, acc[ai][bj][m][1] * scale); }
    }
};
__device__ __forceinline__ void epi_softmax(Acc& acc, const Unit& u, int wr, int wc, int fr, int fq, LAS unsigned char* scr, int ldc, float c) {
    LAS float* XA = (LAS float*)scr; LAS float* XB = (LAS float*)(scr + 4096);
#pragma unroll
    for (int ai = 0; ai < 2; ++ai)
#pragma unroll
        for (int m = 0; m < 4; ++m) { float mx = -3.0e38f;
#pragma unroll
            for (int bj = 0; bj < 2; ++bj)
#pragma unroll
                for (int n = 0; n < 2; ++n) { const f32x4 x = acc[ai][bj][m][n]; mx = fmaxf(mx, fmaxf(fmaxf(x[0], x[1]), fmaxf(x[2], x[3]))); }
            mx = fmaxf(mx, __shfl_xor(mx, 16)); mx = fmaxf(mx, __shfl_xor(mx, 32));
            if (fq == 0) XA[EPI_ROWS(ai, m) * 4 + wc] = mx; }
    LDS_WAIT(); __builtin_amdgcn_s_barrier(); asm volatile("" ::: "memory");
#pragma unroll
    for (int ai = 0; ai < 2; ++ai)
#pragma unroll
        for (int m = 0; m < 4; ++m) { const f32x4 q = *(const LAS f32x4*)(XA + EPI_ROWS(ai, m) * 4); const float mx = fmaxf(fmaxf(q[0], q[1]), fmaxf(q[2], q[3])) * c; float s = 0.f;
#pragma unroll
            for (int bj = 0; bj < 2; ++bj)
#pragma unroll
                for (int n = 0; n < 2; ++n) { f32x4 x = acc[ai][bj][m][n];
#pragma unroll
                    for (int j = 0; j < 4; ++j) { x[j] = __builtin_amdgcn_exp2f(x[j] * c - mx); s += x[j]; }
                    acc[ai][bj][m][n] = x; }
            s += __shfl_xor(s, 16); s += __shfl_xor(s, 32);
            if (fq == 0) XB[EPI_ROWS(ai, m) * 4 + wc] = s; asm volatile("" ::: "memory"); }
    LDS_WAIT(); __builtin_amdgcn_s_barrier(); asm volatile("" ::: "memory");
    unsigned char* base = (unsigned char*)u.C + 32 * wc + 8 * (fq & ~1); const bool odd = fq & 1;
#pragma unroll
    for (int ai = 0; ai < 2; ++ai) {
        u32x2 w8[4][2];
#pragma unroll
        for (int m = 0; m < 4; ++m) { const int r = EPI_ROWS(ai, m); const f32x4 q = *(const LAS f32x4*)(XB + r * 4); const float inv = P_S * __builtin_amdgcn_rcpf((q[0] + q[1]) + (q[2] + q[3]));
#pragma unroll
            for (int bj = 0; bj < 2; ++bj) { const f32x4 v0 = acc[ai][bj][m][0] * inv, v1 = acc[ai][bj][m][1] * inv; w8[m][bj].x = pk4_fp8(v0[0], v0[1], v0[2], v0[3]); w8[m][bj].y = pk4_fp8(v1[0], v1[1], v1[2], v1[3]); } }
#pragma unroll
        for (int mp = 0; mp < 4; mp += 2)
#pragma unroll
            for (int bj = 0; bj < 2; ++bj) { const u32x2 mine = odd ? w8[mp + 1][bj] : w8[mp][bj], send = odd ? w8[mp][bj] : w8[mp + 1][bj];
                u32x2 recv; recv.x = (unsigned)__shfl_xor((int)send.x, 16); recv.y = (unsigned)__shfl_xor((int)send.y, 16);
                u32x4 o; if (odd) { o.x = recv.x; o.y = recv.y; o.z = mine.x; o.w = mine.y; } else { o.x = mine.x; o.y = mine.y; o.z = recv.x; o.w = recv.y; }
                *(u32x4*)(base + (size_t)EPI_ROWS(ai, mp + (odd ? 1 : 0)) * ldc + bj * 128) = o; }
        asm volatile("" ::: "memory"); }
}
struct EpiFp8 {
    float scale0; int ldc0; float scale1; int ldc1;
    __device__ __forceinline__ void operator()(Acc& acc, const Unit& u, int, int wr, int wc, int fr, int fq, LAS unsigned char*) const {
        asm volatile("" : "+v"(fr), "+v"(fq));
        unsigned char* base = (unsigned char*)u.C + EPI_COL0; const float scale = u.aux ? scale1 : scale0; const int ldc = u.aux ? ldc1 : ldc0;
#pragma unroll
        for (int ai = 0; ai < 2; ++ai)
#pragma unroll
            for (int m = 0; m < 4; ++m)
#pragma unroll
                for (int bj = 0; bj < 2; ++bj) { const f32x4 v0 = acc[ai][bj][m][0] * scale, v1 = acc[ai][bj][m][1] * scale; u32x2 w; w.x = pk4_fp8(v0[0], v0[1], v0[2], v0[3]); w.y = pk4_fp8(v1[0], v1[1], v1[2], v1[3]);
                    *(u32x2*)(base + (size_t)EPI_ROWS(ai, m) * ldc + bj * 128) = w; }
    }
};
template <int MODE> struct EpiProj {
    int ldc; const float* rs; float* ssqv; int qt;
    LAS float* rtab; float sc;
    __device__ __forceinline__ void operator()(Acc& acc, const Unit& u, int ui, int wr, int wc, int fr, int fq, LAS unsigned char* scr) const {
        asm volatile("" : "+v"(fr), "+v"(fq));
        bf16_t* base = (bf16_t*)u.C + EPI_COL0;
#pragma unroll
        for (int ai = 0; ai < 2; ++ai)
#pragma unroll
            for (int m = 0; m < 4; ++m) {
                const int r = EPI_ROWS(ai, m), t = u.pm * 256 + r; const float rstd = rtab[ui * 256 + r] * sc;
                float sq = 0.f;
#pragma unroll
                for (int bj = 0; bj < 2; ++bj) { f32x4 v0 = acc[ai][bj][m][0] * rstd, v1 = acc[ai][bj][m][1] * rstd;
                    if (MODE == 1 && u.pn < 8) {
#pragma unroll
                        for (int j = 0; j < 4; ++j) { v0[j] = gelu_tanh(v0[j]); v1[j] = gelu_tanh(v1[j]); } }
                    const u32x4 w = pack8(v0, v1);
                    if (MODE == 1) { const float a0 = bflo(w.x), a1 = bfhi(w.x), a2 = bflo(w.y), a3 = bfhi(w.y), a4 = bflo(w.z), a5 = bfhi(w.z), a6 = bflo(w.w), a7 = bfhi(w.w);
                        sq += (a0 * a0 + a1 * a1) + (a2 * a2 + a3 * a3) + (a4 * a4 + a5 * a5) + (a6 * a6 + a7 * a7); }
                    *(u32x4*)(base + (size_t)r * ldc + bj * 128) = w; }
                if (MODE == 1 && u.pn >= 4 && u.pn < 8) { sq += __shfl_xor(sq, 16); sq += __shfl_xor(sq, 32); if (fq == 0) ssqv[(size_t)t * 16 + (u.pn - 4) * 4 + wc] = sq; }
            }
    }
};
template <int MODE> struct EpiScore {
    LAS float* rtab;
    __device__ __forceinline__ void operator()(Acc& acc, const Unit& u, int ui, int wr, int wc, int fr, int fq, LAS unsigned char* scr) const {
        asm volatile("" : "+v"(fr), "+v"(fq));
#pragma unroll
        for (int ai = 0; ai < 2; ++ai)
#pragma unroll
            for (int m = 0; m < 4; ++m) { const float rstd = rtab[ui * 256 + EPI_ROWS(ai, m)];
#pragma unroll
                for (int bj = 0; bj < 2; ++bj) { acc[ai][bj][m][0] = acc[ai][bj][m][0] * rstd; acc[ai][bj][m][1] = acc[ai][bj][m][1] * rstd; } }
        epi_softmax(acc, u, wr, wc, fr, fq, scr, 3072, 1.442695041f / WQ_S);
    }
};
struct EpiSpatial {
    const bf16_t* uproj; const float* bs;
    __device__ __forceinline__ void operator()(Acc& acc, const Unit& u, int, int wr, int wc, int fr, int fq, LAS unsigned char*) const {
        asm volatile("" : "+v"(fr), "+v"(fq));
        unsigned char* base = (unsigned char*)u.C + EPI_COL0; const bf16_t* ub = uproj + (size_t)u.pm * 256 * 3072 + u.pn * 256 + EPI_COL0;
#pragma unroll
        for (int ai = 0; ai < 2; ++ai)
#pragma unroll
            for (int m = 0; m < 4; ++m) { const int r = EPI_ROWS(ai, m); const float b = bs[u.pn * 128 + (r & 127)];
#pragma unroll
                for (int bj = 0; bj < 2; ++bj) { const u32x4 uw = *(const u32x4*)(ub + (size_t)r * 3072 + bj * 128); f32x4 v0 = acc[ai][bj][m][0] + b, v1 = acc[ai][bj][m][1] + b;
                    v0[0] *= bflo(uw.x); v0[1] *= bfhi(uw.x); v0[2] *= bflo(uw.y); v0[3] *= bfhi(uw.y); v1[0] *= bflo(uw.z); v1[1] *= bfhi(uw.z); v1[2] *= bflo(uw.w); v1[3] *= bfhi(uw.w);
                    v0 = v0 * MX_S; v1 = v1 * MX_S; u32x2 w8; w8.x = pk4_fp8(v0[0], v0[1], v0[2], v0[3]); w8.y = pk4_fp8(v1[0], v1[1], v1[2], v1[3]);
                    *(u32x2*)(base + (size_t)r * 3072 + bj * 128) = w8; }
                asm volatile("" ::: "memory"); }
    }
};
struct EpiOut {
    float* part; unsigned char* xb8; float rsc;
    __device__ __forceinline__ void operator()(Acc& acc, const Unit& u, int, int wr, int wc, int fr, int fq, LAS unsigned char* scr) const {
        asm volatile("" : "+v"(fr), "+v"(fq));
        bf16_t* base = (bf16_t*)u.C + EPI_COL0; LAS float* XA = (LAS float*)scr;
        const bool odd = fq & 1;
#pragma unroll
        for (int ai = 0; ai < 2; ++ai) {
            u32x4 xw[4][2];
#pragma unroll
            for (int m = 0; m < 4; ++m)
#pragma unroll
                for (int bj = 0; bj < 2; ++bj) xw[m][bj] = *(const u32x4*)(base + (size_t)EPI_ROWS(ai, m) * D + bj * 128);
            u32x2 w8[4][2];
#pragma unroll
            for (int m = 0; m < 4; ++m) { const int r = EPI_ROWS(ai, m); float sq = 0.f;
#pragma unroll
                for (int bj = 0; bj < 2; ++bj) { u32x4* p = (u32x4*)(base + (size_t)r * D + bj * 128); const u32x4 x = xw[m][bj]; f32x4 v0 = acc[ai][bj][m][0] * rsc, v1 = acc[ai][bj][m][1] * rsc;
                    v0[0] += bflo(x.x); v0[1] += bfhi(x.x); v0[2] += bflo(x.y); v0[3] += bfhi(x.y); v1[0] += bflo(x.z); v1[1] += bfhi(x.z); v1[2] += bflo(x.w); v1[3] += bfhi(x.w);
                    const u32x4 w = pack8(v0, v1); *p = w;
                    const float a0 = bflo(w.x), a1 = bfhi(w.x), a2 = bflo(w.y), a3 = bfhi(w.y), a4 = bflo(w.z), a5 = bfhi(w.z), a6 = bflo(w.w), a7 = bfhi(w.w);
                    w8[m][bj].x = pk4_fp8(a0, a1, a2, a3); w8[m][bj].y = pk4_fp8(a4, a5, a6, a7);
                    sq += (a0 * a0 + a1 * a1) + (a2 * a2 + a3 * a3) + (a4 * a4 + a5 * a5) + (a6 * a6 + a7 * a7); }
                sq += __shfl_xor(sq, 16); sq += __shfl_xor(sq, 32);
                if (fq == 0) XA[r * 4 + wc] = sq; }
#pragma unroll
            for (int mp = 0; mp < 4; mp += 2)
#pragma unroll
                for (int bj = 0; bj < 2; ++bj) { const u32x2 mine = odd ? w8[mp + 1][bj] : w8[mp][bj], send = odd ? w8[mp][bj] : w8[mp + 1][bj];
                    u32x2 recv; recv.x = (unsigned)__shfl_xor((int)send.x, 16); recv.y = (unsigned)__shfl_xor((int)send.y, 16);
                    u32x4 o; if (odd) { o.x = recv.x; o.y = recv.y; o.z = mine.x; o.w = mine.y; } else { o.x = mine.x; o.y = mine.y; o.z = recv.x; o.w = recv.y; }
                    const int r = EPI_ROWS(ai, mp + (odd ? 1 : 0));
                    *(u32x4*)(xb8 + (size_t)(u.pm * 256 + r) * D + u.pn * 256 + bj * 128 + 32 * wc + 8 * (fq & ~1)) = o; }
            asm volatile("" ::: "memory"); }
        LDS_WAIT(); __builtin_amdgcn_s_barrier(); asm volatile("" ::: "memory");
        { int tid = threadIdx.x; asm volatile("" : "+v"(tid));
          if (tid < 256) { const f32x4 q = *(const LAS f32x4*)(XA + tid * 4); part[(size_t)(u.pm * 256 + tid) * 8 + u.pn] = (q[0] + q[1]) + (q[2] + q[3]); } }
    }
};
struct EpiRoute {
    float* lg;
    __device__ __forceinline__ void operator()(Acc& acc, const Unit& u, int, int wr, int wc, int fr, int fq, LAS unsigned char*) const {
        asm volatile("" : "+v"(fr), "+v"(fq));
        if (wc >= 2) return;
        float* base = lg + (size_t)u.pn * T * 64 + (size_t)u.pm * 256 * 64 + EPI_COL0;
#pragma unroll
        for (int ai = 0; ai < 2; ++ai)
#pragma unroll
            for (int m = 0; m < 4; ++m) { float* rowp = base + (size_t)EPI_ROWS(ai, m) * 64;
                if (wc == 0) { *(f32x4*)rowp = acc[ai][0][m][0] + acc[ai][1][m][0]; *(f32x4*)(rowp + 4) = acc[ai][0][m][1] + acc[ai][1][m][1]; }
                else if (fq == 0) *(f32x4*)rowp = acc[ai][0][m][0] + acc[ai][1][m][0]; }
    }
};
struct SchedMoe {
    LAS int* pre; LAS int* cnt; LAS int* idx; LAS int* preB; LAS int* preS; int lo, hi, G, c, nbu, nunits; int mode;
    int perm;
    __device__ __forceinline__ int plist(int p) const { return perm ? ((p & 1) * 32 + (p >> 1)) : p; }
    LAS int* ul; int nmy;
    const char* A0; const char* B0; char* C0;
    __device__ __forceinline__ bool decode(int i, int& l, int& rt, int& pn, int& tile) const {
        const long L = (long)i * G + c; if (L >= nunits) return false;
        int wgid = (int)L, q; LAS int* px; bool small = wgid >= nbu;
        if (!small) { const int qq = nbu / 8, r = nbu % 8, xcd = wgid % 8, off = wgid / 8; wgid = (xcd < r ? xcd * (qq + 1) : r * (qq + 1) + (xcd - r) * qq) + off; q = wgid >> 3; px = preB; }
        else { wgid -= nbu; q = wgid >> 3; px = preS; }
        pn = wgid & 7;
        const int base = rfl(px[lo]); int a = lo, b = hi;
        while (b - a > 1) { const int mid = (a + b) >> 1; if (rfl(px[mid]) - base <= q) a = mid; else b = mid; }
        l = a; rt = small ? ((rfl(cnt[l]) + 255) >> 8) - 1 : q - (rfl(px[l]) - base); tile = rfl(pre[l]) + rt; return true;
    }
    __device__ __forceinline__ void decode_t(int i, int& l, int& rt, int& pn, int& tile) const {
        int wgid = i * G + c, q; LAS int* px; const bool small = wgid >= nbu;
        if (!small) { const int qq = nbu / 8, r = nbu % 8, xcd = wgid % 8, off = wgid / 8; wgid = (xcd < r ? xcd * (qq + 1) : r * (qq + 1) + (xcd - r) * qq) + off; q = wgid >> 3; px = preB; }
        else { wgid -= nbu; q = wgid >> 3; px = preS; }
        pn = wgid & 7;
        const int base = px[lo]; int a = lo, b = hi;
        while (b - a > 1) { const int mid = (a + b) >> 1; if (px[mid] - base <= q) a = mid; else b = mid; }
        l = plist(a); rt = small ? ((cnt[l] + 255) >> 8) - 1 : q - (px[a] - base); tile = pre[l] + rt;
    }
    __device__ __forceinline__ bool next(int i, Unit& u) const {
        if (i >= nmy) return false;
        const int w0 = rfl(ul[2 * i]), w1 = rfl(ul[2 * i + 1]); const int l = w0 & 255, rt = (w0 >> 8) & 4095, pn = w0 >> 20, tile = w1 & 0xffff;
        const int e = l & 31;
        u.pm = rt; u.pn = pn; u.aux = l; u.nvalid = w1 >> 16;
        if (mode == 0) { u.A = A0; u.B = B0 + (size_t)e * (2048 * 2048) + (size_t)pn * (128 * 2048); u.C = C0 + (size_t)tile * (256 * 1024) + (size_t)pn * 128; }
        else { u.A = A0 + (size_t)tile * (256 * 1024); u.B = B0 + (size_t)e * (2048 * 1024) + (size_t)pn * (256 * 1024); u.C = C0; }
        return true;
    }
    __device__ __forceinline__ int row(int j, int r) const { return idx[j * 256 + r] & 0x1ffff; }
};
template <int KIND  >
__device__ __forceinline__ void moe_setup(SchedMoe& S, const int* totals, const int* listp, const float* vals) {
    int tid = threadIdx.x; LAS int* cnt = S.cnt;
    if (tid < 64) { const int c_ = totals[tid]; cnt[tid] = c_; int a = (c_ + 255) >> 8;
        const int cp = totals[S.plist(tid)], nt_ = (cp + 255) >> 8, sm = (nt_ > 0 && cp - (nt_ - 1) * 256 <= 128) ? 1 : 0; int ab = nt_ - sm, as = sm;
#pragma unroll
        for (int o = 1; o < 64; o <<= 1) { const int ta = __shfl_up(a, o), tb = __shfl_up(ab, o), ts = __shfl_up(as, o); if (tid >= o) { a += ta; ab += tb; as += ts; } }
        S.pre[tid + 1] = a; S.preB[tid + 1] = ab; S.preS[tid + 1] = as; if (tid == 0) { S.pre[0] = 0; S.preB[0] = 0; S.preS[0] = 0; } }
    __syncthreads();
    S.nbu = (rfl(S.preB[S.hi]) - rfl(S.preB[S.lo])) * 8; S.nunits = S.nbu + (rfl(S.preS[S.hi]) - rfl(S.preS[S.lo])) * 8;
    { const int n_ = S.c < S.nunits ? (S.nunits - S.c + S.G - 1) / S.G : 0; S.nmy = n_ < MAX_MOE_UNITS ? n_ : MAX_MOE_UNITS; }
    if (tid < S.nmy) { int li, rt, pn, tile; S.decode_t(tid, li, rt, pn, tile); const int nv_ = cnt[li] - rt * 256; S.ul[2 * tid] = li | (rt << 8) | (pn << 20); S.ul[2 * tid + 1] = tile | ((nv_ < 256 ? nv_ : 256) << 16); }
    __syncthreads();
    const int j2 = tid >> 8, r = tid & 255; int tk[6]; float vv[6]; size_t off[6];
#pragma unroll
    for (int q = 0; q < 6; ++q) { const int j = j2 + 2 * q; tk[q] = T; vv[q] = 0.f; off[q] = 0;
        if (j < S.nmy) { const int w0 = S.ul[2 * j], w1 = S.ul[2 * j + 1]; const int li = w0 & 255, rt = (w0 >> 8) & 4095, nv = w1 >> 16;
            if (r < nv) { off[q] = (size_t)li * T + rt * 256 + r; tk[q] = listp[off[q]]; if (KIND == 1) vv[q] = vals[off[q]]; } } }
    if (KIND == 0) {
#pragma unroll
        for (int q = 0; q < 6; ++q) vv[q] = vals[tk[q]]; }
#pragma unroll
    for (int q = 0; q < 6; ++q) { const int j = j2 + 2 * q; if (j < S.nmy) S.idx[j * 256 + r] = tk[q] | (int)(((__float_as_uint(vv[q]) + 0x8000u) >> 16) << 17); }
    __syncthreads();
}
struct EpiGu {
    const float* rstd; LAS int* idx;
    __device__ __forceinline__ void operator()(Acc& acc, const Unit& u, int ui, int wr, int wc, int fr, int fq, LAS unsigned char*) const {
        asm volatile("" : "+v"(fr), "+v"(fq));
        unsigned char* base = (unsigned char*)u.C + EPI_COL0;
#pragma unroll
        for (int ai = 0; ai < 2; ++ai)
#pragma unroll
            for (int m = 0; m < 4; ++m) { const int r = EPI_ROWS(ai, m); const float rs = __uint_as_float(((unsigned)idx[ui * 256 + r] >> 17) << 16) * (1.0f / GU_WS);
                f32x4 h0, h1;
#pragma unroll
                for (int j = 0; j < 4; ++j) { h0[j] = silu_f(acc[ai][0][m][0][j] * rs) * (acc[ai][1][m][0][j] * (rs * HID_S)); h1[j] = silu_f(acc[ai][0][m][1][j] * rs) * (acc[ai][1][m][1][j] * (rs * HID_S)); }
                u32x2 w; w.x = pk4_fp8(h0[0], h0[1], h0[2], h0[3]); w.y = pk4_fp8(h1[0], h1[1], h1[2], h1[3]);
                *(u32x2*)(base + (size_t)r * DEXP) = w; }
    }
};
template <int MODE> struct EpiDown {
    bf16_t* xb; unsigned char* y0; unsigned char* y1; LAS int* idx; float* part; float rsc, ysc; unsigned char* x8;
    __device__ __forceinline__ void operator()(Acc& acc, const Unit& u, int ui, int wr, int wc, int fr, int fq, LAS unsigned char*) const {
        asm volatile("" : "+v"(fr), "+v"(fq));
        int tok[2][4]; float gt[2][4];
#pragma unroll
        for (int ai = 0; ai < 2; ++ai)
#pragma unroll
            for (int m = 0; m < 4; ++m) { const unsigned e = (unsigned)idx[ui * 256 + EPI_ROWS(ai, m)]; tok[ai][m] = (int)(e & 0x1ffffu); gt[ai][m] = __uint_as_float((e >> 17) << 16) * rsc; }
        if constexpr (MODE == 0) {
            unsigned char* yb = (u.aux >> 5) ? y1 : y0; const bool odd = fq & 1;
#pragma unroll
            for (int ai = 0; ai < 2; ++ai) {
                u32x2 w8[4][2];
#pragma unroll
                for (int m = 0; m < 4; ++m) { const float g = gt[ai][m] * Y_S;
#pragma unroll
                    for (int bj = 0; bj < 2; ++bj) { const f32x4 v0 = acc[ai][bj][m][0] * g, v1 = acc[ai][bj][m][1] * g; w8[m][bj].x = pk4_fp8(v0[0], v0[1], v0[2], v0[3]); w8[m][bj].y = pk4_fp8(v1[0], v1[1], v1[2], v1[3]); } }
#pragma unroll
                for (int mp = 0; mp < 4; mp += 2) { const int msk = -(int)(fq & 1); const int tk = (tok[ai][mp] & ~msk) | (tok[ai][mp + 1] & msk); const int ts = tk + (tk >= T ? 1 : 0);
#pragma unroll
                    for (int bj = 0; bj < 2; ++bj) { const u32x2 mine = odd ? w8[mp + 1][bj] : w8[mp][bj], send = odd ? w8[mp][bj] : w8[mp + 1][bj];
                        u32x2 recv; recv.x = (unsigned)__shfl_xor((int)send.x, 16); recv.y = (unsigned)__shfl_xor((int)send.y, 16);
                        u32x4 o; if (odd) { o.x = recv.x; o.y = recv.y; o.z = mine.x; o.w = mine.y; } else { o.x = mine.x; o.y = mine.y; o.z = recv.x; o.w = recv.y; }
                        *(u32x4*)(yb + (size_t)ts * D + u.pn * 256 + bj * 128 + 32 * wc + 8 * (fq & ~1)) = o; } }
                asm volatile("" ::: "memory"); }
        } else {
#pragma unroll
            for (int ai = 0; ai < 2; ++ai) {
                u32x4 xw[4][2]; u32x2 yw[4][2]; u32x2 w8[4][2];
#pragma unroll
                for (int m = 0; m < 4; ++m)
#pragma unroll
                    for (int bj = 0; bj < 2; ++bj) { xw[m][bj] = *(const u32x4*)(xb + (size_t)tok[ai][m] * D + u.pn * 256 + EPI_COL0 + bj * 128); yw[m][bj] = *(const u32x2*)(y0 + (size_t)tok[ai][m] * D + u.pn * 256 + EPI_COL0 + bj * 128); }
#pragma unroll
                for (int m = 0; m < 4; ++m) { const float g = gt[ai][m]; float sq = 0.f; const int ts = tok[ai][m] + (tok[ai][m] >= T ? 1 : 0); bf16_t* rowp = xb + (size_t)ts * D + u.pn * 256 + EPI_COL0;
#pragma unroll
                    for (int bj = 0; bj < 2; ++bj) { const u32x4 x = xw[m][bj]; float y[8]; fp8x8_to_f32(yw[m][bj], y); f32x4 v0 = acc[ai][bj][m][0] * g, v1 = acc[ai][bj][m][1] * g;
                        v0[0] += bflo(x.x) + y[0] * ysc; v0[1] += bfhi(x.x) + y[1] * ysc; v0[2] += bflo(x.y) + y[2] * ysc; v0[3] += bfhi(x.y) + y[3] * ysc;
                        v1[0] += bflo(x.z) + y[4] * ysc; v1[1] += bfhi(x.z) + y[5] * ysc; v1[2] += bflo(x.w) + y[6] * ysc; v1[3] += bfhi(x.w) + y[7] * ysc;
                        const u32x4 w = pack8(v0, v1); *(u32x4*)(rowp + bj * 128) = w;
                        const float a0 = bflo(w.x), a1 = bfhi(w.x), a2 = bflo(w.y), a3 = bfhi(w.y), a4 = bflo(w.z), a5 = bfhi(w.z), a6 = bflo(w.w), a7 = bfhi(w.w);
                        w8[m][bj].x = pk4_fp8(a0, a1, a2, a3); w8[m][bj].y = pk4_fp8(a4, a5, a6, a7);
                        sq += (a0 * a0 + a1 * a1) + (a2 * a2 + a3 * a3) + (a4 * a4 + a5 * a5) + (a6 * a6 + a7 * a7); }
                    if (part) { sq += __shfl_xor(sq, 16); sq += __shfl_xor(sq, 32); if (fq == 0 && ts < T) part[(size_t)ts * 32 + u.pn * 4 + wc] = sq; } }
#pragma unroll
                for (int mp = 0; mp < 4; mp += 2) { const int msk = -(int)(fq & 1); const int tk = (tok[ai][mp] & ~msk) | (tok[ai][mp + 1] & msk); const int ts = tk + (tk >= T ? 1 : 0); const bool odd = fq & 1;
#pragma unroll
                    for (int bj = 0; bj < 2; ++bj) { const u32x2 mine = odd ? w8[mp + 1][bj] : w8[mp][bj], send = odd ? w8[mp][bj] : w8[mp + 1][bj];
                        u32x2 recv; recv.x = (unsigned)__shfl_xor((int)send.x, 16); recv.y = (unsigned)__shfl_xor((int)send.y, 16);
                        u32x4 o; if (odd) { o.x = recv.x; o.y = recv.y; o.z = mine.x; o.w = mine.y; } else { o.x = mine.x; o.y = mine.y; o.z = recv.x; o.w = recv.y; }
                        *(u32x4*)(x8 + (size_t)ts * D + u.pn * 256 + bj * 128 + 32 * wc + 8 * (fq & ~1)) = o; } }
                asm volatile("" ::: "memory"); }
        }
    }
};
struct SchedSp { pg8::SchedGrid g; __device__ __forceinline__ bool next(int i, Unit& u) const { if (!g.next(i, u)) return false; u.B = g.B0 + ((size_t)u.pm * 4 + u.pn) * (256 * 512); return true; } __device__ __forceinline__ int row(int, int) const { return 0; } };
struct SchedProj {
    int nN, qt, G, c; const char* A0; const char* B0; const char* BQ; char* C0; size_t c_pm; char* CQ; int rb;
    __device__ __forceinline__ bool next(int i, Unit& u) const {
        int pm, pn; if (!pg8::grid_order(i, G, c, T / 256, nN, pm, pn)) return false;
        u.pm = pm; u.pn = pn; u.aux = 0; u.nvalid = 256;
        if (qt) { u.A = A0 + (size_t)pm * 256 * rb; u.B = B0 + (size_t)pn * 256 * rb; u.C = C0 + (size_t)pm * c_pm + (size_t)pn * 512; }
        else { u.A = A0 + (size_t)pm * (256 * 2048); u.B = BQ + (size_t)(pm >> 6) * (1024 * 2048) + (size_t)pn * (256 * 2048); u.C = CQ + (size_t)pm * (256 * 3072) + (size_t)(2048 + pn * 256); }
        return true;
    }
    __device__ __forceinline__ int row(int, int) const { return 0; }
};
template <int MODE, class Sched> __device__ __forceinline__ void proj_fill_rstd(const Sched& S, const float* rs, LAS float* rtab) {
    Unit u; int tid = threadIdx.x;
    for (int j = 0; j < 6 && S.next(j, u); ++j)
        if (tid < 256) { const int t = u.pm * 256 + tid; float v;
            if (MODE == 0) v = rs[t];
            else { const f32x4* pp = (const f32x4*)(rs + (size_t)t * 32); float sm = 0.f;
#pragma unroll
                for (int q = 0; q < 8; ++q) { const f32x4 p = pp[q]; sm += (p[0] + p[1]) + (p[2] + p[3]); }
                v = __builtin_amdgcn_rsqf(sm * (1.0f / D) + EPS); }
            rtab[j * 256 + tid] = v; }
    __syncthreads();
}
struct SchedKV {
    int G, c; const char* memn; const char* wkv; char* kvn;
    __device__ __forceinline__ bool next(int i, Unit& u) const {
        const int id = i * G + c; if (id >= 32) return false;
        const int l = id >> 4, b = (id >> 3) & 1, j = id & 7;
        u.pm = 0; u.pn = 0; u.nvalid = 256; u.aux = 2048;
        u.A = memn + (size_t)l * (512 * 4096) + (size_t)b * (256 * 4096); u.B = wkv + (size_t)l * (2048 * 4096) + (size_t)j * (256 * 4096);
        u.C = kvn + (size_t)l * (512 * 4096) + (size_t)b * (256 * 4096) + (size_t)j * 512; return true;
    }
    __device__ __forceinline__ int row(int, int) const { return 0; }
};
struct SchedFold {
    int G, c; const char* woutT; const char* kvn; const char* grpn; char* bto; const char* wqn; char* winq; int mode; int nmax;
    __device__ __forceinline__ bool next(int i, Unit& u) const {
        const int id = i * G + c; if (id >= (mode ? 256 : 64) || (nmax && i >= nmax)) return false;
        u.pm = 0; u.pn = 0; u.nvalid = 256; u.aux = 0;
        if (mode == 0) { const int b = id >> 5, g = (id >> 3) & 3, rt = id & 7;
            u.A = woutT + (size_t)rt * (256 * 4096) + (size_t)g * 512; u.B = grpn + (size_t)g * 512;
            u.C = bto + (size_t)b * (2048 * 3072) + (size_t)rt * (256 * 3072) + (size_t)g * 512; u.aux = 1536; }
        else if (id < 128) { const int l = id >> 6, b = (id >> 5) & 1, h = (id >> 3) & 3, rt = id & 7;
            u.A = woutT + (size_t)l * (2048 * 4096) + (size_t)rt * (256 * 4096) + (size_t)(1024 + h * 256) * 2;
            u.B = kvn + (size_t)l * (512 * 4096) + (size_t)b * (256 * 4096) + (size_t)(1024 + h * 256) * 2;
            u.C = bto + (size_t)(l * 2 + b) * (2048 * 3072) + (size_t)rt * (256 * 3072) + (size_t)(2048 + h * 256); }
        else { const int r = id - 128, l = r >> 6, b = (r >> 5) & 1, h = (r >> 3) & 3, ct = r & 7;
            u.A = kvn + (size_t)l * (512 * 4096) + (size_t)b * (256 * 4096) + (size_t)h * 512;
            u.B = wqn + (size_t)l * (2048 * 4096) + (size_t)ct * (256 * 4096) + (size_t)h * 512;
            u.C = winq + (size_t)(l * 2 + b) * (1024 * 2048) + (size_t)h * (256 * 2048) + (size_t)ct * 256; u.aux = 1; }
        return true;
    }
    __device__ __forceinline__ int row(int, int) const { return 0; }
};

struct Args { const float* in[22]; float* out; unsigned char* ws; int ph_lo, ph_hi; };
struct Frame { LAS unsigned char* lds; LAS unsigned char* scr; int tid, lane, wave, G, bid; };

struct TrDesc { const float* W; void* WT; const float* ks; const float* ns; float cs; int ldw, kd, k0, n0; bool f8; };
__device__ __forceinline__ void tr_load(const TrDesc& d, f32x4 (&v)[16], int lane) {
    const int kq = lane >> 4, n4 = (lane & 15) * 4;
#pragma unroll
    for (int i = 0; i < 16; ++i) v[i] = *(const f32x4*)(d.W + (size_t)(d.k0 + 16 * kq + i) * d.ldw + d.n0 + n4);
}
__device__ __forceinline__ void tr_finish(const TrDesc& d, f32x4 (&v)[16], LAS unsigned* s32, int lane) {
    const int kq = lane >> 4, n4 = (lane & 15) * 4;
    f32x4 ns = (f32x4){d.cs, d.cs, d.cs, d.cs}; if (d.ns) ns = *(const f32x4*)(d.ns + d.n0 + n4) * d.cs;
    if (d.ks) {
#pragma unroll
        for (int q = 0; q < 4; ++q) { const f32x4 ks = *(const f32x4*)(d.ks + d.k0 + 16 * kq + 4 * q);
#pragma unroll
            for (int e = 0; e < 4; ++e) v[4 * q + e] = v[4 * q + e] * ks[e]; } }
#pragma unroll
    for (int i = 0; i < 16; ++i) v[i] = v[i] * ns;
    if (!d.f8) {
#pragma unroll
        for (int j = 0; j < 4; ++j)
#pragma unroll
            for (int p = 0; p < 8; ++p) s32[(n4 + j) * 33 + 8 * kq + p] = cvt_pk_bf16(v[2 * p][j], v[2 * p + 1][j]);
        LDS_WAIT(); asm volatile("" ::: "memory");
        const int c = lane & 7; bf16_t* WT = (bf16_t*)d.WT;
#pragma unroll
        for (int j = 0; j < 8; ++j) { const int n = (lane >> 3) + 8 * j; const LAS unsigned* sp = s32 + n * 33 + 4 * c;
            u32x4 o; o.x = sp[0]; o.y = sp[1]; o.z = sp[2]; o.w = sp[3];
            *(u32x4*)(WT + (size_t)(d.n0 + n) * d.kd + d.k0 + 8 * c) = o; }
    } else {
#pragma unroll
        for (int j = 0; j < 4; ++j)
#pragma unroll
            for (int p = 0; p < 4; ++p) s32[(n4 + j) * 17 + 4 * kq + p] = pk4_fp8(v[4 * p][j], v[4 * p + 1][j], v[4 * p + 2][j], v[4 * p + 3][j]);
        LDS_WAIT(); asm volatile("" ::: "memory");
        const int c = lane & 3; unsigned char* WT = (unsigned char*)d.WT;
#pragma unroll
        for (int j = 0; j < 4; ++j) { const int n = (lane >> 2) + 16 * j; const LAS unsigned* sp = s32 + n * 17 + 4 * c;
            u32x4 o; o.x = sp[0]; o.y = sp[1]; o.z = sp[2]; o.w = sp[3];
            *(u32x4*)(WT + (size_t)(d.n0 + n) * d.kd + d.k0 + 16 * c) = o; }
    }
    LDS_WAIT(); asm volatile("" ::: "memory");
}
__device__ __forceinline__ void tr_desc(TrDesc& d, const float* W, int K, int N, void* WT, const float* ks, const float* ns, float cs, bool f8, int item) {
    const int nblk = N / 64, kb = item / nblk, nb = item % nblk;
    d.W = W; d.WT = WT; d.ks = ks; d.ns = ns; d.cs = cs; d.ldw = N; d.kd = K; d.k0 = 64 * kb; d.n0 = 64 * nb; d.f8 = f8;
}

#define x_in (args.in[0])
#define mem_in (args.in[1])
#define norm_mix_g (args.in[2])
#define norm_mem_g (args.in[3])
#define norm_ffn_g (args.in[4])
#define pool_w_in (args.in[5])
#define pool_w_grp (args.in[6])
#define pool_scale (args.in[7])
#define pool_w_out (args.in[8])
#define sgu_w_in (args.in[9])
#define sgu_norm_g (args.in[10])
#define sgu_w_s (args.in[11])
#define sgu_b_s (args.in[12])
#define sgu_w_out (args.in[13])
#define xa_w_kv (args.in[14])
#define moe_w_group (args.in[15])
#define moe_b_group (args.in[16])
#define moe_w_expert (args.in[17])
#define moe_b_expert (args.in[18])
#define moe_w_gu (args.in[19])
#define moe_w_down (args.in[20])
#define final_norm_g (args.in[21])
#define WSP(type, off) ((type*)(args.ws + (off)))
#define RSTD0 WSP(float, WS_RSTD)
#define RSTD1 WSP(float, WS_RSTD + RSTD_STRIDE)
#define PART1 WSP(float, WS_PART1)
#define PART2 WSP(float, WS_PART2)
#define SSQV WSP(float, WS_SSQV)
#define LOGITS WSP(float, WS_LOGITS)
#define LIST WSP(int, WS_LIST)
#define GATEW WSP(float, WS_GATEW)
#define KMAT WSP(bf16_t, WS_KMAT)
#define VT WSP(bf16_t, WS_VT)
#define MEMN WSP(bf16_t, WS_MEMN)
#define WIN0 WSP(bf16_t, WS_WIN0)
#define WIN1 WSP(bf16_t, WS_WIN1)
#define WOUT WSP(bf16_t, WS_WOUT)
#define WKV WSP(bf16_t, WS_WKV)
#define GRP WSP(bf16_t, WS_GRP)
#define W2 WSP(bf16_t, WS_W2)
#define RT WSP(bf16_t, WS_RT)
#define GUT WSP(unsigned char, WS_GUT)
#define DOWNT WSP(unsigned char, WS_DOWNT)
#define XB WSP(bf16_t, WS_XB)
#define PROJ WSP(bf16_t, WS_PROJ)
#define POOLED WSP(bf16_t, WS_POOLED)
#define PBUF WSP(bf16_t, WS_PBUF)
#define CONCAT WSP(bf16_t, WS_CONCAT)
#define HIDDEN WSP(unsigned char, WS_HIDDEN)
#define CNTM WSP(int, WS_CNT)
#define TOTALS WSP(int, WS_CNT + 128 * 1024)
#define TOKREC WSP(u32x4, WS_TOKREC)
#define XB8 WSP(unsigned char, WS_XB8)
#define BTO WSP(bf16_t, WS_BTO)
#define GRPW WSP(bf16_t, WS_GRPW)
#define WQN WSP(bf16_t, WS_WQN)
#define WINQ WSP(unsigned char, WS_WINQ)
#define KVN WSP(bf16_t, WS_KMAT)
#define YB0 WSP(unsigned char, WS_PROJ)
#define YB1 WSP(unsigned char, WS_PROJ + 96 * MiB)

#ifndef PHMASK
#define PHMASK 0xffffffffu
#endif
#define IN(k) (((PHMASK >> (((k) < 3) ? (k) : ((k) == 23 ? 13 : 3 + ((k) - 3) % 10))) & 1u) && lo <= (k) && (k) < hi)
#ifndef PROBE_EPI2
#define PROBE_EPI2 false
#endif
#ifndef RMASK
#define RMASK 0u
#endif
#define PHASE(k) if (IN(k)) _Pragma("unroll") for (int rep_ = 0; rep_ < 1 + (int)((RMASK >> (k)) & 1u); ++rep_)
#define REPBAR() do { if (rep_) xcd_barrier(bar); } while (0)
#define SEAM(k) do { if (IN(k) && IN((k) + 1)) xcd_barrier(bar); } while (0)

constexpr int TAIL_PER0 = 4096, TAIL_PER1 = 2048, TAIL_WIN0 = 9, TAIL_WIN1 = 6, TAIL_ITEMS = TAIL_WIN0 * TAIL_PER0 + TAIL_WIN1 * TAIL_PER1;
constexpr int TAIL_HG = TAIL_ITEMS < 32768 ? TAIL_ITEMS : 32768, TAIL_HD = TAIL_ITEMS - TAIL_HG;
#define TAIL_DESC(d_, h_) do { const int hh_ = (h_); if (hh_ < 32768) { const int le_ = 32 + (hh_ >> 10); tr_desc(d_, moe_w_gu + (size_t)le_ * D * D, 2048, 2048, GUT + (size_t)le_ * D * D, norm_ffn_g + D, nullptr, GU_WS, true, hh_ & 1023); } \
        else { const int q_ = hh_ - 32768, le_ = 32 + (q_ >> 9); tr_desc(d_, moe_w_down + (size_t)le_ * DEXP * D, 1024, 2048, DOWNT + (size_t)le_ * DEXP * D, nullptr, nullptr, DN_WS, true, q_ & 511); } } while (0)
#define TAIL_TICKETS(w_) do { const int tb_ = (w_) * TAIL_PER0, nb_ = TAIL_PER0 / NWAVES; unsigned* q_ = ctl + CW_CONVQ + 1 + ((w_) - 6); volatile LAS unsigned* tk_ = (volatile LAS unsigned*)(F.lds + MISC_OFF) + 16; \
        LAS unsigned* tscr_ = (LAS unsigned*)(F.lds + F.wave * 16384); TrDesc dA_; f32x4 vA_[16]; \
        __syncthreads(); if (F.tid == 0) tk_[0] = xb_add(q_, 1u); __syncthreads(); \
        unsigned b_ = tk_[0]; int par_ = 1; \
        while (b_ < (unsigned)nb_) { unsigned nt_ = 0u; if (F.tid == 0) nt_ = xb_add(q_, 1u); \
            TAIL_DESC(dA_, tb_ + (int)b_ * NWAVES + F.wave); tr_load(dA_, vA_, F.lane); tr_finish(dA_, vA_, tscr_, F.lane); \
            if (F.tid == 0) tk_[par_] = nt_; __syncthreads(); b_ = tk_[par_]; par_ ^= 1; } } while (0)
#define TAIL_CONVERT(w_) do { if constexpr (l == 0 && (w_) >= 6) TAIL_TICKETS(w_); else if ((l == 0) || (w_) < TAIL_WIN1) { const int tb_ = l == 0 ? (w_) * TAIL_PER0 : TAIL_WIN0 * TAIL_PER0 + (w_) * TAIL_PER1, tn_ = l == 0 ? TAIL_PER0 : TAIL_PER1; \
        __syncthreads(); LAS unsigned* tscr_ = (LAS unsigned*)(F.lds + F.wave * 16384); TrDesc dA_, dB_; f32x4 vA_[16], vB_[16]; \
        for (int j_ = gw; j_ < tn_; j_ += 2 * NGW) { const bool hasB_ = j_ + NGW < tn_; \
            TAIL_DESC(dA_, tb_ + j_); tr_load(dA_, vA_, F.lane); if (hasB_) { TAIL_DESC(dB_, tb_ + j_ + NGW); tr_load(dB_, vB_, F.lane); } \
            tr_finish(dA_, vA_, tscr_, F.lane); if (hasB_) tr_finish(dB_, vB_, tscr_, F.lane); } } } while (0)
template <int l> __device__ __forceinline__ void layer_phases(const Args& args, const Frame& F, const XcdBarrier& bar, unsigned* ctl, const int lo, const int hi, const int gw, const int NGW, const int gt, const int NGT) {
#ifdef LMASK
        if (!((LMASK >> l) & 1)) return;
#endif
        constexpr int pb = 3 + 10 * l;
        const int ldp = l ? 3072 : 2048, qoff = l ? 2048 : 1024;
        float* RS1 = (float*)((char*)RSTD1 + (size_t)l * RSTD_STRIDE); float* P1 = PART1 + (size_t)l * T * 32;
        PHASE(pb + 0) { REPBAR();
            if (l == 0) {
                if (F.G < EARLY_PLAIN_MIN_G)
                { SchedProj S{4, 4, F.G, F.bid, (const char*)XB, (const char*)WIN0, nullptr, (char*)PROJ, (size_t)256 * 2048 * 2, nullptr, 4096};
                  LAS float* rtab = (LAS float*)(F.scr + SCR_IDX); proj_fill_rstd<0>(S, RSTD0, rtab); EpiProj<0> E{2048, RSTD0, nullptr, 4, rtab, 1.f};
                  pg8::gemm_phase<EpiProj<0>, SchedProj, false>(F.lds, F.scr, 2048, 4096u, 4096u, (size_t)128 * 4096, S, E); }
                const bool early = F.G >= EARLY_PLAIN_MIN_G, poolfirst = early && (F.bid & 1);
                if (poolfirst) {
                for (int it = gt; it < (T / 32) * 128; it += NGT) {
                    const int chunk = it & 127, rb = it >> 7, c0 = chunk * 8, g = c0 >> 8, w = 2 << g, t0 = rb * 32, tl0 = t0 & (SEQ - 1);
                    const bf16_t* pp = PROJ + (size_t)t0 * 2048 + c0; bf16_t* op = CONCAT + (size_t)t0 * 1536 + c0; float s[8];
#pragma unroll
                    for (int j = 0; j < 8; ++j) s[j] = 0.f;
                    for (int j = 1; j < w; ++j) if (tl0 - j >= 0) { const u32x4 v = *(const u32x4*)(pp - (size_t)j * 2048);
                        s[0] += bflo(v.x); s[1] += bfhi(v.x); s[2] += bflo(v.y); s[3] += bfhi(v.y); s[4] += bflo(v.z); s[5] += bfhi(v.z); s[6] += bflo(v.w); s[7] += bfhi(v.w); }
#pragma unroll 8
                    for (int r = 0; r < 32; ++r) { const int tl = tl0 + r; const u32x4 v = *(const u32x4*)(pp + (size_t)r * 2048); float p[8] = {bflo(v.x), bfhi(v.x), bflo(v.y), bfhi(v.y), bflo(v.z), bfhi(v.z), bflo(v.w), bfhi(v.w)};
                        const float inv = 1.0f / (float)(tl + 1 < w ? tl + 1 : w); float o[8];
#pragma unroll
                        for (int j = 0; j < 8; ++j) { s[j] += p[j]; o[j] = s[j] * inv - p[j]; }
                        u32x4 ow; ow.x = pk2(o[0], o[1]); ow.y = pk2(o[2], o[3]); ow.z = pk2(o[4], o[5]); ow.w = pk2(o[6], o[7]); *(u32x4*)(op + (size_t)r * 1536) = ow;
                        if (tl - (w - 1) >= 0) { const u32x4 q = *(const u32x4*)(pp + (size_t)(r - (w - 1)) * 2048);
                            s[0] -= bflo(q.x); s[1] -= bfhi(q.x); s[2] -= bflo(q.y); s[3] -= bfhi(q.y); s[4] -= bflo(q.z); s[5] -= bfhi(q.z); s[6] -= bflo(q.w); s[7] -= bfhi(q.w); } }
                }
                                }
                { SchedProj S{4, 0, F.G, F.bid, (const char*)XB8, nullptr, (const char*)WINQ, nullptr, 0, (char*)CONCAT};
                  LAS float* rtab = (LAS float*)(F.scr + SCR_IDX); proj_fill_rstd<0>(S, RSTD0, rtab); EpiScore<0> E{rtab};
                  pg8::gemm_phase<EpiScore<0>, SchedProj, false, true>(F.lds, F.scr, 1024, 2048u, 2048u, (size_t)128 * 2048, S, E); }
                if (early && !poolfirst) {
                for (int it = gt; it < (T / 32) * 128; it += NGT) {
                    const int chunk = it & 127, rb = it >> 7, c0 = chunk * 8, g = c0 >> 8, w = 2 << g, t0 = rb * 32, tl0 = t0 & (SEQ - 1);
                    const bf16_t* pp = PROJ + (size_t)t0 * 2048 + c0; bf16_t* op = CONCAT + (size_t)t0 * 1536 + c0; float s[8];
#pragma unroll
                    for (int j = 0; j < 8; ++j) s[j] = 0.f;
                    for (int j = 1; j < w; ++j) if (tl0 - j >= 0) { const u32x4 v = *(const u32x4*)(pp - (size_t)j * 2048);
                        s[0] += bflo(v.x); s[1] += bfhi(v.x); s[2] += bflo(v.y); s[3] += bfhi(v.y); s[4] += bflo(v.z); s[5] += bfhi(v.z); s[6] += bflo(v.w); s[7] += bfhi(v.w); }
#pragma unroll 8
                    for (int r = 0; r < 32; ++r) { const int tl = tl0 + r; const u32x4 v = *(const u32x4*)(pp + (size_t)r * 2048); float p[8] = {bflo(v.x), bfhi(v.x), bflo(v.y), bfhi(v.y), bflo(v.z), bfhi(v.z), bflo(v.w), bfhi(v.w)};
                        const float inv = 1.0f / (float)(tl + 1 < w ? tl + 1 : w); float o[8];
#pragma unroll
                        for (int j = 0; j < 8; ++j) { s[j] += p[j]; o[j] = s[j] * inv - p[j]; }
                        u32x4 ow; ow.x = pk2(o[0], o[1]); ow.y = pk2(o[2], o[3]); ow.z = pk2(o[4], o[5]); ow.w = pk2(o[6], o[7]); *(u32x4*)(op + (size_t)r * 1536) = ow;
                        if (tl - (w - 1) >= 0) { const u32x4 q = *(const u32x4*)(pp + (size_t)(r - (w - 1)) * 2048);
                            s[0] -= bflo(q.x); s[1] -= bfhi(q.x); s[2] -= bflo(q.y); s[3] -= bfhi(q.y); s[4] -= bflo(q.z); s[5] -= bfhi(q.z); s[6] -= bflo(q.w); s[7] -= bfhi(q.w); } }
                }
                                }
            } else {
                { SchedProj S{8, 8, F.G, F.bid, (const char*)XB8, (const char*)WIN1, nullptr, (char*)PROJ, (size_t)256 * 3072 * 2, nullptr, 2048};
                  LAS float* rtab = (LAS float*)(F.scr + SCR_IDX); proj_fill_rstd<1>(S, PART2, rtab); EpiProj<1> E{3072, PART2, SSQV, 8, rtab, 1.f / WIN_S};
                  pg8::gemm_phase<EpiProj<1>, SchedProj, false, true>(F.lds, F.scr, 1024, 2048u, 2048u, (size_t)128 * 2048, S, E); }
            }
            TAIL_CONVERT(0);
        }
        SEAM(pb + 0);
        PHASE(pb + 1) { REPBAR();
            if (l == 0) {
                if (F.G < EARLY_PLAIN_MIN_G) {
                for (int it = gt; it < (T / 32) * 128; it += NGT) {
                    const int chunk = it & 127, rb = it >> 7, c0 = chunk * 8, g = c0 >> 8, w = 2 << g, t0 = rb * 32, tl0 = t0 & (SEQ - 1);
                    const bf16_t* pp = PROJ + (size_t)t0 * 2048 + c0; bf16_t* op = CONCAT + (size_t)t0 * 1536 + c0; float s[8];
#pragma unroll
                    for (int j = 0; j < 8; ++j) s[j] = 0.f;
                    for (int j = 1; j < w; ++j) if (tl0 - j >= 0) { const u32x4 v = *(const u32x4*)(pp - (size_t)j * 2048);
                        s[0] += bflo(v.x); s[1] += bfhi(v.x); s[2] += bflo(v.y); s[3] += bfhi(v.y); s[4] += bflo(v.z); s[5] += bfhi(v.z); s[6] += bflo(v.w); s[7] += bfhi(v.w); }
#pragma unroll 8
                    for (int r = 0; r < 32; ++r) { const int tl = tl0 + r; const u32x4 v = *(const u32x4*)(pp + (size_t)r * 2048); float p[8] = {bflo(v.x), bfhi(v.x), bflo(v.y), bfhi(v.y), bflo(v.z), bfhi(v.z), bflo(v.w), bfhi(v.w)};
                        const float inv = 1.0f / (float)(tl + 1 < w ? tl + 1 : w); float o[8];
#pragma unroll
                        for (int j = 0; j < 8; ++j) { s[j] += p[j]; o[j] = s[j] * inv - p[j]; }
                        u32x4 ow; ow.x = pk2(o[0], o[1]); ow.y = pk2(o[2], o[3]); ow.z = pk2(o[4], o[5]); ow.w = pk2(o[6], o[7]); *(u32x4*)(op + (size_t)r * 1536) = ow;
                        if (tl - (w - 1) >= 0) { const u32x4 q = *(const u32x4*)(pp + (size_t)(r - (w - 1)) * 2048);
                            s[0] -= bflo(q.x); s[1] -= bfhi(q.x); s[2] -= bflo(q.y); s[3] -= bfhi(q.y); s[4] -= bflo(q.z); s[5] -= bfhi(q.z); s[6] -= bflo(q.w); s[7] -= bfhi(q.w); } }
                }
                }
            } else {
                const bool sfirst = !(F.bid & 1);
                if (sfirst) {
                { SchedProj S{4, 0, F.G, F.bid, (const char*)XB8, nullptr, (const char*)(WINQ + (size_t)2 * 1024 * D), nullptr, 0, (char*)CONCAT};
                  LAS float* rtab = (LAS float*)(F.scr + SCR_IDX); proj_fill_rstd<1>(S, PART2, rtab); EpiScore<1> E{rtab};
                  pg8::gemm_phase<EpiScore<1>, SchedProj, false, true>(F.lds, F.scr, 1024, 2048u, 2048u, (size_t)128 * 2048, S, E); }
                  __syncthreads(); }
                pg8::SchedGrid S{T / 256, 4, F.G, F.bid, (const char*)W2, 0, (size_t)256 * 512, (const char*)POOLED, 0, (size_t)256 * 512, (char*)CONCAT + 1024, (size_t)256 * 3072, 256};
                SchedSp S2{S};
                LAS bf16_t* Ts = (LAS bf16_t*)F.lds; LAS float* rsv = (LAS float*)(F.lds + 128 * 264 * 2);
                Unit uu;
                for (int it = 0; S2.next(it >> 1, uu); ++it) { const int win = uu.pm, g = uu.pn, half = it & 1;
                    if (F.tid < 256) { const f32x4* pp = (const f32x4*)(SSQV + (size_t)(win * 256 + F.tid) * 16); const f32x4 a = pp[0], b = pp[1], c = pp[2], d = pp[3];
                        const float s = ((a[0] + a[1]) + (a[2] + a[3])) + ((b[0] + b[1]) + (b[2] + b[3])) + ((c[0] + c[1]) + (c[2] + c[3])) + ((d[0] + d[1]) + (d[2] + d[3]));
                        rsv[F.tid] = __builtin_amdgcn_rsqf(s * (1.0f / 1024.0f) + EPS); }
                    __syncthreads();
                    { const int r8 = F.tid >> 4, ch = F.tid & 15, cg = g * 256 + half * 128 + ch * 8; float ng[8];
#pragma unroll
                      for (int j = 0; j < 8; ++j) ng[j] = sgu_norm_g[cg + j];
#pragma unroll
                      for (int st = 0; st < 8; ++st) { const int s = st * 32 + r8; const u32x4 v = *(const u32x4*)(PROJ + (size_t)(win * 256 + s) * 3072 + 1024 + cg); const float rs = rsv[s];
                          const float p[8] = {bflo(v.x), bfhi(v.x), bflo(v.y), bfhi(v.y), bflo(v.z), bfhi(v.z), bflo(v.w), bfhi(v.w)};
#pragma unroll
                          for (int j = 0; j < 8; ++j) Ts[(ch * 8 + j) * 264 + s] = (bf16_t)f2bf(p[j] * rs * ng[j]); } }
                    __syncthreads();
                    { const int c = F.tid >> 5, sc = F.tid & 31; bf16_t* ob = POOLED + ((size_t)(win * 4 + g) * 256 + half * 128) * 256;
#pragma unroll
                      for (int st = 0; st < 8; ++st) { const int cc = st * 16 + c; *(u32x4*)(ob + (size_t)cc * 256 + sc * 8) = *(const LAS u32x4*)(Ts + cc * 264 + sc * 8); } }
                    __syncthreads();
                }
                __syncthreads();
                EpiSpatial E{PROJ, sgu_b_s};
                pg8::gemm_phase<EpiSpatial, SchedSp, false>(F.lds, F.scr, 256, 512u, 512u, (size_t)128 * 512, S2, E);
                if (!sfirst) {
                { SchedProj S{4, 0, F.G, F.bid, (const char*)XB8, nullptr, (const char*)(WINQ + (size_t)2 * 1024 * D), nullptr, 0, (char*)CONCAT};
                  LAS float* rtab = (LAS float*)(F.scr + SCR_IDX); proj_fill_rstd<1>(S, PART2, rtab); EpiScore<1> E{rtab};
                  pg8::gemm_phase<EpiScore<1>, SchedProj, false, true>(F.lds, F.scr, 1024, 2048u, 2048u, (size_t)128 * 2048, S, E); }
                }
            }
            if (!(l == 0 && F.G >= EARLY_PLAIN_MIN_G)) TAIL_CONVERT(1);
        }
        if (!(l == 0 && F.G >= EARLY_PLAIN_MIN_G)) SEAM(pb + 1);
        PHASE(pb + 3) { REPBAR();
            pg8::SchedGrid S{T / 256, 8, F.G, F.bid, (const char*)CONCAT + (l ? 1024 : 0), (size_t)256 * 3072, 0, (const char*)(BTO + (size_t)l * 2 * (2048 * 1536)) + (l ? 1024 : 0), (size_t)2048 * 3072, (size_t)256 * 3072, (char*)XB, (size_t)256 * 4096, 512};
            EpiOut E{P1, XB8, rep_ ? 0.f : 1.0f / F_S};
            if constexpr (l == 1) pg8::gemm_phase<EpiOut, pg8::SchedGrid, false, true>(F.lds, F.scr, 1024, 3072u, 3072u, (size_t)128 * 3072, S, E);
            else pg8::gemm_phase<EpiOut, pg8::SchedGrid, false, false, false, false, 16>(F.lds, F.scr, 1536, 3072u, 3072u, (size_t)128 * 3072, S, E);
            TAIL_CONVERT(2);
        }
        SEAM(pb + 3);
        PHASE(pb + 4) { REPBAR();
            pg8::SchedGrid S{T / 256, 2, F.G, F.bid, (const char*)XB, (size_t)256 * 4096, 2048, (const char*)(RT + (size_t)l * 256 * 2048), 0, 2048, (char*)LOGITS, 0, 0};
            EpiRoute E{LOGITS};
            pg8::gemm_phase<EpiRoute, pg8::SchedGrid, false>(F.lds, F.scr, 1024, 4096u, 4096u, (size_t)128 * 4096, S, E);
            TAIL_CONVERT(3);
        }
        SEAM(pb + 4);
        PHASE(pb + 5) { REPBAR();
            LAS int* hc = (LAS int*)(F.scr + SCR_TAB);
            for (int t0 = F.bid * 128; t0 < T; t0 += F.G * 128) {
                if (F.tid < 64) hc[F.tid] = 0;
                __syncthreads();
                const int t = t0 + F.tid;
                if (F.tid < 128) {
                    const f32x4* pp = (const f32x4*)(P1 + (size_t)t * 8); const f32x4 pa = pp[0], pb_ = pp[1]; const float s = ((pa[0] + pa[1]) + (pa[2] + pa[3])) + ((pb_[0] + pb_[1]) + (pb_[2] + pb_[3]));
                    const float rstd = __builtin_amdgcn_rsqf(s * (1.0f / D) + EPS); RS1[t] = rstd;
                    const float* la = LOGITS + (size_t)t * 64; const float* lb = la + (size_t)T * 64;
                    float gl[4]; int gi = 0;
#pragma unroll
                    for (int j = 0; j < 4; ++j) gl[j] = (la[j] + lb[j]) * rstd + moe_b_group[l * 4 + j];
#pragma unroll
                    for (int j = 1; j < 4; ++j) if (gl[j] > gl[gi]) gi = j;
                    float gs = 0.f;
#pragma unroll
                    for (int j = 0; j < 4; ++j) gs += __expf(gl[j] - gl[gi]);
                    const float pg = 1.0f / gs;
                    float el[8];
#pragma unroll
                    for (int j = 0; j < 8; ++j) el[j] = (la[4 + gi * 8 + j] + lb[4 + gi * 8 + j]) * rstd + moe_b_expert[l * 32 + gi * 8 + j];
                    int i0 = 0;
#pragma unroll
                    for (int j = 1; j < 8; ++j) if (el[j] > el[i0]) i0 = j;
                    int i1 = (i0 == 0) ? 1 : 0;
#pragma unroll
                    for (int j = 0; j < 8; ++j) if (j != i0 && el[j] > el[i1]) i1 = j;
                    const float x1 = __expf(el[i1] - el[i0]); const float tp0 = 1.0f / (1.0f + x1), tp1 = x1 / (1.0f + x1);
                    const int e0 = gi * 8 + i0, e1 = gi * 8 + i1;
                    const int r0 = __hip_atomic_fetch_add(&hc[e0], 1, __ATOMIC_RELAXED, __HIP_MEMORY_SCOPE_WORKGROUP), r1 = __hip_atomic_fetch_add(&hc[32 + e1], 1, __ATOMIC_RELAXED, __HIP_MEMORY_SCOPE_WORKGROUP);
                    u32x4 rec; rec.x = (unsigned)e0 | ((unsigned)e1 << 8) | ((unsigned)r0 << 16) | ((unsigned)r1 << 24); rec.y = __float_as_uint(pg * tp0); rec.z = __float_as_uint(pg * tp1); rec.w = 0u;
                    TOKREC[t] = rec;
                }
                __syncthreads();
                if (F.tid < 64) CNTM[(t0 >> 7) * 64 + F.tid] = hc[F.tid];
                __syncthreads();
            }
            TAIL_CONVERT(4);
        }
        SEAM(pb + 5);
        PHASE(pb + 6) { REPBAR();
            LAS int* ps = (LAS int*)(F.scr + SCR_IDX);
            LAS int* hb = (LAS int*)(F.scr + SCR_TAB);
            for (int t0 = F.bid * 128; t0 < T; t0 += F.G * 128) {
                const int blk = t0 >> 7, li = F.tid & 63, part = F.tid >> 6; int full = 0, upto = 0;
                for (int w = part * 32; w < part * 32 + 32; ++w) { const int c = CNTM[w * 64 + li]; full += c; upto += (w < blk) ? c : 0; }
                ps[part * 64 + li] = full; ps[512 + part * 64 + li] = upto;
                __syncthreads();
                if (F.tid < 64) { int base = 0, tot = 0;
#pragma unroll
                    for (int p = 0; p < 8; ++p) { tot += ps[p * 64 + F.tid]; base += ps[512 + p * 64 + F.tid]; }
                    hb[F.tid] = base; if (blk == 0) TOTALS[l * 64 + F.tid] = tot; }
                __syncthreads();
                if (F.tid < 128) { const int t = t0 + F.tid; const u32x4 rec = TOKREC[t]; const int e0 = rec.x & 255, e1 = (rec.x >> 8) & 255, r0 = (rec.x >> 16) & 255, r1 = rec.x >> 24;
                    const int p0 = hb[e0] + r0, p1 = hb[32 + e1] + r1;
                    LIST[(size_t)e0 * T + p0] = t; GATEW[(size_t)e0 * T + p0] = __uint_as_float(rec.y); LIST[(size_t)(32 + e1) * T + p1] = t; GATEW[(size_t)(32 + e1) * T + p1] = __uint_as_float(rec.z); }
                __syncthreads();
            }
            TAIL_CONVERT(5);
        }
        SEAM(pb + 6);
        { constexpr int ph = 0;
            if (!(l == 1 && ph == 2)) PHASE(pb + 7 + ph) { REPBAR();
                LAS int* cnt = (LAS int*)(F.scr + SCR_TAB); LAS int* pre = cnt + 64; LAS int* preB = cnt + 130; LAS int* preS = cnt + 196; LAS int* idx = (LAS int*)(F.scr + SCR_IDX);
                SchedMoe S; S.pre = pre; S.cnt = cnt; S.idx = idx; S.preB = preB; S.preS = preS; S.G = F.G; S.c = F.bid; S.ul = cnt + 264; S.nmy = 0; S.perm = 0;
                if (ph == 0) { S.lo = 0; S.hi = 64; S.mode = 0; S.perm = 1; S.A0 = (const char*)XB8; S.B0 = (const char*)(GUT + (size_t)l * 32 * D * D); S.C0 = (char*)HIDDEN; }
                else { S.lo = (ph == 1) ? 0 : 32; S.hi = (ph == 1 && l == 0) ? 32 : 64; S.mode = 1; S.perm = (ph == 1 && l == 1) ? 1 : 0; S.A0 = (const char*)HIDDEN; S.B0 = (const char*)(DOWNT + (size_t)l * 32 * DEXP * D); S.C0 = nullptr; }
                if (ph == 0) {
                    moe_setup<0>(S, TOTALS + l * 64, LIST, RS1);
                    EpiGu E{RS1, idx};
                    pg8::gemm_phase<EpiGu, SchedMoe, true, true, true>(F.lds, F.scr, 1024, 2048u, 2048u, (size_t)1024 * 2048, S, E);
                } else if (ph == 1) {
                    moe_setup<1>(S, TOTALS + l * 64, LIST, GATEW);
                    EpiDown<0> E{XB, YB0, YB1, idx, nullptr, 1.0f / (HID_S * DN_WS), 0.f, nullptr};
                    pg8::gemm_phase<EpiDown<0>, SchedMoe, false, true, true>(F.lds, F.scr, 512, 1024u, 1024u, (size_t)128 * 1024, S, E);
                } else {
                    moe_setup<1>(S, TOTALS + l * 64, LIST, GATEW);
                    EpiDown<1> E{XB, YB0, YB1, idx, PART2, rep_ ? 0.f : 1.0f / (HID_S * DN_WS), rep_ ? 0.f : 1.0f / Y_S, XB8};
                    pg8::gemm_phase<EpiDown<1>, SchedMoe, false, true, true>(F.lds, F.scr, 512, 1024u, 1024u, (size_t)128 * 1024, S, E);
                }
                __syncthreads();
                TAIL_CONVERT(6 + ph);
            }
            if (!(l == 1 && ph == 2)) SEAM(pb + 7 + ph);
        }
        { constexpr int ph = 1;
            if (!(l == 1 && ph == 2)) PHASE(pb + 7 + ph) { REPBAR();
                LAS int* cnt = (LAS int*)(F.scr + SCR_TAB); LAS int* pre = cnt + 64; LAS int* preB = cnt + 130; LAS int* preS = cnt + 196; LAS int* idx = (LAS int*)(F.scr + SCR_IDX);
                SchedMoe S; S.pre = pre; S.cnt = cnt; S.idx = idx; S.preB = preB; S.preS = preS; S.G = F.G; S.c = F.bid; S.ul = cnt + 264; S.nmy = 0; S.perm = 0;
                if (ph == 0) { S.lo = 0; S.hi = 64; S.mode = 0; S.perm = 1; S.A0 = (const char*)XB8; S.B0 = (const char*)(GUT + (size_t)l * 32 * D * D); S.C0 = (char*)HIDDEN; }
                else { S.lo = (ph == 1) ? 0 : 32; S.hi = (ph == 1 && l == 0) ? 32 : 64; S.mode = 1; S.perm = (ph == 1 && l == 1) ? 1 : 0; S.A0 = (const char*)HIDDEN; S.B0 = (const char*)(DOWNT + (size_t)l * 32 * DEXP * D); S.C0 = nullptr; }
                if (ph == 0) {
                    moe_setup<0>(S, TOTALS + l * 64, LIST, RS1);
                    EpiGu E{RS1, idx};
                    pg8::gemm_phase<EpiGu, SchedMoe, true, true, true>(F.lds, F.scr, 1024, 2048u, 2048u, (size_t)1024 * 2048, S, E);
                } else if (ph == 1) {
                    moe_setup<1>(S, TOTALS + l * 64, LIST, GATEW);
                    EpiDown<0> E{XB, YB0, YB1, idx, nullptr, 1.0f / (HID_S * DN_WS), 0.f, nullptr};
                    pg8::gemm_phase<EpiDown<0>, SchedMoe, false, true, true>(F.lds, F.scr, 512, 1024u, 1024u, (size_t)128 * 1024, S, E);
                } else {
                    moe_setup<1>(S, TOTALS + l * 64, LIST, GATEW);
                    EpiDown<1> E{XB, YB0, YB1, idx, PART2, rep_ ? 0.f : 1.0f / (HID_S * DN_WS), rep_ ? 0.f : 1.0f / Y_S, XB8};
                    pg8::gemm_phase<EpiDown<1>, SchedMoe, false, true, true>(F.lds, F.scr, 512, 1024u, 1024u, (size_t)128 * 1024, S, E);
                }
                __syncthreads();
                TAIL_CONVERT(6 + ph);
            }
            if (!(l == 1 && ph == 2)) SEAM(pb + 7 + ph);
        }
        { constexpr int ph = 2;
            if (!(l == 1 && ph == 2)) PHASE(pb + 7 + ph) { REPBAR();
                LAS int* cnt = (LAS int*)(F.scr + SCR_TAB); LAS int* pre = cnt + 64; LAS int* preB = cnt + 130; LAS int* preS = cnt + 196; LAS int* idx = (LAS int*)(F.scr + SCR_IDX);
                SchedMoe S; S.pre = pre; S.cnt = cnt; S.idx = idx; S.preB = preB; S.preS = preS; S.G = F.G; S.c = F.bid; S.ul = cnt + 264; S.nmy = 0; S.perm = 0;
                if (ph == 0) { S.lo = 0; S.hi = 64; S.mode = 0; S.perm = 1; S.A0 = (const char*)XB8; S.B0 = (const char*)(GUT + (size_t)l * 32 * D * D); S.C0 = (char*)HIDDEN; }
                else { S.lo = (ph == 1) ? 0 : 32; S.hi = (ph == 1 && l == 0) ? 32 : 64; S.mode = 1; S.perm = (ph == 1 && l == 1) ? 1 : 0; S.A0 = (const char*)HIDDEN; S.B0 = (const char*)(DOWNT + (size_t)l * 32 * DEXP * D); S.C0 = nullptr; }
                if (ph == 0) {
                    moe_setup<0>(S, TOTALS + l * 64, LIST, RS1);
                    EpiGu E{RS1, idx};
                    pg8::gemm_phase<EpiGu, SchedMoe, true, true, true>(F.lds, F.scr, 1024, 2048u, 2048u, (size_t)1024 * 2048, S, E);
                } else if (ph == 1) {
                    moe_setup<1>(S, TOTALS + l * 64, LIST, GATEW);
                    EpiDown<0> E{XB, YB0, YB1, idx, nullptr, 1.0f / (HID_S * DN_WS), 0.f, nullptr};
                    pg8::gemm_phase<EpiDown<0>, SchedMoe, false, true, true>(F.lds, F.scr, 512, 1024u, 1024u, (size_t)128 * 1024, S, E);
                } else {
                    moe_setup<1>(S, TOTALS + l * 64, LIST, GATEW);
                    EpiDown<1> E{XB, YB0, YB1, idx, PART2, rep_ ? 0.f : 1.0f / (HID_S * DN_WS), rep_ ? 0.f : 1.0f / Y_S, XB8};
                    pg8::gemm_phase<EpiDown<1>, SchedMoe, false, true, true>(F.lds, F.scr, 512, 1024u, 1024u, (size_t)128 * 1024, S, E);
                }
                __syncthreads();
                TAIL_CONVERT(6 + ph);
            }
            if (!(l == 1 && ph == 2)) SEAM(pb + 7 + ph);
        }
}
__global__ void __launch_bounds__(NWAVES * 64, 2) fwd(Args args) {
    extern __shared__ __attribute__((aligned(16))) unsigned char lds_raw[];
    Frame F; F.lds = (LAS unsigned char*)lds_raw; F.scr = F.lds + SCR_OFF;
    F.tid = threadIdx.x; F.lane = F.tid & 63; F.wave = rfl(F.tid >> 6); F.G = gridDim.x; F.bid = blockIdx.x;
    volatile LAS unsigned* MISC = (volatile LAS unsigned*)(F.lds + MISC_OFF);
    unsigned* ctl = (unsigned*)(args.ws + WS_CTL);
    if (F.tid < 32) MISC[F.tid] = 0u;
    __syncthreads();
    XcdBarrier bar; bar.bar = ctl + CW_BAR; bar.x = 0; bar.st = nullptr;
    if (!MK_PER_PHASE) bar = xcd_barrier_post(ctl + CW_BAR, MISC + 8);
    const int lo = args.ph_lo, hi = args.ph_hi;

    const int gw = F.bid * NWAVES + F.wave, NGW = F.G * NWAVES;
    const int gt = F.bid * (NWAVES * 64) + F.tid, NGT = F.G * NWAVES * 64;
    constexpr int I_SQ = (2048 / 64) * (2048 / 64), I_IN1 = (2048 / 64) * (3072 / 64), I_DN = (1024 / 64) * (2048 / 64);
    constexpr int NSMALL = I_SQ + I_IN1 + 2 * I_SQ + 2 * I_SQ;
    PHASE(0) { REPBAR();
        LAS unsigned* scr = (LAS unsigned*)(F.lds + F.wave * 16384);
        for (int m = gw; m < T; m += NGW) {
            const f32x4* xr = (const f32x4*)(x_in + (size_t)m * D) + F.lane * 2; unsigned* o = (unsigned*)(XB + (size_t)m * D) + F.lane * 4; float s = 0.f;
#pragma unroll
            for (int j = 0; j < 4; ++j) { const f32x4 a = xr[128 * j], b = xr[128 * j + 1]; u32x4 w; w.x = pk2(a[0], a[1]); w.y = pk2(a[2], a[3]); w.z = pk2(b[0], b[1]); w.w = pk2(b[2], b[3]);
                const float a0 = bflo(w.x), a1 = bfhi(w.x), a2 = bflo(w.y), a3 = bfhi(w.y), a4 = bflo(w.z), a5 = bfhi(w.z), a6 = bflo(w.w), a7 = bfhi(w.w);
                s += (a0 * a0 + a1 * a1) + (a2 * a2 + a3 * a3) + (a4 * a4 + a5 * a5) + (a6 * a6 + a7 * a7);
                u32x2 w8; w8.x = pk4_fp8(a0, a1, a2, a3); w8.y = pk4_fp8(a4, a5, a6, a7); *(u32x2*)(XB8 + (size_t)m * D + 512 * j + 8 * F.lane) = w8;
                *(u32x4*)(o + 256 * j) = w; }
            s = wave_sum(s); if (F.lane == 0) RSTD0[m] = __builtin_amdgcn_rsqf(s * (1.0f / D) + EPS);
        }
        if (gt < D / 2) ((unsigned*)(XB + (size_t)T * D))[gt] = 0u;
        if (gt < D / 4) ((unsigned*)(XB8 + (size_t)T * D))[gt] = 0u;
        if (gt == 0) { RSTD0[T] = 0.f; RSTD1[T] = 0.f; ((float*)((char*)RSTD1 + RSTD_STRIDE))[T] = 0.f; }
        for (int m = gw; m < 2 * 512; m += NGW) { const int l = m >> 9, r = m & 511;
            const f32x4* xr = (const f32x4*)(mem_in + (size_t)r * D) + F.lane * 2; const f32x4* gr = (const f32x4*)(norm_mem_g + (size_t)l * D) + F.lane * 2; f32x4 a[4], b[4]; float s = 0.f;
#pragma unroll
            for (int j = 0; j < 4; ++j) { a[j] = xr[128 * j]; b[j] = xr[128 * j + 1]; s += (a[j][0] * a[j][0] + a[j][1] * a[j][1]) + (a[j][2] * a[j][2] + a[j][3] * a[j][3]) + (b[j][0] * b[j][0] + b[j][1] * b[j][1]) + (b[j][2] * b[j][2] + b[j][3] * b[j][3]); }
            const float rstd = __builtin_amdgcn_rsqf(wave_sum(s) * (1.0f / D) + EPS); unsigned* o = (unsigned*)(MEMN + (size_t)m * D) + F.lane * 4;
#pragma unroll
            for (int j = 0; j < 4; ++j) { const f32x4 ga = gr[128 * j], gb = gr[128 * j + 1]; u32x4 w; w.x = pk2(a[j][0] * rstd * ga[0], a[j][1] * rstd * ga[1]); w.y = pk2(a[j][2] * rstd * ga[2], a[j][3] * rstd * ga[3]);
                w.z = pk2(b[j][0] * rstd * gb[0], b[j][1] * rstd * gb[1]); w.w = pk2(b[j][2] * rstd * gb[2], b[j][3] * rstd * gb[3]); *(u32x4*)(o + 256 * j) = w; }
        }
        for (int i = gt; i < 2 * 256 * 2048; i += NGT) { const int l = i >> 19, n = (i >> 11) & 255, k = i & 2047, j = n & 127; float w = 0.f;
            if (j < 4) w = moe_w_group[((size_t)l * D + k) * 4 + j]; else if (j < 36) w = moe_w_expert[((size_t)l * D + k) * 32 + (j - 4)];
            w *= norm_ffn_g[l * D + k]; const unsigned hi16 = f2bf(w); const float lof = w - __uint_as_float(hi16 << 16);
            RT[i] = (bf16_t)(n < 128 ? hi16 : f2bf(lof)); }
        for (int i = gt; i < 4 * 256 * 256; i += NGT) { const int g = i >> 16, t = (i >> 8) & 255, s = i & 255; float w = 0.f;
            if ((t >> 7) == (s >> 7) && (s & 127) <= (t & 127)) w = sgu_w_s[((size_t)g * 128 + (t & 127)) * 128 + (s & 127)];
            W2[i] = (bf16_t)f2bf(w); }
        for (int i = gt; i < 2 * 2048 * 256; i += NGT) { const int l = i >> 19, kk = (i >> 8) & 2047, c4 = (i & 255) * 4;
            const float* src = l ? sgu_w_in + (size_t)kk * 3072 + 2048 + c4 : pool_w_in + (size_t)kk * 2048 + 1024 + c4; const f32x4 w = *(const f32x4*)src; const float gs = norm_mix_g[l * D + kk] * 0.0625f;
            u32x2 o; o.x = pk2(w[0] * gs, w[1] * gs); o.y = pk2(w[2] * gs, w[3] * gs); *(u32x2*)(WQN + (size_t)l * D * D + (size_t)kk * D + c4) = o; }
        for (int i = gt; i < 4 * 256 * 256; i += NGT) { const int g = i >> 16, c = (i >> 8) & 255, d = i & 255; GRPW[(size_t)c * 2048 + g * 256 + d] = (bf16_t)f2bf(pool_w_grp[i] * pool_scale[g * 256 + d]); }
#define TR_DECODE(d, it_) do { int r = (it_); \
            if (r < I_SQ) { tr_desc(d, pool_w_in, 2048, 2048, WIN0, norm_mix_g, nullptr, 1.f, false, r); break; } r -= I_SQ; \
            if (r < I_IN1) { tr_desc(d, sgu_w_in, 2048, 3072, WIN1, norm_mix_g + D, nullptr, WIN_S, true, r); break; } r -= I_IN1; \
            if (r < 2 * I_SQ) { const int l_ = r / I_SQ; tr_desc(d, l_ ? sgu_w_out : pool_w_out, 2048, 2048, WOUT + (size_t)l_ * D * D, nullptr, nullptr, 1.f, false, r % I_SQ); break; } r -= 2 * I_SQ; \
            if (r < 2 * I_SQ) { const int l_ = r / I_SQ; tr_desc(d, xa_w_kv + (size_t)l_ * D * D, 2048, 2048, WKV + (size_t)l_ * D * D, nullptr, nullptr, 1.f, false, r % I_SQ); break; } r -= 2 * I_SQ; \
            if (r >= 32 * I_SQ) { r += TAIL_HG; if (r >= 64 * I_SQ + 32 * I_DN) r += TAIL_HD; }     \
            if (r < 64 * I_SQ) { const int le = r / I_SQ; tr_desc(d, moe_w_gu + (size_t)le * D * D, 2048, 2048, GUT + (size_t)le * D * D, norm_ffn_g + (le >> 5) * D, nullptr, GU_WS, true, r % I_SQ); break; } r -= 64 * I_SQ; \
            { const int le = r / I_DN; tr_desc(d, moe_w_down + (size_t)le * DEXP * D, 1024, 2048, DOWNT + (size_t)le * DEXP * D, nullptr, nullptr, DN_WS, true, r % I_DN); } } while (0)
#define TR_ID(j) ((j) < nj1 ? id1 + (j) * st1 : id2 + ((j) - nj1) * st2)
#define TR_RUN() do {   \
            TrDesc dA, dB; f32x4 vA[16], vB[16]; const int nj = nj1 + nj2; int j = 0; \
            if (nj > 0) { TR_DECODE(dA, TR_ID(0)); tr_load(dA, vA, F.lane); \
                for (;;) { \
                    const bool hasB = j + 1 < nj; if (hasB) { TR_DECODE(dB, TR_ID(j + 1)); tr_load(dB, vB, F.lane); } \
                    tr_finish(dA, vA, scr, F.lane); \
                    if (!hasB) break; \
                    const bool hasA = j + 2 < nj; if (hasA) { TR_DECODE(dA, TR_ID(j + 2)); tr_load(dA, vA, F.lane); } \
                    tr_finish(dB, vB, scr, F.lane); \
                    if (!hasA) break; \
                    j += 2; \
                } } } while (0)
        {
            const int id1 = gw, st1 = NGW, nj1 = (NSMALL - gw + NGW - 1) / NGW > 0 ? (NSMALL - gw + NGW - 1) / NGW : 0, id2 = 0, st2 = 1, nj2 = 0;
            TR_RUN();
        }
    }
    SEAM(0);
    PHASE(1) { REPBAR();
        {
            SchedKV S{F.G, F.bid, (const char*)MEMN, (const char*)WKV, (char*)KVN};
            EpiPlain E{0, 1.f};
            pg8::gemm_phase<EpiPlain, SchedKV, false>(F.lds, F.scr, 2048, 4096u, 4096u, (size_t)128 * 4096, S, E);
        }
        if (F.G >= EARLY_PLAIN_MIN_G && F.bid >= 32 && F.bid < 160) {
            SchedProj S{4, 4, 128, F.bid - 32, (const char*)XB, (const char*)WIN0, nullptr, (char*)PROJ, (size_t)256 * 2048 * 2, nullptr, 4096};
            LAS float* rtab = (LAS float*)(F.scr + SCR_IDX); proj_fill_rstd<0>(S, RSTD0, rtab); EpiProj<0> E{2048, RSTD0, nullptr, 4, rtab, 1.f};
            pg8::gemm_phase<EpiProj<0>, SchedProj, false>(F.lds, F.scr, 2048, 4096u, 4096u, (size_t)128 * 4096, S, E);
        }
        if (F.G >= EARLY_PLAIN_MIN_G && F.bid < 32) {
            asm volatile("s_waitcnt vmcnt(0)" ::: "memory"); __syncthreads();
            const int l_ = F.bid >> 4, b_ = (F.bid >> 3) & 1, j_ = F.bid & 7, h_ = j_ & 3;
            SchedFold S{1, (j_ >= 4 ? 0 : 128) + l_ * 64 + b_ * 32 + h_ * 8, (const char*)WOUT, (const char*)KVN, (const char*)GRPW, (char*)BTO, (const char*)WQN, (char*)WINQ, 1, 8};
            EpiFp8 E{VW_S, 3072, WQ_S, 2048};
            pg8::gemm_phase<EpiFp8, SchedFold, false>(F.lds, F.scr, 256, 4096u, 4096u, (size_t)128 * 4096, S, E);
        }
        if (F.G >= EARLY_PLAIN_MIN_G && F.bid >= 160) {
        for (int i = (F.bid - 160) * (NWAVES * 64) + F.tid; i < 2 * 2048 * 128; i += (F.G - 160) * (NWAVES * 64)) { const int b = i >> 18, n = (i >> 7) & 2047, c = i & 127;
            const u32x4 w = *(const u32x4*)(WOUT + (size_t)D * D + (size_t)n * D + c * 8); u32x4 o;
            u32x2 o8; o8.x = pk4_fp8(bflo(w.x) * WO_S, bfhi(w.x) * WO_S, bflo(w.y) * WO_S, bfhi(w.y) * WO_S); o8.y = pk4_fp8(bflo(w.z) * WO_S, bfhi(w.z) * WO_S, bflo(w.w) * WO_S, bfhi(w.w) * WO_S);
            *(u32x2*)((unsigned char*)(BTO + (size_t)(2 + b) * (2048 * 1536) + (size_t)n * 1536) + 1024 + c * 8) = o8; }
        { SchedFold S{F.G - 160, F.bid - 160, (const char*)WOUT, (const char*)KVN, (const char*)GRPW, (char*)BTO, (const char*)WQN, (char*)WINQ, 0};
          EpiPlain E{0, F_S};
          pg8::gemm_phase<EpiPlain, SchedFold, false>(F.lds, F.scr, 256, 4096u, 4096u, (size_t)128 * 4096, S, E); }
        }
        {
            LAS unsigned* scr = (LAS unsigned*)(F.lds + F.wave * 16384);
            constexpr int NMOE = 64 * I_SQ + 64 * I_DN - TAIL_ITEMS; static_assert(NMOE % 16 == 0 && TAIL_PER0 % 16 == 0, "tickets of 16 items");
            const int NTK = (NMOE + (F.G >= EARLY_PLAIN_MIN_G ? TAIL_PER0 : 0)) / 16;
#define CONV_DESC(d_, it_) do { const int ci_ = (it_); if (ci_ < NMOE) TR_DECODE(d_, NSMALL + ci_); else TAIL_DESC(d_, TAIL_PER0 + ci_ - NMOE); } while (0)
            unsigned* q = ctl + CW_CONVQ; volatile LAS unsigned* tk = MISC + 16; TrDesc dA, dB; f32x4 vA[16], vB[16];
            __syncthreads(); if (F.tid == 0) tk[0] = xb_add(q, 1u); __syncthreads();
            unsigned b = tk[0]; int par = 1;
            while (b < (unsigned)NTK) { unsigned nt = 0u; if (F.tid == 0) nt = xb_add(q, 1u);
                const int iA = (int)b * 16 + F.wave;
                CONV_DESC(dA, iA); tr_load(dA, vA, F.lane); CONV_DESC(dB, iA + 8); tr_load(dB, vB, F.lane);
                tr_finish(dA, vA, scr, F.lane); tr_finish(dB, vB, scr, F.lane);
                if (F.tid == 0) tk[par] = nt; __syncthreads(); b = tk[par]; par ^= 1; }
        }
#undef CONV_DESC
#undef TR_RUN
#undef TR_ID

#undef TR_DECODE
    }
    SEAM(1);
    PHASE(2) { REPBAR();
        if (F.G < EARLY_PLAIN_MIN_G) {
        for (int i = gt; i < 2 * 2048 * 128; i += NGT) { const int b = i >> 18, n = (i >> 7) & 2047, c = i & 127;
            const u32x4 w = *(const u32x4*)(WOUT + (size_t)D * D + (size_t)n * D + c * 8); u32x4 o;
            u32x2 o8; o8.x = pk4_fp8(bflo(w.x) * WO_S, bfhi(w.x) * WO_S, bflo(w.y) * WO_S, bfhi(w.y) * WO_S); o8.y = pk4_fp8(bflo(w.z) * WO_S, bfhi(w.z) * WO_S, bflo(w.w) * WO_S, bfhi(w.w) * WO_S);
            *(u32x2*)((unsigned char*)(BTO + (size_t)(2 + b) * (2048 * 1536) + (size_t)n * 1536) + 1024 + c * 8) = o8; }
        { SchedFold S{F.G, F.bid, (const char*)WOUT, (const char*)KVN, (const char*)GRPW, (char*)BTO, (const char*)WQN, (char*)WINQ, 0};
          EpiPlain E{0, F_S};
          pg8::gemm_phase<EpiPlain, SchedFold, false>(F.lds, F.scr, 256, 4096u, 4096u, (size_t)128 * 4096, S, E); }
        { SchedFold S{F.G, F.bid, (const char*)WOUT, (const char*)KVN, (const char*)GRPW, (char*)BTO, (const char*)WQN, (char*)WINQ, 1};
          EpiFp8 E{VW_S, 3072, WQ_S, 2048};
          pg8::gemm_phase<EpiFp8, SchedFold, false>(F.lds, F.scr, 256, 4096u, 4096u, (size_t)128 * 4096, S, E); }
        }
    }
    if (F.G < EARLY_PLAIN_MIN_G) SEAM(2);

    layer_phases<0>(args, F, bar, ctl, lo, hi, gw, NGW, gt, NGT);
    layer_phases<1>(args, F, bar, ctl, lo, hi, gw, NGW, gt, NGT);
    PHASE(23) { REPBAR();
        f32x4 gv[4][2];
#pragma unroll
        for (int j = 0; j < 4; ++j) { gv[j][0] = ((const f32x4*)final_norm_g)[F.lane * 2 + 128 * j]; gv[j][1] = ((const f32x4*)final_norm_g)[F.lane * 2 + 128 * j + 1]; }
        for (int m0 = gw; m0 < T; m0 += 2 * NGW) {
            u32x4 xw[2][4]; u32x2 ya[2][4], yb[2][4]; const int m1 = m0 + NGW; const bool has1 = m1 < T;
#pragma unroll
            for (int rr = 0; rr < 2; ++rr) { const int m = (rr == 0 || has1) ? (rr ? m1 : m0) : m0;
                const u32x4* xr = (const u32x4*)(XB + (size_t)m * D) + F.lane; const u32x2* y0r = (const u32x2*)(YB0 + (size_t)m * D) + F.lane; const u32x2* y1r = (const u32x2*)(YB1 + (size_t)m * D) + F.lane;
#pragma unroll
                for (int j = 0; j < 4; ++j) { xw[rr][j] = xr[64 * j]; ya[rr][j] = y0r[64 * j]; yb[rr][j] = y1r[64 * j]; } }
#pragma unroll
            for (int rr = 0; rr < 2; ++rr) { if (rr == 1 && !has1) break; const int m = rr ? m1 : m0;
                float xv[4][8]; float s = 0.f;
#pragma unroll
                for (int j = 0; j < 4; ++j) { const u32x4 v = xw[rr][j]; float fa[8], fb[8]; fp8x8_to_f32(ya[rr][j], fa); fp8x8_to_f32(yb[rr][j], fb);
                    const float xx[8] = {bflo(v.x), bfhi(v.x), bflo(v.y), bfhi(v.y), bflo(v.z), bfhi(v.z), bflo(v.w), bfhi(v.w)};
#pragma unroll
                    for (int e = 0; e < 8; ++e) { xv[j][e] = xx[e] + (fa[e] + fb[e]) * (1.0f / Y_S); s += xv[j][e] * xv[j][e]; } }
                const float rstd = __builtin_amdgcn_rsqf(wave_sum(s) * (1.0f / D) + EPS);
                f32x4* o = (f32x4*)(args.out + (size_t)m * D) + F.lane * 2;
#pragma unroll
                for (int j = 0; j < 4; ++j) { const f32x4 ga = gv[j][0], gb = gv[j][1];
                    o[128 * j] = (f32x4){xv[j][0] * rstd * ga[0], xv[j][1] * rstd * ga[1], xv[j][2] * rstd * ga[2], xv[j][3] * rstd * ga[3]};
                    o[128 * j + 1] = (f32x4){xv[j][4] * rstd * gb[0], xv[j][5] * rstd * gb[1], xv[j][6] * rstd * gb[2], xv[j][7] * rstd * gb[3]}; } }
        }
    }
#undef IN
#undef SEAM
}

extern "C" void kernel_launch(void* const* d_in, const int* in_sizes, int n_in, void* d_out, int out_size, void* d_ws, size_t ws_size, hipStream_t stream) {
    static int grid = 0;
    if (grid == 0) {
        if (n_in != 22 || out_size != T * D || ws_size < WS_END) { fprintf(stderr, "kernel_launch: unexpected shapes (n_in %d, out %d, ws %zu)\n", n_in, out_size, ws_size); grid = -1; return; }
        int dev = 0, cus = 0, per_cu = 0;
        if (hipGetDevice(&dev) != hipSuccess || hipDeviceGetAttribute(&cus, hipDeviceAttributeMultiprocessorCount, dev) != hipSuccess) { grid = -1; return; }
        if (hipFuncSetAttribute((const void*)fwd, hipFuncAttributeMaxDynamicSharedMemorySize, LDS_BYTES) != hipSuccess) { fprintf(stderr, "kernel_launch: hipFuncSetAttribute failed\n"); grid = -1; return; }
        if (hipOccupancyMaxActiveBlocksPerMultiprocessor(&per_cu, (const void*)fwd, NWAVES * 64, LDS_BYTES) != hipSuccess || per_cu < 1) { fprintf(stderr, "kernel_launch: occupancy query says %d\n", per_cu); }
        (void)hipGetLastError();
        grid = cus;
    }
    if (grid < 0) return;
    (void)hipMemsetAsync((char*)d_ws + WS_CTL, 0, CTL_ZERO_BYTES, stream);
    Args a{};
    for (int i = 0; i < 22; ++i) a.in[i] = (const float*)d_in[i];
    a.out = (float*)d_out; a.ws = (unsigned char*)d_ws;
#if MK_PER_PHASE
    for (int p = 0; p < NPHASE; ++p) { a.ph_lo = p; a.ph_hi = p + 1; hipLaunchKernelGGL(fwd, dim3(grid), dim3(NWAVES * 64), LDS_BYTES, stream, a); }
#else
    a.ph_lo = 0; a.ph_hi = NPHASE; hipLaunchKernelGGL(fwd, dim3(grid), dim3(NWAVES * 64), LDS_BYTES, stream, a);
#endif
}
```

```cpp
#include <hip/hip_runtime.h>
#include <cstdio>
#include <cstdint>

#ifndef MK_PER_PHASE
#define MK_PER_PHASE 0
#endif

#define GAS __attribute__((address_space(1)))
#define LAS __attribute__((address_space(3)))
typedef unsigned short bf16_t;
typedef short bf16x8 __attribute__((ext_vector_type(8)));
typedef float f32x4 __attribute__((ext_vector_type(4)));
typedef float f32x2 __attribute__((ext_vector_type(2)));
typedef unsigned u32x4 __attribute__((ext_vector_type(4)));
typedef unsigned u32x2 __attribute__((ext_vector_type(2)));
typedef int i32x4 __attribute__((ext_vector_type(4)));
typedef int i32x8 __attribute__((ext_vector_type(8)));

constexpr int T = 32768, SEQ = 16384, D = 2048, NMEM = 256, NEXP = 32, DEXP = 1024;
constexpr float EPS = 1e-6f;
constexpr int NWAVES = 8;
constexpr int NPHASE = 24;
constexpr float GU_WS = 64.f, DN_WS = 32.f, HID_S = 8.f, Y_S = 16.f, WQ_S = 64.f, WIN_S = 64.f, MX_S = 8.f, WO_S = 128.f, P_S = 256.f, VW_S = 4.f, F_S = P_S * VW_S;

constexpr size_t MiB = 1u << 20;
constexpr size_t WS_CTL = 0, CTL_ZERO_BYTES = 1 * MiB;
constexpr size_t WS_RSTD = 1 * MiB;
constexpr size_t RSTD_STRIDE = 320 * 1024;
constexpr size_t WS_PART1 = 2 * MiB;
constexpr size_t WS_PART2 = 10 * MiB;
constexpr size_t WS_SSQV = 14 * MiB;
constexpr size_t WS_LOGITS = 16 * MiB;
constexpr size_t WS_LIST = 32 * MiB;
constexpr size_t WS_GATEW = 40 * MiB;
constexpr size_t WS_KMAT = 48 * MiB;
constexpr size_t WS_VT = 50 * MiB;
constexpr size_t WS_MEMN = 52 * MiB;
constexpr size_t WS_WIN0 = 56 * MiB;
constexpr size_t WS_WIN1 = 64 * MiB;
constexpr size_t WS_WOUT = 76 * MiB;
constexpr size_t WS_WKV = 92 * MiB;
constexpr size_t WS_GRP = 108 * MiB;
constexpr size_t WS_W2 = 109 * MiB;
constexpr size_t WS_CNT = 108 * MiB + 512 * 1024;
constexpr size_t WS_TOKREC = 109 * MiB + 512 * 1024;
constexpr size_t WS_RT = 110 * MiB;
constexpr size_t WS_GUT = 112 * MiB;
constexpr size_t WS_DOWNT = 624 * MiB;
constexpr size_t WS_XB = 880 * MiB;
constexpr size_t WS_PROJ = 1010 * MiB;
constexpr size_t WS_POOLED = 1202 * MiB;
constexpr size_t WS_PBUF = 1266 * MiB;
constexpr size_t WS_CONCAT = 1330 * MiB;
constexpr size_t WS_HIDDEN = 1458 * MiB;
constexpr size_t WS_XB8 = 1618 * MiB;
constexpr size_t WS_BTO = 1684 * MiB;
constexpr size_t WS_GRPW = 1716 * MiB;
constexpr size_t WS_WQN = 1718 * MiB;
constexpr size_t WS_WINQ = 1734 * MiB;
constexpr size_t WS_END = 1750 * MiB;
constexpr int CW_BAR = 4096;
constexpr int CW_CONVQ = 2048;
constexpr int EARLY_PLAIN_MIN_G = 176;
constexpr int CW_CURSOR = 16384;

constexpr int RING_BYTES = 131072;
constexpr int SCR_OFF = RING_BYTES;
constexpr int SCR_IDX = 8192, SCR_TAB = 20480, SCR_BYTES = 22528;
constexpr int MISC_OFF = SCR_OFF + SCR_BYTES;
constexpr int LDS_BYTES = MISC_OFF + 128;
constexpr int MAX_MOE_UNITS = 12;

#define RLX_AGENT __ATOMIC_RELAXED, __HIP_MEMORY_SCOPE_AGENT
#define LDS_WAIT() asm volatile("s_waitcnt lgkmcnt(0)" ::: "memory")
#define VM_WAIT() asm volatile("s_waitcnt vmcnt(0)" ::: "memory")
__device__ __forceinline__ int rfl(int v) { return __builtin_amdgcn_readfirstlane(v); }
__device__ __forceinline__ unsigned f2bf(float f) { unsigned u = __builtin_bit_cast(unsigned, f); return (u + 0x7fffu + ((u >> 16) & 1u)) >> 16; }
__device__ __forceinline__ unsigned pk2(float lo, float hi) { return f2bf(lo) | (f2bf(hi) << 16); }
__device__ __forceinline__ unsigned cvt_pk_bf16(float lo, float hi) { unsigned r; asm volatile("v_cvt_pk_bf16_f32 %0, %1, %2" : "=v"(r) : "v"(lo), "v"(hi)); return r; }
__device__ __forceinline__ unsigned pk4_fp8(float a, float b, float c, float d) {
    a = __builtin_amdgcn_fmed3f(a, -448.f, 448.f); b = __builtin_amdgcn_fmed3f(b, -448.f, 448.f); c = __builtin_amdgcn_fmed3f(c, -448.f, 448.f); d = __builtin_amdgcn_fmed3f(d, -448.f, 448.f);
    int w = 0; w = __builtin_amdgcn_cvt_pk_fp8_f32(a, b, w, false); w = __builtin_amdgcn_cvt_pk_fp8_f32(c, d, w, true); return (unsigned)w; }
typedef float f32x2v __attribute__((ext_vector_type(2)));
__device__ __forceinline__ void fp8x8_to_f32(const u32x2 w, float (&o)[8]) { const f32x2v a = __builtin_amdgcn_cvt_pk_f32_fp8((int)w.x, false), b = __builtin_amdgcn_cvt_pk_f32_fp8((int)w.x, true), c = __builtin_amdgcn_cvt_pk_f32_fp8((int)w.y, false), d = __builtin_amdgcn_cvt_pk_f32_fp8((int)w.y, true);
    o[0] = a.x; o[1] = a.y; o[2] = b.x; o[3] = b.y; o[4] = c.x; o[5] = c.y; o[6] = d.x; o[7] = d.y; }
__device__ __forceinline__ float bflo(unsigned w) { return __uint_as_float(w << 16); }
__device__ __forceinline__ float bfhi(unsigned w) { return __uint_as_float(w & 0xffff0000u); }
__device__ __forceinline__ float wave_sum(float v) {
#pragma unroll
    for (int o = 1; o < 64; o <<= 1) v += __shfl_xor(v, o);
    return v;
}
__device__ __forceinline__ float gelu_tanh(float x) {
    const float e = __builtin_amdgcn_exp2f(x * (-2.302208198f - 0.1029432396f * x * x));
    return x * __builtin_amdgcn_rcpf(1.0f + e);
}
__device__ __forceinline__ float silu_f(float x) { return x * __builtin_amdgcn_rcpf(1.0f + __builtin_amdgcn_exp2f(-1.442695041f * x)); }

#define XB_TMO      128
#define XB_XCNT(j)  (256  + 64 * (j))
#define XB_XSUB(j)  (1280 + 64 * (j))
#define XB_XGEN(j)  (2304 + 64 * (j))
#define XB_TOP      3328
#define XB_TOPGEN   3392
#define XCD_BAR_WORDS 3456
#define XB_SPIN_CAP (1u << 20)

__device__ __forceinline__ unsigned xb_ld(unsigned* p)              { return __hip_atomic_load(p, __ATOMIC_RELAXED, __HIP_MEMORY_SCOPE_AGENT); }
__device__ __forceinline__ unsigned xb_add(unsigned* p, unsigned v) { return __hip_atomic_fetch_add(p, v, __ATOMIC_RELAXED, __HIP_MEMORY_SCOPE_AGENT); }
__device__ __forceinline__ unsigned xb_xcc_id() { return (unsigned)__builtin_amdgcn_s_getreg((3 << 11) | 20) & 0xFu; }
#define XB_SPIN(cond, bar) do { unsigned _sp = 0; while (cond) { __builtin_amdgcn_s_sleep(1); \
    if ((++_sp & 255u) == 0u) { if (xb_ld(&(bar)[XB_TMO])) break; if (_sp > XB_SPIN_CAP) { atomicAdd(&(bar)[XB_TMO], 1u); break; } } } } while (0)

struct XcdBarrier { unsigned* bar; unsigned x; volatile LAS unsigned* st; };
__device__ __forceinline__ XcdBarrier xcd_barrier_post(unsigned* bar, volatile LAS unsigned* st) {
    XcdBarrier b; b.bar = bar; b.x = xb_xcc_id(); b.st = st;
    if (threadIdx.x == 0) (void)xb_add(&bar[XB_XCNT(b.x)], 1u);
    return b;
}
__device__ __forceinline__ void xcd_barrier_complete(unsigned* bar, unsigned x, unsigned& nloc, unsigned& nx) {
    const unsigned G = gridDim.x * gridDim.y * gridDim.z;
    unsigned sum, cnt, mine, sp = 0u;
    for (;;) {
        sum = 0u; cnt = 0u; mine = 0u;
#pragma unroll
        for (unsigned j = 0; j < 16; ++j) { const unsigned c = xb_ld(&bar[XB_XCNT(j)]); sum += c; cnt += (c > 0u) ? 1u : 0u; mine = (j == x) ? c : mine; }
        if (sum == G) break;
        __builtin_amdgcn_s_sleep(1);
        if ((++sp & 255u) == 0u) { if (xb_ld(&bar[XB_TMO])) break; if (sp > XB_SPIN_CAP) { atomicAdd(&bar[XB_TMO], 1u); break; } }
    }
    nloc = mine > 0u ? mine : 1u; nx = cnt > 0u ? cnt : 1u;
}
__device__ __forceinline__ void xcd_barrier(const XcdBarrier& b) {
    asm volatile("s_waitcnt vmcnt(0)" ::: "memory");
    __syncthreads();
    if (threadIdx.x == 0) {
        unsigned* bar = b.bar;
        __builtin_amdgcn_s_waitcnt(0);
        unsigned nloc = b.st[0], nx = b.st[1];
        if (nloc == 0u) { xcd_barrier_complete(bar, b.x, nloc, nx); b.st[0] = nloc; b.st[1] = nx; }
        const unsigned old = xb_add(&bar[XB_XSUB(b.x)], 1u);
        const unsigned gen = old / nloc;
        if (old + 1u == (gen + 1u) * nloc) {
            __builtin_amdgcn_fence(__ATOMIC_RELEASE, "agent");
            asm volatile("s_waitcnt vmcnt(0)" ::: "memory");
            const unsigned og = xb_add(&bar[XB_TOP], 1u);
            const unsigned tg = og / nx;
            if (og + 1u == (tg + 1u) * nx) xb_add(&bar[XB_TOPGEN], 1u);
            else XB_SPIN(xb_ld(&bar[XB_TOPGEN]) == tg, bar);
            __builtin_amdgcn_fence(__ATOMIC_ACQUIRE, "agent");
            xb_add(&bar[XB_XGEN(b.x)], 1u);
            asm volatile("s_waitcnt vmcnt(0)" ::: "memory");
        } else {
            XB_SPIN(xb_ld(&bar[XB_XGEN(b.x)]) == gen, bar);
            __builtin_amdgcn_fence(__ATOMIC_ACQUIRE, "agent");
            asm volatile("s_waitcnt vmcnt(0)" ::: "memory");
        }
    }
    __syncthreads();
}

namespace pg8 {
constexpr int BM = 256, BK = 64, HALF = 128, HTB = HALF * BK * 2, NXCD = 8, WGM = 4;
__device__ __forceinline__ int lds_byte(int r, int c) { const int st = (r >> 4) * 2 + (c >> 5), rr = r & 15, cc = c & 31, ob = rr * 64 + cc * 2; return st * 1024 + (ob ^ (((ob >> 9) & 1) << 5)); }
__device__ __forceinline__ void stage_rc(int b, int& R, int& C) { const int st = b / 1024, sb = b % 1024, swz = sb ^ (((sb >> 9) & 1) << 5); R = (st >> 1) * 16 + swz / 64; C = (st & 1) * 32 + (swz % 64) / 2; }
__device__ __forceinline__ int perm32(int rho) { const int n = rho >> 4, i = rho & 15; return 8 * (i >> 2) + 4 * n + (i & 3); }

struct Unit { const char* A; const char* B; char* C; int pm, pn, aux, nvalid; };

__device__ __forceinline__ bool grid_order(int i, int G, int c, int nM, int nN, int& pm, int& pn) {
    const int nwg = nM * nN; const long L = (long)i * G + c; if (L >= nwg) return false;
    int wgid = (int)L; { const int q = nwg / NXCD, r = nwg % NXCD, xcd = wgid % NXCD, off = wgid / NXCD; wgid = (xcd < r ? xcd * (q + 1) : r * (q + 1) + (xcd - r) * q) + off; }
    const int nig = WGM * nN, gid = wgid / nig, fm = gid * WGM, gsz = (nM - fm) < WGM ? (nM - fm) : WGM;
    pm = fm + ((wgid % nig) % gsz); pn = (wgid % nig) / gsz; return true;
}
struct SchedGrid {
    int nM, nN, G, c; const char* A0; size_t a_pm, a_pn; const char* B0; size_t b_bt, b_pn; char* C0; size_t c_pm, c_pn;
    __device__ __forceinline__ bool next(int i, Unit& u) const {
        int pm, pn; if (!grid_order(i, G, c, nM, nN, pm, pn)) return false;
        u.pm = pm; u.pn = pn; u.aux = 0; u.nvalid = 256;
        u.A = A0 + (size_t)pm * a_pm + (size_t)pn * a_pn; u.B = B0 + (size_t)(pm >> 6) * b_bt + (size_t)pn * b_pn; u.C = C0 + (size_t)pm * c_pm + (size_t)pn * c_pn; return true;
    }
    __device__ __forceinline__ int row(int, int) const { return 0; }
};

template <bool F8> struct FragSel { struct A { i32x4 v[4][2]; }; struct B { i32x4 v[2][2]; }; };
template <> struct FragSel<true> { struct A { i32x8 v[4]; }; struct B { i32x8 v[2]; }; };
template <class Epi, class Sched, bool GATHER, bool FP8 = false, bool HALFSKIP = false, bool EPI2 = false, int MIXSW = 0>
__device__ __forceinline__ void gemm_phase(LAS unsigned char* lds, LAS unsigned char* scr, const int K, const unsigned lda2, const unsigned ldb2, const size_t hstepB, const Sched& S, const Epi& E) {
    const int tid = threadIdx.x, wid = __builtin_amdgcn_readfirstlane(tid >> 6), lane = tid & 63, wr = wid >> 2, wc = wid & 3, fr = lane & 15, fq = lane >> 4;
    const int nt = K / BK;
    unsigned voffB[2], vAc[2][2], vAn[2][2]; int Rr[2], Cc[2];
#pragma unroll
    for (int i = 0; i < 2; ++i) { int R, C; stage_rc(tid * 16 + i * 8192, R, C); const int Rb = (R & ~31) + perm32(R & 31); Rr[i] = R; Cc[i] = C;
        voffB[i] = (unsigned)Rb * ldb2 + (unsigned)C * 2u; vAc[0][i] = (unsigned)R * lda2 + (unsigned)C * 2u; vAc[1][i] = vAc[0][i]; vAn[0][i] = vAc[0][i]; vAn[1][i] = vAc[0][i]; }
    const size_t kstep = (size_t)(BK * 2);
    const size_t hstepA = GATHER ? (size_t)0 : (size_t)HALF * lda2;
    const unsigned ldsw = (unsigned)wid * 1024u;
    const int aoff = lds_byte(wr * 64 + fr, fq * 8), boff = lds_byte(wc * 32 + fr, fq * 8);
#define PG8_SA(b, h) (((b) * 2 + (h)) * HTB)
#define PG8_SB(b, h) ((4 + (b) * 2 + (h)) * HTB)
#define PG8_STG(bufoff, gptr, v0, v1) do { \
        __builtin_amdgcn_global_load_lds((const unsigned*)((const char*)(gptr) + (v0)), (LAS unsigned*)(lds + (bufoff) + ldsw), 16, 0, 0); \
        __builtin_amdgcn_global_load_lds((const unsigned*)((const char*)(gptr) + (v1)), (LAS unsigned*)(lds + (bufoff) + ldsw + 8192), 16, 0, 0); } while (0)
#define PG8_STG_B(b, h, bp) PG8_STG(PG8_SB(b, h), (bp) + (h) * hstepB, voffB[0], voffB[1])
#define PG8_STG_A(b, h, ap, nx) do { if constexpr (GATHER) { const unsigned _o0 = (nx) ? vAn[h][0] : vAc[h][0], _o1 = (nx) ? vAn[h][1] : vAc[h][1]; PG8_STG(PG8_SA(b, h), (ap), _o0, _o1); } \
        else { PG8_STG(PG8_SA(b, h), (ap) + (h) * hstepA, vAc[0][0], vAc[0][1]); } } while (0)
#define PG8_LDA(KIND, b, h) do { _Pragma("unroll") for (int m = 0; m < 4; ++m) { const i32x4 _l0 = *(const LAS i32x4*)(lds + PG8_SA(b, h) + aoff + m * 2048), _l1 = *(const LAS i32x4*)(lds + PG8_SA(b, h) + aoff + m * 2048 + 1024); \
        if constexpr (KIND) AtQ.v[m] = __builtin_shufflevector(_l0, _l1, 0, 1, 2, 3, 4, 5, 6, 7); else { AtH.v[m][0] = _l0; AtH.v[m][1] = _l1; } } } while (0)
#define PG8_LDB(KIND, W, b, h) do { _Pragma("unroll") for (int n = 0; n < 2; ++n) { const i32x4 _l0 = *(const LAS i32x4*)(lds + PG8_SB(b, h) + boff + n * 2048), _l1 = *(const LAS i32x4*)(lds + PG8_SB(b, h) + boff + n * 2048 + 1024); \
        if constexpr (KIND) B##W##Q.v[n] = __builtin_shufflevector(_l0, _l1, 0, 1, 2, 3, 4, 5, 6, 7); else { B##W##H.v[n][0] = _l0; B##W##H.v[n][1] = _l1; } } } while (0)
#define PG8_MMA(KIND, ai, bj, W) do { __builtin_amdgcn_s_setprio(1); _Pragma("unroll") for (int m = 0; m < 4; ++m) _Pragma("unroll") for (int n = 0; n < 2; ++n) { \
        if constexpr (KIND) asm volatile("v_mfma_scale_f32_16x16x128_f8f6f4 %0, %1, %2, %0, %3, %3 op_sel_hi:[0,0,0]" : "+v"(acc[ai][bj][m][n]) : "v"(B##W##Q.v[n]), "v"(AtQ.v[m]), "v"(scl1)); \
        else { _Pragma("unroll") for (int k = 0; k < 2; ++k) acc[ai][bj][m][n] = __builtin_amdgcn_mfma_f32_16x16x32_bf16(__builtin_bit_cast(bf16x8, B##W##H.v[n][k]), __builtin_bit_cast(bf16x8, AtH.v[m][k]), acc[ai][bj][m][n], 0, 0, 0); } } \
        __builtin_amdgcn_s_setprio(0); } while (0)
#define PG8_WAIT_V(n) asm volatile("s_waitcnt vmcnt(" #n ")" ::: "memory")
#define PG8_WAIT_L(n) asm volatile("s_waitcnt lgkmcnt(" #n ")" ::: "memory")
#define PG8_BAR __builtin_amdgcn_s_barrier()
#define PG8_SCHED __builtin_amdgcn_sched_barrier(0)
    Unit cur, nxt; int ui = 0;
    if (!S.next(0, cur)) return;
    int scl1 = 0x7f7f7f7f; asm volatile("" : "+v"(scl1));
    if constexpr (GATHER) {
#pragma unroll
        for (int h = 0; h < 2; ++h)
#pragma unroll
            for (int i = 0; i < 2; ++i) vAc[h][i] = (unsigned)S.row(0, Rr[i] + HALF * h) * lda2 + (unsigned)Cc[i] * 2u;
    }
    f32x4 acc[2][2][4][2];
#pragma unroll
    for (int a = 0; a < 2; ++a)
#pragma unroll
        for (int b = 0; b < 2; ++b)
#pragma unroll
            for (int m = 0; m < 4; ++m)
#pragma unroll
                for (int n = 0; n < 2; ++n) acc[a][b][m][n] = (f32x4){0.f, 0.f, 0.f, 0.f};
    typename FragSel<false>::A AtH; typename FragSel<false>::B B0H, B1H; typename FragSel<true>::A AtQ; typename FragSel<true>::B B0Q, B1Q;
    const char* cA = cur.A; const char* cB = cur.B;
    PG8_STG_B(0, 0, cB); PG8_STG_B(0, 1, cB); PG8_STG_A(0, 0, cA, false); PG8_STG_A(0, 1, cA, false);
    if (wr == 1) PG8_BAR;
    PG8_WAIT_V(2); PG8_BAR;
    PG8_STG_B(1, 0, cB + kstep); PG8_STG_A(1, 0, cA + kstep, false); PG8_STG_B(1, 1, cB + kstep);
    PG8_WAIT_V(6); PG8_BAR;
    for (;;) {
        const bool has_next = S.next(ui + 1, nxt);
        const char* nA = has_next ? nxt.A : cA; const char* nB = has_next ? nxt.B : cB;
        if constexpr (GATHER) {
#pragma unroll
            for (int h = 0; h < 2; ++h)
#pragma unroll
                for (int i = 0; i < 2; ++i) vAn[h][i] = has_next ? (unsigned)S.row(ui + 1, Rr[i] + HALF * h) * lda2 + (unsigned)Cc[i] * 2u : vAc[h][i];
        }
#define PG8_KLOOP(KIND, MMA1, TBEG, TEND, FINAL) _Pragma("unroll 1") for (int t = (TBEG); t < (TEND); t += 2) { \
            const bool last = (FINAL) && (t == nt - 2); \
            const char* a1 = cA + (size_t)(t + 1) * kstep; \
            const char* a2 = last ? nA : cA + (size_t)(t + 2) * kstep; const char* b2 = last ? nB : cB + (size_t)(t + 2) * kstep; \
            const char* a3 = a2 + kstep; const char* b3 = b2 + kstep; \
              \
            PG8_LDB(KIND, 0, 0, 0); PG8_LDB(KIND, 1, 0, 1); PG8_SCHED; PG8_LDA(KIND, 0, 0); PG8_STG_A(1, 1, a1, false); \
            PG8_WAIT_V(8); PG8_WAIT_L(0); PG8_BAR; PG8_MMA(KIND, 0, 0, 0); PG8_MMA(KIND, 0, 1, 1); PG8_BAR; PG8_SCHED; \
              \
            PG8_LDA(KIND, 0, 1); PG8_STG_B(0, 0, b2); PG8_STG_B(0, 1, b2); PG8_STG_A(0, 0, a2, last); \
            PG8_WAIT_V(8); PG8_WAIT_L(0); PG8_BAR; if (MMA1) { PG8_MMA(KIND, 1, 0, 0); PG8_MMA(KIND, 1, 1, 1); } PG8_BAR; PG8_SCHED; \
              \
            PG8_LDB(KIND, 0, 1, 0); PG8_LDB(KIND, 1, 1, 1); PG8_SCHED; PG8_LDA(KIND, 1, 0); PG8_STG_A(0, 1, a2, last); \
            PG8_WAIT_V(8); PG8_WAIT_L(0); PG8_BAR; PG8_MMA(KIND, 0, 0, 0); PG8_MMA(KIND, 0, 1, 1); PG8_BAR; PG8_SCHED; \
              \
            PG8_LDA(KIND, 1, 1); PG8_STG_B(1, 0, b3); PG8_STG_B(1, 1, b3); PG8_STG_A(1, 0, a3, last); \
            PG8_WAIT_V(8); PG8_WAIT_L(0); PG8_BAR; if (MMA1) { PG8_MMA(KIND, 1, 0, 0); PG8_MMA(KIND, 1, 1, 1); } PG8_BAR; PG8_SCHED; \
        }
#define PG8_KLOOPS(KIND, TBEG, TEND, FINAL) do { if (HALFSKIP && cur.nvalid <= 128) { PG8_KLOOP(KIND, false, TBEG, TEND, FINAL) } else { PG8_KLOOP(KIND, true, TBEG, TEND, FINAL) } } while (0)
        if constexpr (MIXSW > 0) { PG8_KLOOPS(0, 0, MIXSW, false); PG8_KLOOPS(1, MIXSW, nt, true); }
        else if constexpr (FP8) { PG8_KLOOPS(1, 0, nt, true); }
        else { PG8_KLOOPS(0, 0, nt, true); }
        if constexpr (FP8 || MIXSW > 0) asm volatile("s_nop 15\n\ts_nop 15" ::: "memory");
        if (wr == 0) PG8_BAR;
        E(acc, cur, ui, wr, wc, fr, fq, scr);
        if constexpr (EPI2) { asm volatile("" ::: "memory"); E(acc, cur, ui, wr, wc, fr, fq, scr); }
        if (!has_next) break;
#pragma unroll
        for (int a = 0; a < 2; ++a)
#pragma unroll
            for (int b = 0; b < 2; ++b)
#pragma unroll
                for (int m = 0; m < 4; ++m)
#pragma unroll
                    for (int n = 0; n < 2; ++n) acc[a][b][m][n] = (f32x4){0.f, 0.f, 0.f, 0.f};
        cur = nxt; cA = nA; cB = nB; ++ui;
        if constexpr (GATHER) {
#pragma unroll
            for (int h = 0; h < 2; ++h)
#pragma unroll
                for (int i = 0; i < 2; ++i) vAc[h][i] = vAn[h][i];
        }
        if (wr == 1) PG8_BAR;
    }
    PG8_WAIT_V(0);
    PG8_BAR;
#undef PG8_KLOOPS
#undef PG8_KLOOP
#undef PG8_SA
#undef PG8_SB
#undef PG8_STG
#undef PG8_STG_A
#undef PG8_STG_B
#undef PG8_LDA
#undef PG8_LDB
#undef PG8_MMA
#undef PG8_WAIT_V
#undef PG8_WAIT_L
#undef PG8_BAR
#undef PG8_SCHED
}
}
using pg8::Unit;

typedef f32x4 Acc[2][2][4][2];
#define EPI_ROWS(ai, m) (128 * (ai) + 64 * wr + 16 * (m) + fr)
#define EPI_COL0 (32 * wc + 8 * fq)
__device__ __forceinline__ u32x4 pack8(const f32x4 a, const f32x4 b) { u32x4 w; w.x = cvt_pk_bf16(a[0], a[1]); w.y = cvt_pk_bf16(a[2], a[3]); w.z = cvt_pk_bf16(b[0], b[1]); w.w = cvt_pk_bf16(b[2], b[3]); return w; }

struct EpiPlain {
    int ldc; float scale;
    __device__ __forceinline__ void operator()(Acc& acc, const Unit& u, int, int wr, int wc, int fr, int fq, LAS unsigned char*) const {
        asm volatile("" : "+v"(fr), "+v"(fq));
        const int ld = ldc ? ldc : u.aux; bf16_t* base = (bf16_t*)u.C + EPI_COL0;
#pragma unroll
        for (int ai = 0; ai < 2; ++ai)
#pragma unroll
            for (int m = 0; m < 4; ++m) { bf16_t* rowp = base + (size_t)EPI_ROWS(ai, m) * ld;
#pragma unroll
                for (int bj = 0; bj < 2; ++bj) *(u32x4*)(rowp + bj * 128) = pack8(acc[ai][bj][m][0] * scale, acc[ai][bj][m][1] * scale); }
    }
};
__device__ __forceinline__ void epi_softmax(Acc& acc, const Unit& u, int wr, int wc, int fr, int fq, LAS unsigned char* scr, int ldc, float c) {
    LAS float* XA = (LAS float*)scr; LAS float* XB = (LAS float*)(scr + 4096);
#pragma unroll
    for (int ai = 0; ai < 2; ++ai)
#pragma unroll
        for (int m = 0; m < 4; ++m) { float mx = -3.0e38f;
#pragma unroll
            for (int bj = 0; bj < 2; ++bj)
#pragma unroll
                for (int n = 0; n < 2; ++n) { const f32x4 x = acc[ai][bj][m][n]; mx = fmaxf(mx, fmaxf(fmaxf(x[0], x[1]), fmaxf(x[2], x[3]))); }
            mx = fmaxf(mx, __shfl_xor(mx, 16)); mx = fmaxf(mx, __shfl_xor(mx, 32));
            if (fq == 0) XA[EPI_ROWS(ai, m) * 4 + wc] = mx; }
    LDS_WAIT(); __builtin_amdgcn_s_barrier(); asm volatile("" ::: "memory");
#pragma unroll
    for (int ai = 0; ai < 2; ++ai)
#pragma unroll
        for (int m = 0; m < 4; ++m) { const f32x4 q = *(const LAS f32x4*)(XA + EPI_ROWS(ai, m) * 4); const float mx = fmaxf(fmaxf(q[0], q[1]), fmaxf(q[2], q[3])) * c; float s = 0.f;
#pragma unroll
            for (int bj = 0; bj < 2; ++bj)
#pragma unroll
                for (int n = 0; n < 2; ++n) { f32x4 x = acc[ai][bj][m][n];
#pragma unroll
                    for (int j = 0; j < 4; ++j) { x[j] = __builtin_amdgcn_exp2f(x[j] * c - mx); s += x[j]; }
                    acc[ai][bj][m][n] = x; }
            s += __shfl_xor(s, 16); s += __shfl_xor(s, 32);
            if (fq == 0) XB[EPI_ROWS(ai, m) * 4 + wc] = s; asm volatile("" ::: "memory"); }
    LDS_WAIT(); __builtin_amdgcn_s_barrier(); asm volatile("" ::: "memory");
    unsigned char* base = (unsigned char*)u.C + 32 * wc + 8 * (fq & ~1); const bool odd = fq & 1;
#pragma unroll
    for (int ai = 0; ai < 2; ++ai) {
        u32x2 w8[4][2];
#pragma unroll
        for (int m = 0; m < 4; ++m) { const int r = EPI_ROWS(ai, m); const f32x4 q = *(const LAS f32x4*)(XB + r * 4); const float inv = P_S * __builtin_amdgcn_rcpf((q[0] + q[1]) + (q[2] + q[3]));
#pragma unroll
            for (int bj = 0; bj < 2; ++bj) { const f32x4 v0 = acc[ai][bj][m][0] * inv, v1 = acc[ai][bj][m][1] * inv; w8[m][bj].x = pk4_fp8(v0[0], v0[1], v0[2], v0[3]); w8[m][bj].y = pk4_fp8(v1[0], v1[1], v1[2], v1[3]); } }
#pragma unroll
        for (int mp = 0; mp < 4; mp += 2)
#pragma unroll
            for (int bj = 0; bj < 2; ++bj) { const u32x2 mine = odd ? w8[mp + 1][bj] : w8[mp][bj], send = odd ? w8[mp][bj] : w8[mp + 1][bj];
                u32x2 recv; recv.x = (unsigned)__shfl_xor((int)send.x, 16); recv.y = (unsigned)__shfl_xor((int)send.y, 16);
                u32x4 o; if (odd) { o.x = recv.x; o.y = recv.y; o.z = mine.x; o.w = mine.y; } else { o.x = mine.x; o.y = mine.y; o.z = recv.x; o.w = recv.y; }
                *(u32x4*)(base + (size_t)EPI_ROWS(ai, mp + (odd ? 1 : 0)) * ldc + bj * 128) = o; }
        asm volatile("" ::: "memory"); }
}
struct EpiFp8 {
    float scale0; int ldc0; float scale1; int ldc1;
    __device__ __forceinline__ void operator()(Acc& acc, const Unit& u, int, int wr, int wc, int fr, int fq, LAS unsigned char*) const {
        asm volatile("" : "+v"(fr), "+v"(fq));
        unsigned char* base = (unsigned char*)u.C + EPI_COL0; const float scale = u.aux ? scale1 : scale0; const int ldc = u.aux ? ldc1 : ldc0;
#pragma unroll
        for (int ai = 0; ai < 2; ++ai)
#pragma unroll
            for (int m = 0; m < 4; ++m)
#pragma unroll
                for (int bj = 0; bj < 2; ++bj) { const f32x4 v0 = acc[ai][bj][m][0] * scale, v1 = acc[ai][bj][m][1] * scale; u32x2 w; w.x = pk4_fp8(v0[0], v0[1], v0[2], v0[3]); w.y = pk4_fp8(v1[0], v1[1], v1[2], v1[3]);
                    *(u32x2*)(base + (size_t)EPI_ROWS(ai, m) * ldc + bj * 128) = w; }
    }
};
template <int MODE> struct EpiProj {
    int ldc; const float* rs; float* ssqv; int qt;
    LAS float* rtab; float sc;
    __device__ __forceinline__ void operator()(Acc& acc, const Unit& u, int ui, int wr, int wc, int fr, int fq, LAS unsigned char* scr) const {
        asm volatile("" : "+v"(fr), "+v"(fq));
        bf16_t* base = (bf16_t*)u.C + EPI_COL0;
#pragma unroll
        for (int ai = 0; ai < 2; ++ai)
#pragma unroll
            for (int m = 0; m < 4; ++m) {
                const int r = EPI_ROWS(ai, m), t = u.pm * 256 + r; const float rstd = rtab[ui * 256 + r] * sc;
                float sq = 0.f;
#pragma unroll
                for (int bj = 0; bj < 2; ++bj) { f32x4 v0 = acc[ai][bj][m][0] * rstd, v1 = acc[ai][bj][m][1] * rstd;
                    if (MODE == 1 && u.pn < 8) {
#pragma unroll
                        for (int j = 0; j < 4; ++j) { v0[j] = gelu_tanh(v0[j]); v1[j] = gelu_tanh(v1[j]); } }
                    const u32x4 w = pack8(v0, v1);
                    if (MODE == 1) { const float a0 = bflo(w.x), a1 = bfhi(w.x), a2 = bflo(w.y), a3 = bfhi(w.y), a4 = bflo(w.z), a5 = bfhi(w.z), a6 = bflo(w.w), a7 = bfhi(w.w);
                        sq += (a0 * a0 + a1 * a1) + (a2 * a2 + a3 * a3) + (a4 * a4 + a5 * a5) + (a6 * a6 + a7 * a7); }
                    *(u32x4*)(base + (size_t)r * ldc + bj * 128) = w; }
                if (MODE == 1 && u.pn >= 4 && u.pn < 8) { sq += __shfl_xor(sq, 16); sq += __shfl_xor(sq, 32); if (fq == 0) ssqv[(size_t)t * 16 + (u.pn - 4) * 4 + wc] = sq; }
            }
    }
};
template <int MODE> struct EpiScore {
    LAS float* rtab;
    __device__ __forceinline__ void operator()(Acc& acc, const Unit& u, int ui, int wr, int wc, int fr, int fq, LAS unsigned char* scr) const {
        asm volatile("" : "+v"(fr), "+v"(fq));
#pragma unroll
        for (int ai = 0; ai < 2; ++ai)
#pragma unroll
            for (int m = 0; m < 4; ++m) { const float rstd = rtab[ui * 256 + EPI_ROWS(ai, m)];
#pragma unroll
                for (int bj = 0; bj < 2; ++bj) { acc[ai][bj][m][0] = acc[ai][bj][m][0] * rstd; acc[ai][bj][m][1] = acc[ai][bj][m][1] * rstd; } }
        epi_softmax(acc, u, wr, wc, fr, fq, scr, 3072, 1.442695041f / WQ_S);
    }
};
struct EpiSpatial {
    const bf16_t* uproj; const float* bs;
    __device__ __forceinline__ void operator()(Acc& acc, const Unit& u, int, int wr, int wc, int fr, int fq, LAS unsigned char*) const {
        asm volatile("" : "+v"(fr), "+v"(fq));
        unsigned char* base = (unsigned char*)u.C + EPI_COL0; const bf16_t* ub = uproj + (size_t)u.pm * 256 * 3072 + u.pn * 256 + EPI_COL0;
#pragma unroll
        for (int ai = 0; ai < 2; ++ai)
#pragma unroll
            for (int m = 0; m < 4; ++m) { const int r = EPI_ROWS(ai, m); const float b = bs[u.pn * 128 + (r & 127)];
#pragma unroll
                for (int bj = 0; bj < 2; ++bj) { const u32x4 uw = *(const u32x4*)(ub + (size_t)r * 3072 + bj * 128); f32x4 v0 = acc[ai][bj][m][0] + b, v1 = acc[ai][bj][m][1] + b;
                    v0[0] *= bflo(uw.x); v0[1] *= bfhi(uw.x); v0[2] *= bflo(uw.y); v0[3] *= bfhi(uw.y); v1[0] *= bflo(uw.z); v1[1] *= bfhi(uw.z); v1[2] *= bflo(uw.w); v1[3] *= bfhi(uw.w);
                    v0 = v0 * MX_S; v1 = v1 * MX_S; u32x2 w8; w8.x = pk4_fp8(v0[0], v0[1], v0[2], v0[3]); w8.y = pk4_fp8(v1[0], v1[1], v1[2], v1[3]);
                    *(u32x2*)(base + (size_t)r * 3072 + bj * 128) = w8; }
                asm volatile("" ::: "memory"); }
    }
};
struct EpiOut {
    float* part; unsigned char* xb8; float rsc;
    __device__ __forceinline__ void operator()(Acc& acc, const Unit& u, int, int wr, int wc, int fr, int fq, LAS unsigned char* scr) const {
        asm volatile("" : "+v"(fr), "+v"(fq));
        bf16_t* base = (bf16_t*)u.C + EPI_COL0; LAS float* XA = (LAS float*)scr;
        const bool odd = fq & 1;
#pragma unroll
        for (int ai = 0; ai < 2; ++ai) {
            u32x4 xw[4][2];
#pragma unroll
            for (int m = 0; m < 4; ++m)
#pragma unroll
                for (int bj = 0; bj < 2; ++bj) xw[m][bj] = *(const u32x4*)(base + (size_t)EPI_ROWS(ai, m) * D + bj * 128);
            u32x2 w8[4][2];
#pragma unroll
            for (int m = 0; m < 4; ++m) { const int r = EPI_ROWS(ai, m); float sq = 0.f;
#pragma unroll
                for (int bj = 0; bj < 2; ++bj) { u32x4* p = (u32x4*)(base + (size_t)r * D + bj * 128); const u32x4 x = xw[m][bj]; f32x4 v0 = acc[ai][bj][m][0] * rsc, v1 = acc[ai][bj][m][1] * rsc;
                    v0[0] += bflo(x.x); v0[1] += bfhi(x.x); v0[2] += bflo(x.y); v0[3] += bfhi(x.y); v1[0] += bflo(x.z); v1[1] += bfhi(x.z); v1[2] += bflo(x.w); v1[3] += bfhi(x.w);
                    const u32x4 w = pack8(v0, v1); *p = w;
                    const float a0 = bflo(w.x), a1 = bfhi(w.x), a2 = bflo(w.y), a3 = bfhi(w.y), a4 = bflo(w.z), a5 = bfhi(w.z), a6 = bflo(w.w), a7 = bfhi(w.w);
                    w8[m][bj].x = pk4_fp8(a0, a1, a2, a3); w8[m][bj].y = pk4_fp8(a4, a5, a6, a7);
                    sq += (a0 * a0 + a1 * a1) + (a2 * a2 + a3 * a3) + (a4 * a4 + a5 * a5) + (a6 * a6 + a7 * a7); }
                sq += __shfl_xor(sq, 16); sq += __shfl_xor(sq, 32);
                if (fq == 0) XA[r * 4 + wc] = sq; }
#pragma unroll
            for (int mp = 0; mp < 4; mp += 2)
#pragma unroll
                for (int bj = 0; bj < 2; ++bj) { const u32x2 mine = odd ? w8[mp + 1][bj] : w8[mp][bj], send = odd ? w8[mp][bj] : w8[mp + 1][bj];
                    u32x2 recv; recv.x = (unsigned)__shfl_xor((int)send.x, 16); recv.y = (unsigned)__shfl_xor((int)send.y, 16);
                    u32x4 o; if (odd) { o.x = recv.x; o.y = recv.y; o.z = mine.x; o.w = mine.y; } else { o.x = mine.x; o.y = mine.y; o.z = recv.x; o.w = recv.y; }
                    const int r = EPI_ROWS(ai, mp + (odd ? 1 : 0));
                    *(u32x4*)(xb8 + (size_t)(u.pm * 256 + r) * D + u.pn * 256 + bj * 128 + 32 * wc + 8 * (fq & ~1)) = o; }
            asm volatile("" ::: "memory"); }
        LDS_WAIT(); __builtin_amdgcn_s_barrier(); asm volatile("" ::: "memory");
        { int tid = threadIdx.x; asm volatile("" : "+v"(tid));
          if (tid < 256) { const f32x4 q = *(const LAS f32x4*)(XA + tid * 4); part[(size_t)(u.pm * 256 + tid) * 8 + u.pn] = (q[0] + q[1]) + (q[2] + q[3]); } }
    }
};
struct EpiRoute {
    float* lg;
    __device__ __forceinline__ void operator()(Acc& acc, const Unit& u, int, int wr, int wc, int fr, int fq, LAS unsigned char*) const {
        asm volatile("" : "+v"(fr), "+v"(fq));
        if (wc >= 2) return;
        float* base = lg + (size_t)u.pn * T * 64 + (size_t)u.pm * 256 * 64 + EPI_COL0;
#pragma unroll
        for (int ai = 0; ai < 2; ++ai)
#pragma unroll
            for (int m = 0; m < 4; ++m) { float* rowp = base + (size_t)EPI_ROWS(ai, m) * 64;
                if (wc == 0) { *(f32x4*)rowp = acc[ai][0][m][0] + acc[ai][1][m][0]; *(f32x4*)(rowp + 4) = acc[ai][0][m][1] + acc[ai][1][m][1]; }
                else if (fq == 0) *(f32x4*)rowp = acc[ai][0][m][0] + acc[ai][1][m][0]; }
    }
};
struct SchedMoe {
    LAS int* pre; LAS int* cnt; LAS int* idx; LAS int* preB; LAS int* preS; int lo, hi, G, c, nbu, nunits; int mode;
    int perm;
    __device__ __forceinline__ int plist(int p) const { return perm ? ((p & 1) * 32 + (p >> 1)) : p; }
    LAS int* ul; int nmy;
    const char* A0; const char* B0; char* C0;
    __device__ __forceinline__ bool decode(int i, int& l, int& rt, int& pn, int& tile) const {
        const long L = (long)i * G + c; if (L >= nunits) return false;
        int wgid = (int)L, q; LAS int* px; bool small = wgid >= nbu;
        if (!small) { const int qq = nbu / 8, r = nbu % 8, xcd = wgid % 8, off = wgid / 8; wgid = (xcd < r ? xcd * (qq + 1) : r * (qq + 1) + (xcd - r) * qq) + off; q = wgid >> 3; px = preB; }
        else { wgid -= nbu; q = wgid >> 3; px = preS; }
        pn = wgid & 7;
        const int base = rfl(px[lo]); int a = lo, b = hi;
        while (b - a > 1) { const int mid = (a + b) >> 1; if (rfl(px[mid]) - base <= q) a = mid; else b = mid; }
        l = a; rt = small ? ((rfl(cnt[l]) + 255) >> 8) - 1 : q - (rfl(px[l]) - base); tile = rfl(pre[l]) + rt; return true;
    }
    __device__ __forceinline__ void decode_t(int i, int& l, int& rt, int& pn, int& tile) const {
        int wgid = i * G + c, q; LAS int* px; const bool small = wgid >= nbu;
        if (!small) { const int qq = nbu / 8, r = nbu % 8, xcd = wgid % 8, off = wgid / 8; wgid = (xcd < r ? xcd * (qq + 1) : r * (qq + 1) + (xcd - r) * qq) + off; q = wgid >> 3; px = preB; }
        else { wgid -= nbu; q = wgid >> 3; px = preS; }
        pn = wgid & 7;
        const int base = px[lo]; int a = lo, b = hi;
        while (b - a > 1) { const int mid = (a + b) >> 1; if (px[mid] - base <= q) a = mid; else b = mid; }
        l = plist(a); rt = small ? ((cnt[l] + 255) >> 8) - 1 : q - (px[a] - base); tile = pre[l] + rt;
    }
    __device__ __forceinline__ bool next(int i, Unit& u) const {
        if (i >= nmy) return false;
        const int w0 = rfl(ul[2 * i]), w1 = rfl(ul[2 * i + 1]); const int l = w0 & 255, rt = (w0 >> 8) & 4095, pn = w0 >> 20, tile = w1 & 0xffff;
        const int e = l & 31;
        u.pm = rt; u.pn = pn; u.aux = l; u.nvalid = w1 >> 16;
        if (mode == 0) { u.A = A0; u.B = B0 + (size_t)e * (2048 * 2048) + (size_t)pn * (128 * 2048); u.C = C0 + (size_t)tile * (256 * 1024) + (size_t)pn * 128; }
        else { u.A = A0 + (size_t)tile * (256 * 1024); u.B = B0 + (size_t)e * (2048 * 1024) + (size_t)pn * (256 * 1024); u.C = C0; }
        return true;
    }
    __device__ __forceinline__ int row(int j, int r) const { return idx[j * 256 + r] & 0x1ffff; }
};
template <int KIND  >
__device__ __forceinline__ void moe_setup(SchedMoe& S, const int* totals, const int* listp, const float* vals) {
    int tid = threadIdx.x; LAS int* cnt = S.cnt;
    if (tid < 64) { const int c_ = totals[tid]; cnt[tid] = c_; int a = (c_ + 255) >> 8;
        const int cp = totals[S.plist(tid)], nt_ = (cp + 255) >> 8, sm = (nt_ > 0 && cp - (nt_ - 1) * 256 <= 128) ? 1 : 0; int ab = nt_ - sm, as = sm;
#pragma unroll
        for (int o = 1; o < 64; o <<= 1) { const int ta = __shfl_up(a, o), tb = __shfl_up(ab, o), ts = __shfl_up(as, o); if (tid >= o) { a += ta; ab += tb; as += ts; } }
        S.pre[tid + 1] = a; S.preB[tid + 1] = ab; S.preS[tid + 1] = as; if (tid == 0) { S.pre[0] = 0; S.preB[0] = 0; S.preS[0] = 0; } }
    __syncthreads();
    S.nbu = (rfl(S.preB[S.hi]) - rfl(S.preB[S.lo])) * 8; S.nunits = S.nbu + (rfl(S.preS[S.hi]) - rfl(S.preS[S.lo])) * 8;
    { const int n_ = S.c < S.nunits ? (S.nunits - S.c + S.G - 1) / S.G : 0; S.nmy = n_ < MAX_MOE_UNITS ? n_ : MAX_MOE_UNITS; }
    if (tid < S.nmy) { int li, rt, pn, tile; S.decode_t(tid, li, rt, pn, tile); const int nv_ = cnt[li] - rt * 256; S.ul[2 * tid] = li | (rt << 8) | (pn << 20); S.ul[2 * tid + 1] = tile | ((nv_ < 256 ? nv_ : 256) << 16); }
    __syncthreads();
    const int j2 = tid >> 8, r = tid & 255; int tk[6]; float vv[6]; size_t off[6];
#pragma unroll
    for (int q = 0; q < 6; ++q) { const int j = j2 + 2 * q; tk[q] = T; vv[q] = 0.f; off[q] = 0;
        if (j < S.nmy) { const int w0 = S.ul[2 * j], w1 = S.ul[2 * j + 1]; const int li = w0 & 255, rt = (w0 >> 8) & 4095, nv = w1 >> 16;
            if (r < nv) { off[q] = (size_t)li * T + rt * 256 + r; tk[q] = listp[off[q]]; if (KIND == 1) vv[q] = vals[off[q]]; } } }
    if (KIND == 0) {
#pragma unroll
        for (int q = 0; q < 6; ++q) vv[q] = vals[tk[q]]; }
#pragma unroll
    for (int q = 0; q < 6; ++q) { const int j = j2 + 2 * q; if (j < S.nmy) S.idx[j * 256 + r] = tk[q] | (int)(((__float_as_uint(vv[q]) + 0x8000u) >> 16) << 17); }
    __syncthreads();
}
struct EpiGu {
    const float* rstd; LAS int* idx;
    __device__ __forceinline__ void operator()(Acc& acc, const Unit& u, int ui, int wr, int wc, int fr, int fq, LAS unsigned char*) const {
        asm volatile("" : "+v"(fr), "+v"(fq));
        unsigned char* base = (unsigned char*)u.C + EPI_COL0;
#pragma unroll
        for (int ai = 0; ai < 2; ++ai)
#pragma unroll
            for (int m = 0; m < 4; ++m) { const int r = EPI_ROWS(ai, m); const float rs = __uint_as_float(((unsigned)idx[ui * 256 + r] >> 17) << 16) * (1.0f / GU_WS);
                f32x4 h0, h1;
#pragma unroll
                for (int j = 0; j < 4; ++j) { h0[j] = silu_f(acc[ai][0][m][0][j] * rs) * (acc[ai][1][m][0][j] * (rs * HID_S)); h1[j] = silu_f(acc[ai][0][m][1][j] * rs) * (acc[ai][1][m][1][j] * (rs * HID_S)); }
                u32x2 w; w.x = pk4_fp8(h0[0], h0[1], h0[2], h0[3]); w.y = pk4_fp8(h1[0], h1[1], h1[2], h1[3]);
                *(u32x2*)(base + (size_t)r * DEXP) = w; }
    }
};
template <int MODE> struct EpiDown {
    bf16_t* xb; unsigned char* y0; unsigned char* y1; LAS int* idx; float* part; float rsc, ysc; unsigned char* x8;
    __device__ __forceinline__ void operator()(Acc& acc, const Unit& u, int ui, int wr, int wc, int fr, int fq, LAS unsigned char*) const {
        asm volatile("" : "+v"(fr), "+v"(fq));
        int tok[2][4]; float gt[2][4];
#pragma unroll
        for (int ai = 0; ai < 2; ++ai)
#pragma unroll
            for (int m = 0; m < 4; ++m) { const unsigned e = (unsigned)idx[ui * 256 + EPI_ROWS(ai, m)]; tok[ai][m] = (int)(e & 0x1ffffu); gt[ai][m] = __uint_as_float((e >> 17) << 16) * rsc; }
        if constexpr (MODE == 0) {
            unsigned char* yb = (u.aux >> 5) ? y1 : y0; const bool odd = fq & 1;
#pragma unroll
            for (int ai = 0; ai < 2; ++ai) {
                u32x2 w8[4][2];
#pragma unroll
                for (int m = 0; m < 4; ++m) { const float g = gt[ai][m] * Y_S;
#pragma unroll
                    for (int bj = 0; bj < 2; ++bj) { const f32x4 v0 = acc[ai][bj][m][0] * g, v1 = acc[ai][bj][m][1] * g; w8[m][bj].x = pk4_fp8(v0[0], v0[1], v0[2], v0[3]); w8[m][bj].y = pk4_fp8(v1[0], v1[1], v1[2], v1[3]); } }
#pragma unroll
                for (int mp = 0; mp < 4; mp += 2) { const int msk = -(int)(fq & 1); const int tk = (tok[ai][mp] & ~msk) | (tok[ai][mp + 1] & msk); const int ts = tk + (tk >= T ? 1 : 0);
#pragma unroll
                    for (int bj = 0; bj < 2; ++bj) { const u32x2 mine = odd ? w8[mp + 1][bj] : w8[mp][bj], send = odd ? w8[mp][bj] : w8[mp + 1][bj];
                        u32x2 recv; recv.x = (unsigned)__shfl_xor((int)send.x, 16); recv.y = (unsigned)__shfl_xor((int)send.y, 16);
                        u32x4 o; if (odd) { o.x = recv.x; o.y = recv.y; o.z = mine.x; o.w = mine.y; } else { o.x = mine.x; o.y = mine.y; o.z = recv.x; o.w = recv.y; }
                        *(u32x4*)(yb + (size_t)ts * D + u.pn * 256 + bj * 128 + 32 * wc + 8 * (fq & ~1)) = o; } }
                asm volatile("" ::: "memory"); }
        } else {
#pragma unroll
            for (int ai = 0; ai < 2; ++ai) {
                u32x4 xw[4][2]; u32x2 yw[4][2]; u32x2 w8[4][2];
#pragma unroll
                for (int m = 0; m < 4; ++m)
#pragma unroll
                    for (int bj = 0; bj < 2; ++bj) { xw[m][bj] = *(const u32x4*)(xb + (size_t)tok[ai][m] * D + u.pn * 256 + EPI_COL0 + bj * 128); yw[m][bj] = *(const u32x2*)(y0 + (size_t)tok[ai][m] * D + u.pn * 256 + EPI_COL0 + bj * 128); }
#pragma unroll
                for (int m = 0; m < 4; ++m) { const float g = gt[ai][m]; float sq = 0.f; const int ts = tok[ai][m] + (tok[ai][m] >= T ? 1 : 0); bf16_t* rowp = xb + (size_t)ts * D + u.pn * 256 + EPI_COL0;
#pragma unroll
                    for (int bj = 0; bj < 2; ++bj) { const u32x4 x = xw[m][bj]; float y[8]; fp8x8_to_f32(yw[m][bj], y); f32x4 v0 = acc[ai][bj][m][0] * g, v1 = acc[ai][bj][m][1] * g;
                        v0[0] += bflo(x.x) + y[0] * ysc; v0[1] += bfhi(x.x) + y[1] * ysc; v0[2] += bflo(x.y) + y[2] * ysc; v0[3] += bfhi(x.y) + y[3] * ysc;
                        v1[0] += bflo(x.z) + y[4] * ysc; v1[1] += bfhi(x.z) + y[5] * ysc; v1[2] += bflo(x.w) + y[6] * ysc; v1[3] += bfhi(x.w) + y[7] * ysc;
                        const u32x4 w = pack8(v0, v1); *(u32x4*)(rowp + bj * 128) = w;
                        const float a0 = bflo(w.x), a1 = bfhi(w.x), a2 = bflo(w.y), a3 = bfhi(w.y), a4 = bflo(w.z), a5 = bfhi(w.z), a6 = bflo(w.w), a7 = bfhi(w.w);
                        w8[m][bj].x = pk4_fp8(a0, a1, a2, a3); w8[m][bj].y = pk4_fp8(a4, a5, a6, a7);
                        sq += (a0 * a0 + a1 * a1) + (a2 * a2 + a3 * a3) + (a4 * a4 + a5 * a5) + (a6 * a6 + a7 * a7); }
                    if (part) { sq += __shfl_xor(sq, 16); sq += __shfl_xor(sq, 32); if (fq == 0 && ts < T) part[(size_t)ts * 32 + u.pn * 4 + wc] = sq; } }
#pragma unroll
                for (int mp = 0; mp < 4; mp += 2) { const int msk = -(int)(fq & 1); const int tk = (tok[ai][mp] & ~msk) | (tok[ai][mp + 1] & msk); const int ts = tk + (tk >= T ? 1 : 0); const bool odd = fq & 1;
#pragma unroll
                    for (int bj = 0; bj < 2; ++bj) { const u32x2 mine = odd ? w8[mp + 1][bj] : w8[mp][bj], send = odd ? w8[mp][bj] : w8[mp + 1][bj];
                        u32x2 recv; recv.x = (unsigned)__shfl_xor((int)send.x, 16); recv.y = (unsigned)__shfl_xor((int)send.y, 16);
                        u32x4 o; if (odd) { o.x = recv.x; o.y = recv.y; o.z = mine.x; o.w = mine.y; } else { o.x = mine.x; o.y = mine.y; o.z = recv.x; o.w = recv.y; }
                        *(u32x4*)(x8 + (size_t)ts * D + u.pn * 256 + bj * 128 + 32 * wc + 8 * (fq & ~1)) = o; } }
                asm volatile("" ::: "memory"); }
        }
    }
};
struct SchedSp { pg8::SchedGrid g; __device__ __forceinline__ bool next(int i, Unit& u) const { if (!g.next(i, u)) return false; u.B = g.B0 + ((size_t)u.pm * 4 + u.pn) * (256 * 512); return true; } __device__ __forceinline__ int row(int, int) const { return 0; } };
struct SchedProj {
    int nN, qt, G, c; const char* A0; const char* B0; const char* BQ; char* C0; size_t c_pm; char* CQ; int rb;
    __device__ __forceinline__ bool next(int i, Unit& u) const {
        int pm, pn; if (!pg8::grid_order(i, G, c, T / 256, nN, pm, pn)) return false;
        u.pm = pm; u.pn = pn; u.aux = 0; u.nvalid = 256;
        if (qt) { u.A = A0 + (size_t)pm * 256 * rb; u.B = B0 + (size_t)pn * 256 * rb; u.C = C0 + (size_t)pm * c_pm + (size_t)pn * 512; }
        else { u.A = A0 + (size_t)pm * (256 * 2048); u.B = BQ + (size_t)(pm >> 6) * (1024 * 2048) + (size_t)pn * (256 * 2048); u.C = CQ + (size_t)pm * (256 * 3072) + (size_t)(2048 + pn * 256); }
        return true;
    }
    __device__ __forceinline__ int row(int, int) const { return 0; }
};
template <int MODE, class Sched> __device__ __forceinline__ void proj_fill_rstd(const Sched& S, const float* rs, LAS float* rtab) {
    Unit u; int tid = threadIdx.x;
    for (int j = 0; j < 6 && S.next(j, u); ++j)
        if (tid < 256) { const int t = u.pm * 256 + tid; float v;
            if (MODE == 0) v = rs[t];
            else { const f32x4* pp = (const f32x4*)(rs + (size_t)t * 32); float sm = 0.f;
#pragma unroll
                for (int q = 0; q < 8; ++q) { const f32x4 p = pp[q]; sm += (p[0] + p[1]) + (p[2] + p[3]); }
                v = __builtin_amdgcn_rsqf(sm * (1.0f / D) + EPS); }
            rtab[j * 256 + tid] = v; }
    __syncthreads();
}
struct SchedKV {
    int G, c; const char* memn; const char* wkv; char* kvn;
    __device__ __forceinline__ bool next(int i, Unit& u) const {
        const int id = i * G + c; if (id >= 32) return false;
        const int l = id >> 4, b = (id >> 3) & 1, j = id & 7;
        u.pm = 0; u.pn = 0; u.nvalid = 256; u.aux = 2048;
        u.A = memn + (size_t)l * (512 * 4096) + (size_t)b * (256 * 4096); u.B = wkv + (size_t)l * (2048 * 4096) + (size_t)j * (256 * 4096);
        u.C = kvn + (size_t)l * (512 * 4096) + (size_t)b * (256 * 4096) + (size_t)j * 512; return true;
    }
    __device__ __forceinline__ int row(int, int) const { return 0; }
};
struct SchedFold {
    int G, c; const char* woutT; const char* kvn; const char* grpn; char* bto; const char* wqn; char* winq; int mode; int nmax;
    __device__ __forceinline__ bool next(int i, Unit& u) const {
        const int id = i * G + c; if (id >= (mode ? 256 : 64) || (nmax && i >= nmax)) return false;
        u.pm = 0; u.pn = 0; u.nvalid = 256; u.aux = 0;
        if (mode == 0) { const int b = id >> 5, g = (id >> 3) & 3, rt = id & 7;
            u.A = woutT + (size_t)rt * (256 * 4096) + (size_t)g * 512; u.B = grpn + (size_t)g * 512;
            u.C = bto + (size_t)b * (2048 * 3072) + (size_t)rt * (256 * 3072) + (size_t)g * 512; u.aux = 1536; }
        else if (id < 128) { const int l = id >> 6, b = (id >> 5) & 1, h = (id >> 3) & 3, rt = id & 7;
            u.A = woutT + (size_t)l * (2048 * 4096) + (size_t)rt * (256 * 4096) + (size_t)(1024 + h * 256) * 2;
            u.B = kvn + (size_t)l * (512 * 4096) + (size_t)b * (256 * 4096) + (size_t)(1024 + h * 256) * 2;
            u.C = bto + (size_t)(l * 2 + b) * (2048 * 3072) + (size_t)rt * (256 * 3072) + (size_t)(2048 + h * 256); }
        else { const int r = id - 128, l = r >> 6, b = (r >> 5) & 1, h = (r >> 3) & 3, ct = r & 7;
            u.A = kvn + (size_t)l * (512 * 4096) + (size_t)b * (256 * 4096) + (size_t)h * 512;
            u.B = wqn + (size_t)l * (2048 * 4096) + (size_t)ct * (256 * 4096) + (size_t)h * 512;
            u.C = winq + (size_t)(l * 2 + b) * (1024 * 2048) + (size_t)h * (256 * 2048) + (size_t)ct * 256; u.aux = 1; }
        return true;
    }
    __device__ __forceinline__ int row(int, int) const { return 0; }
};

struct Args { const float* in[22]; float* out; unsigned char* ws; int ph_lo, ph_hi; };
struct Frame { LAS unsigned char* lds; LAS unsigned char* scr; int tid, lane, wave, G, bid; };

struct TrDesc { const float* W; void* WT; const float* ks; const float* ns; float cs; int ldw, kd, k0, n0; bool f8; };
__device__ __forceinline__ void tr_load(const TrDesc& d, f32x4 (&v)[16], int lane) {
    const int kq = lane >> 4, n4 = (lane & 15) * 4;
#pragma unroll
    for (int i = 0; i < 16; ++i) v[i] = *(const f32x4*)(d.W + (size_t)(d.k0 + 16 * kq + i) * d.ldw + d.n0 + n4);
}
__device__ __forceinline__ void tr_finish(const TrDesc& d, f32x4 (&v)[16], LAS unsigned* s32, int lane) {
    const int kq = lane >> 4, n4 = (lane & 15) * 4;
    f32x4 ns = (f32x4){d.cs, d.cs, d.cs, d.cs}; if (d.ns) ns = *(const f32x4*)(d.ns + d.n0 + n4) * d.cs;
    if (d.ks) {
#pragma unroll
        for (int q = 0; q < 4; ++q) { const f32x4 ks = *(const f32x4*)(d.ks + d.k0 + 16 * kq + 4 * q);
#pragma unroll
            for (int e = 0; e < 4; ++e) v[4 * q + e] = v[4 * q + e] * ks[e]; } }
#pragma unroll
    for (int i = 0; i < 16; ++i) v[i] = v[i] * ns;
    if (!d.f8) {
#pragma unroll
        for (int j = 0; j < 4; ++j)
#pragma unroll
            for (int p = 0; p < 8; ++p) s32[(n4 + j) * 33 + 8 * kq + p] = cvt_pk_bf16(v[2 * p][j], v[2 * p + 1][j]);
        LDS_WAIT(); asm volatile("" ::: "memory");
        const int c = lane & 7; bf16_t* WT = (bf16_t*)d.WT;
#pragma unroll
        for (int j = 0; j < 8; ++j) { const int n = (lane >> 3) + 8 * j; const LAS unsigned* sp = s32 + n * 33 + 4 * c;
            u32x4 o; o.x = sp[0]; o.y = sp[1]; o.z = sp[2]; o.w = sp[3];
            *(u32x4*)(WT + (size_t)(d.n0 + n) * d.kd + d.k0 + 8 * c) = o; }
    } else {
#pragma unroll
        for (int j = 0; j < 4; ++j)
#pragma unroll
            for (int p = 0; p < 4; ++p) s32[(n4 + j) * 17 + 4 * kq + p] = pk4_fp8(v[4 * p][j], v[4 * p + 1][j], v[4 * p + 2][j], v[4 * p + 3][j]);
        LDS_WAIT(); asm volatile("" ::: "memory");
        const int c = lane & 3; unsigned char* WT = (unsigned char*)d.WT;
#pragma unroll
        for (int j = 0; j < 4; ++j) { const int n = (lane >> 2) + 16 * j; const LAS unsigned* sp = s32 + n * 17 + 4 * c;
            u32x4 o; o.x = sp[0]; o.y = sp[1]; o.z = sp[2]; o.w = sp[3];
            *(u32x4*)(WT + (size_t)(d.n0 + n) * d.kd + d.k0 + 16 * c) = o; }
    }
    LDS_WAIT(); asm volatile("" ::: "memory");
}
__device__ __forceinline__ void tr_desc(TrDesc& d, const float* W, int K, int N, void* WT, const float* ks, const float* ns, float cs, bool f8, int item) {
    const int nblk = N / 64, kb = item / nblk, nb = item % nblk;
    d.W = W; d.WT = WT; d.ks = ks; d.ns = ns; d.cs = cs; d.ldw = N; d.kd = K; d.k0 = 64 * kb; d.n0 = 64 * nb; d.f8 = f8;
}

#define x_in (args.in[0])
#define mem_in (args.in[1])
#define norm_mix_g (args.in[2])
#define norm_mem_g (args.in[3])
#define norm_ffn_g (args.in[4])
#define pool_w_in (args.in[5])
#define pool_w_grp (args.in[6])
#define pool_scale (args.in[7])
#define pool_w_out (args.in[8])
#define sgu_w_in (args.in[9])
#define sgu_norm_g (args.in[10])
#define sgu_w_s (args.in[11])
#define sgu_b_s (args.in[12])
#define sgu_w_out (args.in[13])
#define xa_w_kv (args.in[14])
#define moe_w_group (args.in[15])
#define moe_b_group (args.in[16])
#define moe_w_expert (args.in[17])
#define moe_b_expert (args.in[18])
#define moe_w_gu (args.in[19])
#define moe_w_down (args.in[20])
#define final_norm_g (args.in[21])
#define WSP(type, off) ((type*)(args.ws + (off)))
#define RSTD0 WSP(float, WS_RSTD)
#define RSTD1 WSP(float, WS_RSTD + RSTD_STRIDE)
#define PART1 WSP(float, WS_PART1)
#define PART2 WSP(float, WS_PART2)
#define SSQV WSP(float, WS_SSQV)
#define LOGITS WSP(float, WS_LOGITS)
#define LIST WSP(int, WS_LIST)
#define GATEW WSP(float, WS_GATEW)
#define KMAT WSP(bf16_t, WS_KMAT)
#define VT WSP(bf16_t, WS_VT)
#define MEMN WSP(bf16_t, WS_MEMN)
#define WIN0 WSP(bf16_t, WS_WIN0)
#define WIN1 WSP(bf16_t, WS_WIN1)
#define WOUT WSP(bf16_t, WS_WOUT)
#define WKV WSP(bf16_t, WS_WKV)
#define GRP WSP(bf16_t, WS_GRP)
#define W2 WSP(bf16_t, WS_W2)
#define RT WSP(bf16_t, WS_RT)
#define GUT WSP(unsigned char, WS_GUT)
#define DOWNT WSP(unsigned char, WS_DOWNT)
#define XB WSP(bf16_t, WS_XB)
#define PROJ WSP(bf16_t, WS_PROJ)
#define POOLED WSP(bf16_t, WS_POOLED)
#define PBUF WSP(bf16_t, WS_PBUF)
#define CONCAT WSP(bf16_t, WS_CONCAT)
#define HIDDEN WSP(unsigned char, WS_HIDDEN)
#define CNTM WSP(int, WS_CNT)
#define TOTALS WSP(int, WS_CNT + 128 * 1024)
#define TOKREC WSP(u32x4, WS_TOKREC)
#define XB8 WSP(unsigned char, WS_XB8)
#define BTO WSP(bf16_t, WS_BTO)
#define GRPW WSP(bf16_t, WS_GRPW)
#define WQN WSP(bf16_t, WS_WQN)
#define WINQ WSP(unsigned char, WS_WINQ)
#define KVN WSP(bf16_t, WS_KMAT)
#define YB0 WSP(unsigned char, WS_PROJ)
#define YB1 WSP(unsigned char, WS_PROJ + 96 * MiB)

#ifndef PHMASK
#define PHMASK 0xffffffffu
#endif
#define IN(k) (((PHMASK >> (((k) < 3) ? (k) : ((k) == 23 ? 13 : 3 + ((k) - 3) % 10))) & 1u) && lo <= (k) && (k) < hi)
#ifndef PROBE_EPI2
#define PROBE_EPI2 false
#endif
#ifndef RMASK
#define RMASK 0u
#endif
#define PHASE(k) if (IN(k)) _Pragma("unroll") for (int rep_ = 0; rep_ < 1 + (int)((RMASK >> (k)) & 1u); ++rep_)
#define REPBAR() do { if (rep_) xcd_barrier(bar); } while (0)
#define SEAM(k) do { if (IN(k) && IN((k) + 1)) xcd_barrier(bar); } while (0)

constexpr int TAIL_PER0 = 4096, TAIL_PER1 = 2048, TAIL_WIN0 = 9, TAIL_WIN1 = 6, TAIL_ITEMS = TAIL_WIN0 * TAIL_PER0 + TAIL_WIN1 * TAIL_PER1;
constexpr int TAIL_HG = TAIL_ITEMS < 32768 ? TAIL_ITEMS : 32768, TAIL_HD = TAIL_ITEMS - TAIL_HG;
#define TAIL_DESC(d_, h_) do { const int hh_ = (h_); if (hh_ < 32768) { const int le_ = 32 + (hh_ >> 10); tr_desc(d_, moe_w_gu + (size_t)le_ * D * D, 2048, 2048, GUT + (size_t)le_ * D * D, norm_ffn_g + D, nullptr, GU_WS, true, hh_ & 1023); } \
        else { const int q_ = hh_ - 32768, le_ = 32 + (q_ >> 9); tr_desc(d_, moe_w_down + (size_t)le_ * DEXP * D, 1024, 2048, DOWNT + (size_t)le_ * DEXP * D, nullptr, nullptr, DN_WS, true, q_ & 511); } } while (0)
#define TAIL_TICKETS(w_) do { const int tb_ = (w_) * TAIL_PER0, nown_ = TAIL_PER0 / NWAVES, nhalf_ = TAIL_PER0 / 2 / NWAVES, nb_ = nown_ + ((w_) == 8 ? 1 : 2) * nhalf_; \
        const int sw0_ = (w_) == 6 ? 0 : (w_) == 7 ? 3 : 5, sw1_ = (w_) == 6 ? 2 : 4;     \
        unsigned* q_ = ctl + CW_CONVQ + 1 + ((w_) - 6); volatile LAS unsigned* tk_ = (volatile LAS unsigned*)(F.lds + MISC_OFF) + 16; \
        LAS unsigned* tscr_ = (LAS unsigned*)(F.lds + F.wave * 16384); TrDesc dA_; f32x4 vA_[16]; \
        __syncthreads(); if (F.tid == 0) tk_[0] = xb_add(q_, 1u); __syncthreads(); \
        unsigned b_ = tk_[0]; int par_ = 1; \
        while (b_ < (unsigned)nb_) { unsigned nt_ = 0u; if (F.tid == 0) nt_ = xb_add(q_, 1u); \
            { const int e_ = (int)b_ - nown_; const int h_ = e_ < 0 ? tb_ + (int)b_ * NWAVES : (e_ < nhalf_ ? sw0_ : sw1_) * TAIL_PER0 + TAIL_PER0 / 2 + (e_ % nhalf_) * NWAVES; \
              TAIL_DESC(dA_, h_ + F.wave); } tr_load(dA_, vA_, F.lane); tr_finish(dA_, vA_, tscr_, F.lane); \
            if (F.tid == 0) tk_[par_] = nt_; __syncthreads(); b_ = tk_[par_]; par_ ^= 1; } } while (0)
#define TAIL_CONVERT(w_) do { if constexpr (l == 0 && (w_) >= 6) TAIL_TICKETS(w_); else if ((l == 0) || (w_) < TAIL_WIN1) { const int tb_ = l == 0 ? (w_) * TAIL_PER0 : TAIL_WIN0 * TAIL_PER0 + (w_) * TAIL_PER1, tn_ = l == 0 ? ((w_) == 1 ? TAIL_PER0 : TAIL_PER0 / 2) : TAIL_PER1;     \
        __syncthreads(); LAS unsigned* tscr_ = (LAS unsigned*)(F.lds + F.wave * 16384); TrDesc dA_, dB_; f32x4 vA_[16], vB_[16]; \
        for (int j_ = gw; j_ < tn_; j_ += 2 * NGW) { const bool hasB_ = j_ + NGW < tn_; \
            TAIL_DESC(dA_, tb_ + j_); tr_load(dA_, vA_, F.lane); if (hasB_) { TAIL_DESC(dB_, tb_ + j_ + NGW); tr_load(dB_, vB_, F.lane); } \
            tr_finish(dA_, vA_, tscr_, F.lane); if (hasB_) tr_finish(dB_, vB_, tscr_, F.lane); } } } while (0)
template <int l> __device__ __forceinline__ void layer_phases(const Args& args, const Frame& F, const XcdBarrier& bar, unsigned* ctl, const int lo, const int hi, const int gw, const int NGW, const int gt, const int NGT) {
#ifdef LMASK
        if (!((LMASK >> l) & 1)) return;
#endif
        constexpr int pb = 3 + 10 * l;
        const int ldp = l ? 3072 : 2048, qoff = l ? 2048 : 1024;
        float* RS1 = (float*)((char*)RSTD1 + (size_t)l * RSTD_STRIDE); float* P1 = PART1 + (size_t)l * T * 32;
        PHASE(pb + 0) { REPBAR();
            if (l == 0) {
                if (F.G < EARLY_PLAIN_MIN_G)
                { SchedProj S{4, 4, F.G, F.bid, (const char*)XB, (const char*)WIN0, nullptr, (char*)PROJ, (size_t)256 * 2048 * 2, nullptr, 4096};
                  LAS float* rtab = (LAS float*)(F.scr + SCR_IDX); proj_fill_rstd<0>(S, RSTD0, rtab); EpiProj<0> E{2048, RSTD0, nullptr, 4, rtab, 1.f};
                  pg8::gemm_phase<EpiProj<0>, SchedProj, false>(F.lds, F.scr, 2048, 4096u, 4096u, (size_t)128 * 4096, S, E); }
                const bool early = F.G >= EARLY_PLAIN_MIN_G, poolfirst = early && (F.bid & 1);
                if (poolfirst) {
                for (int it = gt; it < (T / 32) * 128; it += NGT) {
                    const int chunk = it & 127, rb = it >> 7, c0 = chunk * 8, g = c0 >> 8, w = 2 << g, t0 = rb * 32, tl0 = t0 & (SEQ - 1);
                    const bf16_t* pp = PROJ + (size_t)t0 * 2048 + c0; bf16_t* op = CONCAT + (size_t)t0 * 1536 + c0; float s[8];
#pragma unroll
                    for (int j = 0; j < 8; ++j) s[j] = 0.f;
                    for (int j = 1; j < w; ++j) if (tl0 - j >= 0) { const u32x4 v = *(const u32x4*)(pp - (size_t)j * 2048);
                        s[0] += bflo(v.x); s[1] += bfhi(v.x); s[2] += bflo(v.y); s[3] += bfhi(v.y); s[4] += bflo(v.z); s[5] += bfhi(v.z); s[6] += bflo(v.w); s[7] += bfhi(v.w); }
#pragma unroll 8
                    for (int r = 0; r < 32; ++r) { const int tl = tl0 + r; const u32x4 v = *(const u32x4*)(pp + (size_t)r * 2048); float p[8] = {bflo(v.x), bfhi(v.x), bflo(v.y), bfhi(v.y), bflo(v.z), bfhi(v.z), bflo(v.w), bfhi(v.w)};
                        const float inv = 1.0f / (float)(tl + 1 < w ? tl + 1 : w); float o[8];
#pragma unroll
                        for (int j = 0; j < 8; ++j) { s[j] += p[j]; o[j] = s[j] * inv - p[j]; }
                        u32x4 ow; ow.x = pk2(o[0], o[1]); ow.y = pk2(o[2], o[3]); ow.z = pk2(o[4], o[5]); ow.w = pk2(o[6], o[7]); *(u32x4*)(op + (size_t)r * 1536) = ow;
                        if (tl - (w - 1) >= 0) { const u32x4 q = *(const u32x4*)(pp + (size_t)(r - (w - 1)) * 2048);
                            s[0] -= bflo(q.x); s[1] -= bfhi(q.x); s[2] -= bflo(q.y); s[3] -= bfhi(q.y); s[4] -= bflo(q.z); s[5] -= bfhi(q.z); s[6] -= bflo(q.w); s[7] -= bfhi(q.w); } }
                }
                                }
                { SchedProj S{4, 0, F.G, F.bid, (const char*)XB8, nullptr, (const char*)WINQ, nullptr, 0, (char*)CONCAT};
                  LAS float* rtab = (LAS float*)(F.scr + SCR_IDX); proj_fill_rstd<0>(S, RSTD0, rtab); EpiScore<0> E{rtab};
                  pg8::gemm_phase<EpiScore<0>, SchedProj, false, true>(F.lds, F.scr, 1024, 2048u, 2048u, (size_t)128 * 2048, S, E); }
                if (early && !poolfirst) {
                for (int it = gt; it < (T / 32) * 128; it += NGT) {
                    const int chunk = it & 127, rb = it >> 7, c0 = chunk * 8, g = c0 >> 8, w = 2 << g, t0 = rb * 32, tl0 = t0 & (SEQ - 1);
                    const bf16_t* pp = PROJ + (size_t)t0 * 2048 + c0; bf16_t* op = CONCAT + (size_t)t0 * 1536 + c0; float s[8];
#pragma unroll
                    for (int j = 0; j < 8; ++j) s[j] = 0.f;
                    for (int j = 1; j < w; ++j) if (tl0 - j >= 0) { const u32x4 v = *(const u32x4*)(pp - (size_t)j * 2048);
                        s[0] += bflo(v.x); s[1] += bfhi(v.x); s[2] += bflo(v.y); s[3] += bfhi(v.y); s[4] += bflo(v.z); s[5] += bfhi(v.z); s[6] += bflo(v.w); s[7] += bfhi(v.w); }
#pragma unroll 8
                    for (int r = 0; r < 32; ++r) { const int tl = tl0 + r; const u32x4 v = *(const u32x4*)(pp + (size_t)r * 2048); float p[8] = {bflo(v.x), bfhi(v.x), bflo(v.y), bfhi(v.y), bflo(v.z), bfhi(v.z), bflo(v.w), bfhi(v.w)};
                        const float inv = 1.0f / (float)(tl + 1 < w ? tl + 1 : w); float o[8];
#pragma unroll
                        for (int j = 0; j < 8; ++j) { s[j] += p[j]; o[j] = s[j] * inv - p[j]; }
                        u32x4 ow; ow.x = pk2(o[0], o[1]); ow.y = pk2(o[2], o[3]); ow.z = pk2(o[4], o[5]); ow.w = pk2(o[6], o[7]); *(u32x4*)(op + (size_t)r * 1536) = ow;
                        if (tl - (w - 1) >= 0) { const u32x4 q = *(const u32x4*)(pp + (size_t)(r - (w - 1)) * 2048);
                            s[0] -= bflo(q.x); s[1] -= bfhi(q.x); s[2] -= bflo(q.y); s[3] -= bfhi(q.y); s[4] -= bflo(q.z); s[5] -= bfhi(q.z); s[6] -= bflo(q.w); s[7] -= bfhi(q.w); } }
                }
                                }
            } else {
                { SchedProj S{8, 8, F.G, F.bid, (const char*)XB8, (const char*)WIN1, nullptr, (char*)PROJ, (size_t)256 * 3072 * 2, nullptr, 2048};
                  LAS float* rtab = (LAS float*)(F.scr + SCR_IDX); proj_fill_rstd<1>(S, PART2, rtab); EpiProj<1> E{3072, PART2, SSQV, 8, rtab, 1.f / WIN_S};
                  pg8::gemm_phase<EpiProj<1>, SchedProj, false, true>(F.lds, F.scr, 1024, 2048u, 2048u, (size_t)128 * 2048, S, E); }
            }
            TAIL_CONVERT(0);
        }
        SEAM(pb + 0);
        PHASE(pb + 1) { REPBAR();
            if (l == 0) {
                if (F.G < EARLY_PLAIN_MIN_G) {
                for (int it = gt; it < (T / 32) * 128; it += NGT) {
                    const int chunk = it & 127, rb = it >> 7, c0 = chunk * 8, g = c0 >> 8, w = 2 << g, t0 = rb * 32, tl0 = t0 & (SEQ - 1);
                    const bf16_t* pp = PROJ + (size_t)t0 * 2048 + c0; bf16_t* op = CONCAT + (size_t)t0 * 1536 + c0; float s[8];
#pragma unroll
                    for (int j = 0; j < 8; ++j) s[j] = 0.f;
                    for (int j = 1; j < w; ++j) if (tl0 - j >= 0) { const u32x4 v = *(const u32x4*)(pp - (size_t)j * 2048);
                        s[0] += bflo(v.x); s[1] += bfhi(v.x); s[2] += bflo(v.y); s[3] += bfhi(v.y); s[4] += bflo(v.z); s[5] += bfhi(v.z); s[6] += bflo(v.w); s[7] += bfhi(v.w); }
#pragma unroll 8
                    for (int r = 0; r < 32; ++r) { const int tl = tl0 + r; const u32x4 v = *(const u32x4*)(pp + (size_t)r * 2048); float p[8] = {bflo(v.x), bfhi(v.x), bflo(v.y), bfhi(v.y), bflo(v.z), bfhi(v.z), bflo(v.w), bfhi(v.w)};
                        const float inv = 1.0f / (float)(tl + 1 < w ? tl + 1 : w); float o[8];
#pragma unroll
                        for (int j = 0; j < 8; ++j) { s[j] += p[j]; o[j] = s[j] * inv - p[j]; }
                        u32x4 ow; ow.x = pk2(o[0], o[1]); ow.y = pk2(o[2], o[3]); ow.z = pk2(o[4], o[5]); ow.w = pk2(o[6], o[7]); *(u32x4*)(op + (size_t)r * 1536) = ow;
                        if (tl - (w - 1) >= 0) { const u32x4 q = *(const u32x4*)(pp + (size_t)(r - (w - 1)) * 2048);
                            s[0] -= bflo(q.x); s[1] -= bfhi(q.x); s[2] -= bflo(q.y); s[3] -= bfhi(q.y); s[4] -= bflo(q.z); s[5] -= bfhi(q.z); s[6] -= bflo(q.w); s[7] -= bfhi(q.w); } }
                }
                }
            } else {
                const bool sfirst = !(F.bid & 1);
                if (sfirst) {
                { SchedProj S{4, 0, F.G, F.bid, (const char*)XB8, nullptr, (const char*)(WINQ + (size_t)2 * 1024 * D), nullptr, 0, (char*)CONCAT};
                  LAS float* rtab = (LAS float*)(F.scr + SCR_IDX); proj_fill_rstd<1>(S, PART2, rtab); EpiScore<1> E{rtab};
                  pg8::gemm_phase<EpiScore<1>, SchedProj, false, true>(F.lds, F.scr, 1024, 2048u, 2048u, (size_t)128 * 2048, S, E); }
                  __syncthreads(); }
                pg8::SchedGrid S{T / 256, 4, F.G, F.bid, (const char*)W2, 0, (size_t)256 * 512, (const char*)POOLED, 0, (size_t)256 * 512, (char*)CONCAT + 1024, (size_t)256 * 3072, 256};
                SchedSp S2{S};
                LAS bf16_t* Ts = (LAS bf16_t*)F.lds; LAS float* rsv = (LAS float*)(F.lds + 128 * 264 * 2);
                Unit uu;
                for (int it = 0; S2.next(it >> 1, uu); ++it) { const int win = uu.pm, g = uu.pn, half = it & 1;
                    if (F.tid < 256) { const f32x4* pp = (const f32x4*)(SSQV + (size_t)(win * 256 + F.tid) * 16); const f32x4 a = pp[0], b = pp[1], c = pp[2], d = pp[3];
                        const float s = ((a[0] + a[1]) + (a[2] + a[3])) + ((b[0] + b[1]) + (b[2] + b[3])) + ((c[0] + c[1]) + (c[2] + c[3])) + ((d[0] + d[1]) + (d[2] + d[3]));
                        rsv[F.tid] = __builtin_amdgcn_rsqf(s * (1.0f / 1024.0f) + EPS); }
                    __syncthreads();
                    { const int r8 = F.tid >> 4, ch = F.tid & 15, cg = g * 256 + half * 128 + ch * 8; float ng[8];
#pragma unroll
                      for (int j = 0; j < 8; ++j) ng[j] = sgu_norm_g[cg + j];
#pragma unroll
                      for (int st = 0; st < 8; ++st) { const int s = st * 32 + r8; const u32x4 v = *(const u32x4*)(PROJ + (size_t)(win * 256 + s) * 3072 + 1024 + cg); const float rs = rsv[s];
                          const float p[8] = {bflo(v.x), bfhi(v.x), bflo(v.y), bfhi(v.y), bflo(v.z), bfhi(v.z), bflo(v.w), bfhi(v.w)};
#pragma unroll
                          for (int j = 0; j < 8; ++j) Ts[(ch * 8 + j) * 264 + s] = (bf16_t)f2bf(p[j] * rs * ng[j]); } }
                    __syncthreads();
                    { const int c = F.tid >> 5, sc = F.tid & 31; bf16_t* ob = POOLED + ((size_t)(win * 4 + g) * 256 + half * 128) * 256;
#pragma unroll
                      for (int st = 0; st < 8; ++st) { const int cc = st * 16 + c; *(u32x4*)(ob + (size_t)cc * 256 + sc * 8) = *(const LAS u32x4*)(Ts + cc * 264 + sc * 8); } }
                    __syncthreads();
                }
                __syncthreads();
                EpiSpatial E{PROJ, sgu_b_s};
                pg8::gemm_phase<EpiSpatial, SchedSp, false>(F.lds, F.scr, 256, 512u, 512u, (size_t)128 * 512, S2, E);
                if (!sfirst) {
                { SchedProj S{4, 0, F.G, F.bid, (const char*)XB8, nullptr, (const char*)(WINQ + (size_t)2 * 1024 * D), nullptr, 0, (char*)CONCAT};
                  LAS float* rtab = (LAS float*)(F.scr + SCR_IDX); proj_fill_rstd<1>(S, PART2, rtab); EpiScore<1> E{rtab};
                  pg8::gemm_phase<EpiScore<1>, SchedProj, false, true>(F.lds, F.scr, 1024, 2048u, 2048u, (size_t)128 * 2048, S, E); }
                }
            }
            if (!(l == 0 && F.G >= EARLY_PLAIN_MIN_G)) TAIL_CONVERT(1);
        }
        if (!(l == 0 && F.G >= EARLY_PLAIN_MIN_G)) SEAM(pb + 1);
        PHASE(pb + 3) { REPBAR();
            pg8::SchedGrid S{T / 256, 8, F.G, F.bid, (const char*)CONCAT + (l ? 1024 : 0), (size_t)256 * 3072, 0, (const char*)(BTO + (size_t)l * 2 * (2048 * 1536)) + (l ? 1024 : 0), (size_t)2048 * 3072, (size_t)256 * 3072, (char*)XB, (size_t)256 * 4096, 512};
            EpiOut E{P1, XB8, rep_ ? 0.f : 1.0f / F_S};
            if constexpr (l == 1) pg8::gemm_phase<EpiOut, pg8::SchedGrid, false, true>(F.lds, F.scr, 1024, 3072u, 3072u, (size_t)128 * 3072, S, E);
            else pg8::gemm_phase<EpiOut, pg8::SchedGrid, false, false, false, false, 16>(F.lds, F.scr, 1536, 3072u, 3072u, (size_t)128 * 3072, S, E);
            TAIL_CONVERT(2);
        }
        SEAM(pb + 3);
        PHASE(pb + 4) { REPBAR();
            pg8::SchedGrid S{T / 256, 2, F.G, F.bid, (const char*)XB, (size_t)256 * 4096, 2048, (const char*)(RT + (size_t)l * 256 * 2048), 0, 2048, (char*)LOGITS, 0, 0};
            EpiRoute E{LOGITS};
            pg8::gemm_phase<EpiRoute, pg8::SchedGrid, false>(F.lds, F.scr, 1024, 4096u, 4096u, (size_t)128 * 4096, S, E);
            TAIL_CONVERT(3);
        }
        SEAM(pb + 4);
        PHASE(pb + 5) { REPBAR();
            LAS int* hc = (LAS int*)(F.scr + SCR_TAB);
            for (int t0 = F.bid * 128; t0 < T; t0 += F.G * 128) {
                if (F.tid < 64) hc[F.tid] = 0;
                __syncthreads();
                const int t = t0 + F.tid;
                if (F.tid < 128) {
                    const f32x4* pp = (const f32x4*)(P1 + (size_t)t * 8); const f32x4 pa = pp[0], pb_ = pp[1]; const float s = ((pa[0] + pa[1]) + (pa[2] + pa[3])) + ((pb_[0] + pb_[1]) + (pb_[2] + pb_[3]));
                    const float rstd = __builtin_amdgcn_rsqf(s * (1.0f / D) + EPS); RS1[t] = rstd;
                    const float* la = LOGITS + (size_t)t * 64; const float* lb = la + (size_t)T * 64;
                    float gl[4]; int gi = 0;
#pragma unroll
                    for (int j = 0; j < 4; ++j) gl[j] = (la[j] + lb[j]) * rstd + moe_b_group[l * 4 + j];
#pragma unroll
                    for (int j = 1; j < 4; ++j) if (gl[j] > gl[gi]) gi = j;
                    float gs = 0.f;
#pragma unroll
                    for (int j = 0; j < 4; ++j) gs += __expf(gl[j] - gl[gi]);
                    const float pg = 1.0f / gs;
                    float el[8];
#pragma unroll
                    for (int j = 0; j < 8; ++j) el[j] = (la[4 + gi * 8 + j] + lb[4 + gi * 8 + j]) * rstd + moe_b_expert[l * 32 + gi * 8 + j];
                    int i0 = 0;
#pragma unroll
                    for (int j = 1; j < 8; ++j) if (el[j] > el[i0]) i0 = j;
                    int i1 = (i0 == 0) ? 1 : 0;
#pragma unroll
                    for (int j = 0; j < 8; ++j) if (j != i0 && el[j] > el[i1]) i1 = j;
                    const float x1 = __expf(el[i1] - el[i0]); const float tp0 = 1.0f / (1.0f + x1), tp1 = x1 / (1.0f + x1);
                    const int e0 = gi * 8 + i0, e1 = gi * 8 + i1;
                    const int r0 = __hip_atomic_fetch_add(&hc[e0], 1, __ATOMIC_RELAXED, __HIP_MEMORY_SCOPE_WORKGROUP), r1 = __hip_atomic_fetch_add(&hc[32 + e1], 1, __ATOMIC_RELAXED, __HIP_MEMORY_SCOPE_WORKGROUP);
                    u32x4 rec; rec.x = (unsigned)e0 | ((unsigned)e1 << 8) | ((unsigned)r0 << 16) | ((unsigned)r1 << 24); rec.y = __float_as_uint(pg * tp0); rec.z = __float_as_uint(pg * tp1); rec.w = 0u;
                    TOKREC[t] = rec;
                }
                __syncthreads();
                if (F.tid < 64) CNTM[(t0 >> 7) * 64 + F.tid] = hc[F.tid];
                __syncthreads();
            }
            TAIL_CONVERT(4);
        }
        SEAM(pb + 5);
        PHASE(pb + 6) { REPBAR();
            LAS int* ps = (LAS int*)(F.scr + SCR_IDX);
            LAS int* hb = (LAS int*)(F.scr + SCR_TAB);
            for (int t0 = F.bid * 128; t0 < T; t0 += F.G * 128) {
                const int blk = t0 >> 7, li = F.tid & 63, part = F.tid >> 6; int full = 0, upto = 0;
                for (int w = part * 32; w < part * 32 + 32; ++w) { const int c = CNTM[w * 64 + li]; full += c; upto += (w < blk) ? c : 0; }
                ps[part * 64 + li] = full; ps[512 + part * 64 + li] = upto;
                __syncthreads();
                if (F.tid < 64) { int base = 0, tot = 0;
#pragma unroll
                    for (int p = 0; p < 8; ++p) { tot += ps[p * 64 + F.tid]; base += ps[512 + p * 64 + F.tid]; }
                    hb[F.tid] = base; if (blk == 0) TOTALS[l * 64 + F.tid] = tot; }
                __syncthreads();
                if (F.tid < 128) { const int t = t0 + F.tid; const u32x4 rec = TOKREC[t]; const int e0 = rec.x & 255, e1 = (rec.x >> 8) & 255, r0 = (rec.x >> 16) & 255, r1 = rec.x >> 24;
                    const int p0 = hb[e0] + r0, p1 = hb[32 + e1] + r1;
                    LIST[(size_t)e0 * T + p0] = t; GATEW[(size_t)e0 * T + p0] = __uint_as_float(rec.y); LIST[(size_t)(32 + e1) * T + p1] = t; GATEW[(size_t)(32 + e1) * T + p1] = __uint_as_float(rec.z); }
                __syncthreads();
            }
            TAIL_CONVERT(5);
        }
        SEAM(pb + 6);
        { constexpr int ph = 0;
            if (!(l == 1 && ph == 2)) PHASE(pb + 7 + ph) { REPBAR();
                LAS int* cnt = (LAS int*)(F.scr + SCR_TAB); LAS int* pre = cnt + 64; LAS int* preB = cnt + 130; LAS int* preS = cnt + 196; LAS int* idx = (LAS int*)(F.scr + SCR_IDX);
                SchedMoe S; S.pre = pre; S.cnt = cnt; S.idx = idx; S.preB = preB; S.preS = preS; S.G = F.G; S.c = F.bid; S.ul = cnt + 264; S.nmy = 0; S.perm = 0;
                if (ph == 0) { S.lo = 0; S.hi = 64; S.mode = 0; S.perm = 1; S.A0 = (const char*)XB8; S.B0 = (const char*)(GUT + (size_t)l * 32 * D * D); S.C0 = (char*)HIDDEN; }
                else { S.lo = (ph == 1) ? 0 : 32; S.hi = (ph == 1 && l == 0) ? 32 : 64; S.mode = 1; S.perm = (ph == 1 && l == 1) ? 1 : 0; S.A0 = (const char*)HIDDEN; S.B0 = (const char*)(DOWNT + (size_t)l * 32 * DEXP * D); S.C0 = nullptr; }
                if (ph == 0) {
                    moe_setup<0>(S, TOTALS + l * 64, LIST, RS1);
                    EpiGu E{RS1, idx};
                    pg8::gemm_phase<EpiGu, SchedMoe, true, true, true>(F.lds, F.scr, 1024, 2048u, 2048u, (size_t)1024 * 2048, S, E);
                } else if (ph == 1) {
                    moe_setup<1>(S, TOTALS + l * 64, LIST, GATEW);
                    EpiDown<0> E{XB, YB0, YB1, idx, nullptr, 1.0f / (HID_S * DN_WS), 0.f, nullptr};
                    pg8::gemm_phase<EpiDown<0>, SchedMoe, false, true, true>(F.lds, F.scr, 512, 1024u, 1024u, (size_t)128 * 1024, S, E);
                } else {
                    moe_setup<1>(S, TOTALS + l * 64, LIST, GATEW);
                    EpiDown<1> E{XB, YB0, YB1, idx, PART2, rep_ ? 0.f : 1.0f / (HID_S * DN_WS), rep_ ? 0.f : 1.0f / Y_S, XB8};
                    pg8::gemm_phase<EpiDown<1>, SchedMoe, false, true, true>(F.lds, F.scr, 512, 1024u, 1024u, (size_t)128 * 1024, S, E);
                }
                __syncthreads();
                TAIL_CONVERT(6 + ph);
            }
            if (!(l == 1 && ph == 2)) SEAM(pb + 7 + ph);
        }
        { constexpr int ph = 1;
            if (!(l == 1 && ph == 2)) PHASE(pb + 7 + ph) { REPBAR();
                LAS int* cnt = (LAS int*)(F.scr + SCR_TAB); LAS int* pre = cnt + 64; LAS int* preB = cnt + 130; LAS int* preS = cnt + 196; LAS int* idx = (LAS int*)(F.scr + SCR_IDX);
                SchedMoe S; S.pre = pre; S.cnt = cnt; S.idx = idx; S.preB = preB; S.preS = preS; S.G = F.G; S.c = F.bid; S.ul = cnt + 264; S.nmy = 0; S.perm = 0;
                if (ph == 0) { S.lo = 0; S.hi = 64; S.mode = 0; S.perm = 1; S.A0 = (const char*)XB8; S.B0 = (const char*)(GUT + (size_t)l * 32 * D * D); S.C0 = (char*)HIDDEN; }
                else { S.lo = (ph == 1) ? 0 : 32; S.hi = (ph == 1 && l == 0) ? 32 : 64; S.mode = 1; S.perm = (ph == 1 && l == 1) ? 1 : 0; S.A0 = (const char*)HIDDEN; S.B0 = (const char*)(DOWNT + (size_t)l * 32 * DEXP * D); S.C0 = nullptr; }
                if (ph == 0) {
                    moe_setup<0>(S, TOTALS + l * 64, LIST, RS1);
                    EpiGu E{RS1, idx};
                    pg8::gemm_phase<EpiGu, SchedMoe, true, true, true>(F.lds, F.scr, 1024, 2048u, 2048u, (size_t)1024 * 2048, S, E);
                } else if (ph == 1) {
                    moe_setup<1>(S, TOTALS + l * 64, LIST, GATEW);
                    EpiDown<0> E{XB, YB0, YB1, idx, nullptr, 1.0f / (HID_S * DN_WS), 0.f, nullptr};
                    pg8::gemm_phase<EpiDown<0>, SchedMoe, false, true, true>(F.lds, F.scr, 512, 1024u, 1024u, (size_t)128 * 1024, S, E);
                } else {
                    moe_setup<1>(S, TOTALS + l * 64, LIST, GATEW);
                    EpiDown<1> E{XB, YB0, YB1, idx, PART2, rep_ ? 0.f : 1.0f / (HID_S * DN_WS), rep_ ? 0.f : 1.0f / Y_S, XB8};
                    pg8::gemm_phase<EpiDown<1>, SchedMoe, false, true, true>(F.lds, F.scr, 512, 1024u, 1024u, (size_t)128 * 1024, S, E);
                }
                __syncthreads();
                TAIL_CONVERT(6 + ph);
            }
            if (!(l == 1 && ph == 2)) SEAM(pb + 7 + ph);
        }
        { constexpr int ph = 2;
            if (!(l == 1 && ph == 2)) PHASE(pb + 7 + ph) { REPBAR();
                LAS int* cnt = (LAS int*)(F.scr + SCR_TAB); LAS int* pre = cnt + 64; LAS int* preB = cnt + 130; LAS int* preS = cnt + 196; LAS int* idx = (LAS int*)(F.scr + SCR_IDX);
                SchedMoe S; S.pre = pre; S.cnt = cnt; S.idx = idx; S.preB = preB; S.preS = preS; S.G = F.G; S.c = F.bid; S.ul = cnt + 264; S.nmy = 0; S.perm = 0;
                if (ph == 0) { S.lo = 0; S.hi = 64; S.mode = 0; S.perm = 1; S.A0 = (const char*)XB8; S.B0 = (const char*)(GUT + (size_t)l * 32 * D * D); S.C0 = (char*)HIDDEN; }
                else { S.lo = (ph == 1) ? 0 : 32; S.hi = (ph == 1 && l == 0) ? 32 : 64; S.mode = 1; S.perm = (ph == 1 && l == 1) ? 1 : 0; S.A0 = (const char*)HIDDEN; S.B0 = (const char*)(DOWNT + (size_t)l * 32 * DEXP * D); S.C0 = nullptr; }
                if (ph == 0) {
                    moe_setup<0>(S, TOTALS + l * 64, LIST, RS1);
                    EpiGu E{RS1, idx};
                    pg8::gemm_phase<EpiGu, SchedMoe, true, true, true>(F.lds, F.scr, 1024, 2048u, 2048u, (size_t)1024 * 2048, S, E);
                } else if (ph == 1) {
                    moe_setup<1>(S, TOTALS + l * 64, LIST, GATEW);
                    EpiDown<0> E{XB, YB0, YB1, idx, nullptr, 1.0f / (HID_S * DN_WS), 0.f, nullptr};
                    pg8::gemm_phase<EpiDown<0>, SchedMoe, false, true, true>(F.lds, F.scr, 512, 1024u, 1024u, (size_t)128 * 1024, S, E);
                } else {
                    moe_setup<1>(S, TOTALS + l * 64, LIST, GATEW);
                    EpiDown<1> E{XB, YB0, YB1, idx, PART2, rep_ ? 0.f : 1.0f / (HID_S * DN_WS), rep_ ? 0.f : 1.0f / Y_S, XB8};
                    pg8::gemm_phase<EpiDown<1>, SchedMoe, false, true, true>(F.lds, F.scr, 512, 1024u, 1024u, (size_t)128 * 1024, S, E);
                }
                __syncthreads();
                TAIL_CONVERT(6 + ph);
            }
            if (!(l == 1 && ph == 2)) SEAM(pb + 7 + ph);
        }
}
__global__ void __launch_bounds__(NWAVES * 64, 2) fwd(Args args) {
    extern __shared__ __attribute__((aligned(16))) unsigned char lds_raw[];
    Frame F; F.lds = (LAS unsigned char*)lds_raw; F.scr = F.lds + SCR_OFF;
    F.tid = threadIdx.x; F.lane = F.tid & 63; F.wave = rfl(F.tid >> 6); F.G = gridDim.x; F.bid = blockIdx.x;
    volatile LAS unsigned* MISC = (volatile LAS unsigned*)(F.lds + MISC_OFF);
    unsigned* ctl = (unsigned*)(args.ws + WS_CTL);
    if (F.tid < 32) MISC[F.tid] = 0u;
    __syncthreads();
    XcdBarrier bar; bar.bar = ctl + CW_BAR; bar.x = 0; bar.st = nullptr;
    if (!MK_PER_PHASE) bar = xcd_barrier_post(ctl + CW_BAR, MISC + 8);
    const int lo = args.ph_lo, hi = args.ph_hi;

    const int gw = F.bid * NWAVES + F.wave, NGW = F.G * NWAVES;
    const int gt = F.bid * (NWAVES * 64) + F.tid, NGT = F.G * NWAVES * 64;
    constexpr int I_SQ = (2048 / 64) * (2048 / 64), I_IN1 = (2048 / 64) * (3072 / 64), I_DN = (1024 / 64) * (2048 / 64);
    constexpr int NSMALL = I_SQ + I_IN1 + 2 * I_SQ + 2 * I_SQ;
    PHASE(0) { REPBAR();
        LAS unsigned* scr = (LAS unsigned*)(F.lds + F.wave * 16384);
        for (int m = gw; m < T; m += NGW) {
            const f32x4* xr = (const f32x4*)(x_in + (size_t)m * D) + F.lane * 2; unsigned* o = (unsigned*)(XB + (size_t)m * D) + F.lane * 4; float s = 0.f;
#pragma unroll
            for (int j = 0; j < 4; ++j) { const f32x4 a = xr[128 * j], b = xr[128 * j + 1]; u32x4 w; w.x = pk2(a[0], a[1]); w.y = pk2(a[2], a[3]); w.z = pk2(b[0], b[1]); w.w = pk2(b[2], b[3]);
                const float a0 = bflo(w.x), a1 = bfhi(w.x), a2 = bflo(w.y), a3 = bfhi(w.y), a4 = bflo(w.z), a5 = bfhi(w.z), a6 = bflo(w.w), a7 = bfhi(w.w);
                s += (a0 * a0 + a1 * a1) + (a2 * a2 + a3 * a3) + (a4 * a4 + a5 * a5) + (a6 * a6 + a7 * a7);
                u32x2 w8; w8.x = pk4_fp8(a0, a1, a2, a3); w8.y = pk4_fp8(a4, a5, a6, a7); *(u32x2*)(XB8 + (size_t)m * D + 512 * j + 8 * F.lane) = w8;
                *(u32x4*)(o + 256 * j) = w; }
            s = wave_sum(s); if (F.lane == 0) RSTD0[m] = __builtin_amdgcn_rsqf(s * (1.0f / D) + EPS);
        }
        if (gt < D / 2) ((unsigned*)(XB + (size_t)T * D))[gt] = 0u;
        if (gt < D / 4) ((unsigned*)(XB8 + (size_t)T * D))[gt] = 0u;
        if (gt == 0) { RSTD0[T] = 0.f; RSTD1[T] = 0.f; ((float*)((char*)RSTD1 + RSTD_STRIDE))[T] = 0.f; }
        for (int m = gw; m < 2 * 512; m += NGW) { const int l = m >> 9, r = m & 511;
            const f32x4* xr = (const f32x4*)(mem_in + (size_t)r * D) + F.lane * 2; const f32x4* gr = (const f32x4*)(norm_mem_g + (size_t)l * D) + F.lane * 2; f32x4 a[4], b[4]; float s = 0.f;
#pragma unroll
            for (int j = 0; j < 4; ++j) { a[j] = xr[128 * j]; b[j] = xr[128 * j + 1]; s += (a[j][0] * a[j][0] + a[j][1] * a[j][1]) + (a[j][2] * a[j][2] + a[j][3] * a[j][3]) + (b[j][0] * b[j][0] + b[j][1] * b[j][1]) + (b[j][2] * b[j][2] + b[j][3] * b[j][3]); }
            const float rstd = __builtin_amdgcn_rsqf(wave_sum(s) * (1.0f / D) + EPS); unsigned* o = (unsigned*)(MEMN + (size_t)m * D) + F.lane * 4;
#pragma unroll
            for (int j = 0; j < 4; ++j) { const f32x4 ga = gr[128 * j], gb = gr[128 * j + 1]; u32x4 w; w.x = pk2(a[j][0] * rstd * ga[0], a[j][1] * rstd * ga[1]); w.y = pk2(a[j][2] * rstd * ga[2], a[j][3] * rstd * ga[3]);
                w.z = pk2(b[j][0] * rstd * gb[0], b[j][1] * rstd * gb[1]); w.w = pk2(b[j][2] * rstd * gb[2], b[j][3] * rstd * gb[3]); *(u32x4*)(o + 256 * j) = w; }
        }
        for (int i = gt; i < 2 * 256 * 2048; i += NGT) { const int l = i >> 19, n = (i >> 11) & 255, k = i & 2047, j = n & 127; float w = 0.f;
            if (j < 4) w = moe_w_group[((size_t)l * D + k) * 4 + j]; else if (j < 36) w = moe_w_expert[((size_t)l * D + k) * 32 + (j - 4)];
            w *= norm_ffn_g[l * D + k]; const unsigned hi16 = f2bf(w); const float lof = w - __uint_as_float(hi16 << 16);
            RT[i] = (bf16_t)(n < 128 ? hi16 : f2bf(lof)); }
        for (int i = gt; i < 4 * 256 * 256; i += NGT) { const int g = i >> 16, t = (i >> 8) & 255, s = i & 255; float w = 0.f;
            if ((t >> 7) == (s >> 7) && (s & 127) <= (t & 127)) w = sgu_w_s[((size_t)g * 128 + (t & 127)) * 128 + (s & 127)];
            W2[i] = (bf16_t)f2bf(w); }
        for (int i = gt; i < 2 * 2048 * 256; i += NGT) { const int l = i >> 19, kk = (i >> 8) & 2047, c4 = (i & 255) * 4;
            const float* src = l ? sgu_w_in + (size_t)kk * 3072 + 2048 + c4 : pool_w_in + (size_t)kk * 2048 + 1024 + c4; const f32x4 w = *(const f32x4*)src; const float gs = norm_mix_g[l * D + kk] * 0.0625f;
            u32x2 o; o.x = pk2(w[0] * gs, w[1] * gs); o.y = pk2(w[2] * gs, w[3] * gs); *(u32x2*)(WQN + (size_t)l * D * D + (size_t)kk * D + c4) = o; }
        for (int i = gt; i < 4 * 256 * 256; i += NGT) { const int g = i >> 16, c = (i >> 8) & 255, d = i & 255; GRPW[(size_t)c * 2048 + g * 256 + d] = (bf16_t)f2bf(pool_w_grp[i] * pool_scale[g * 256 + d]); }
#define TR_DECODE(d, it_) do { int r = (it_); \
            if (r < I_SQ) { tr_desc(d, pool_w_in, 2048, 2048, WIN0, norm_mix_g, nullptr, 1.f, false, r); break; } r -= I_SQ; \
            if (r < I_IN1) { tr_desc(d, sgu_w_in, 2048, 3072, WIN1, norm_mix_g + D, nullptr, WIN_S, true, r); break; } r -= I_IN1; \
            if (r < 2 * I_SQ) { const int l_ = r / I_SQ; tr_desc(d, l_ ? sgu_w_out : pool_w_out, 2048, 2048, WOUT + (size_t)l_ * D * D, nullptr, nullptr, 1.f, false, r % I_SQ); break; } r -= 2 * I_SQ; \
            if (r < 2 * I_SQ) { const int l_ = r / I_SQ; tr_desc(d, xa_w_kv + (size_t)l_ * D * D, 2048, 2048, WKV + (size_t)l_ * D * D, nullptr, nullptr, 1.f, false, r % I_SQ); break; } r -= 2 * I_SQ; \
            if (r >= 32 * I_SQ) { r += TAIL_HG; if (r >= 64 * I_SQ + 32 * I_DN) r += TAIL_HD; }     \
            if (r < 64 * I_SQ) { const int le = r / I_SQ; tr_desc(d, moe_w_gu + (size_t)le * D * D, 2048, 2048, GUT + (size_t)le * D * D, norm_ffn_g + (le >> 5) * D, nullptr, GU_WS, true, r % I_SQ); break; } r -= 64 * I_SQ; \
            { const int le = r / I_DN; tr_desc(d, moe_w_down + (size_t)le * DEXP * D, 1024, 2048, DOWNT + (size_t)le * DEXP * D, nullptr, nullptr, DN_WS, true, r % I_DN); } } while (0)
#define TR_ID(j) ((j) < nj1 ? id1 + (j) * st1 : id2 + ((j) - nj1) * st2)
#define TR_RUN() do {   \
            TrDesc dA, dB; f32x4 vA[16], vB[16]; const int nj = nj1 + nj2; int j = 0; \
            if (nj > 0) { TR_DECODE(dA, TR_ID(0)); tr_load(dA, vA, F.lane); \
                for (;;) { \
                    const bool hasB = j + 1 < nj; if (hasB) { TR_DECODE(dB, TR_ID(j + 1)); tr_load(dB, vB, F.lane); } \
                    tr_finish(dA, vA, scr, F.lane); \
                    if (!hasB) break; \
                    const bool hasA = j + 2 < nj; if (hasA) { TR_DECODE(dA, TR_ID(j + 2)); tr_load(dA, vA, F.lane); } \
                    tr_finish(dB, vB, scr, F.lane); \
                    if (!hasA) break; \
                    j += 2; \
                } } } while (0)
        {
            const int id1 = gw, st1 = NGW, nj1 = (NSMALL - gw + NGW - 1) / NGW > 0 ? (NSMALL - gw + NGW - 1) / NGW : 0, id2 = 0, st2 = 1, nj2 = 0;
            TR_RUN();
        }
    }
    SEAM(0);
    PHASE(1) { REPBAR();
        {
            SchedKV S{F.G, F.bid, (const char*)MEMN, (const char*)WKV, (char*)KVN};
            EpiPlain E{0, 1.f};
            pg8::gemm_phase<EpiPlain, SchedKV, false>(F.lds, F.scr, 2048, 4096u, 4096u, (size_t)128 * 4096, S, E);
        }
        if (F.G >= EARLY_PLAIN_MIN_G && F.bid >= 32 && F.bid < 160) {
            SchedProj S{4, 4, 128, F.bid - 32, (const char*)XB, (const char*)WIN0, nullptr, (char*)PROJ, (size_t)256 * 2048 * 2, nullptr, 4096};
            LAS float* rtab = (LAS float*)(F.scr + SCR_IDX); proj_fill_rstd<0>(S, RSTD0, rtab); EpiProj<0> E{2048, RSTD0, nullptr, 4, rtab, 1.f};
            pg8::gemm_phase<EpiProj<0>, SchedProj, false>(F.lds, F.scr, 2048, 4096u, 4096u, (size_t)128 * 4096, S, E);
        }
        if (F.G >= EARLY_PLAIN_MIN_G && F.bid < 32) {
            asm volatile("s_waitcnt vmcnt(0)" ::: "memory"); __syncthreads();
            const int l_ = F.bid >> 4, b_ = (F.bid >> 3) & 1, j_ = F.bid & 7, h_ = j_ & 3;
            SchedFold S{1, (j_ >= 4 ? 0 : 128) + l_ * 64 + b_ * 32 + h_ * 8, (const char*)WOUT, (const char*)KVN, (const char*)GRPW, (char*)BTO, (const char*)WQN, (char*)WINQ, 1, 8};
            EpiFp8 E{VW_S, 3072, WQ_S, 2048};
            pg8::gemm_phase<EpiFp8, SchedFold, false>(F.lds, F.scr, 256, 4096u, 4096u, (size_t)128 * 4096, S, E);
        }
        if (F.G >= EARLY_PLAIN_MIN_G && F.bid >= 160) {
        for (int i = (F.bid - 160) * (NWAVES * 64) + F.tid; i < 2 * 2048 * 128; i += (F.G - 160) * (NWAVES * 64)) { const int b = i >> 18, n = (i >> 7) & 2047, c = i & 127;
            const u32x4 w = *(const u32x4*)(WOUT + (size_t)D * D + (size_t)n * D + c * 8); u32x4 o;
            u32x2 o8; o8.x = pk4_fp8(bflo(w.x) * WO_S, bfhi(w.x) * WO_S, bflo(w.y) * WO_S, bfhi(w.y) * WO_S); o8.y = pk4_fp8(bflo(w.z) * WO_S, bfhi(w.z) * WO_S, bflo(w.w) * WO_S, bfhi(w.w) * WO_S);
            *(u32x2*)((unsigned char*)(BTO + (size_t)(2 + b) * (2048 * 1536) + (size_t)n * 1536) + 1024 + c * 8) = o8; }
        { SchedFold S{F.G - 160, F.bid - 160, (const char*)WOUT, (const char*)KVN, (const char*)GRPW, (char*)BTO, (const char*)WQN, (char*)WINQ, 0};
          EpiPlain E{0, F_S};
          pg8::gemm_phase<EpiPlain, SchedFold, false>(F.lds, F.scr, 256, 4096u, 4096u, (size_t)128 * 4096, S, E); }
        }
        {
            LAS unsigned* scr = (LAS unsigned*)(F.lds + F.wave * 16384);
            constexpr int NMOE = 64 * I_SQ + 64 * I_DN - TAIL_ITEMS; static_assert(NMOE % 16 == 0 && TAIL_PER0 % 16 == 0, "tickets of 16 items");
            const int NTK = (NMOE + (F.G >= EARLY_PLAIN_MIN_G ? TAIL_PER0 : 0)) / 16;
#define CONV_DESC(d_, it_) do { const int ci_ = (it_); if (ci_ < NMOE) TR_DECODE(d_, NSMALL + ci_); else TAIL_DESC(d_, TAIL_PER0 + ci_ - NMOE); } while (0)
            unsigned* q = ctl + CW_CONVQ; volatile LAS unsigned* tk = MISC + 16; TrDesc dA, dB; f32x4 vA[16], vB[16];
            __syncthreads(); if (F.tid == 0) tk[0] = xb_add(q, 1u); __syncthreads();
            unsigned b = tk[0]; int par = 1;
            while (b < (unsigned)NTK) { unsigned nt = 0u; if (F.tid == 0) nt = xb_add(q, 1u);
                const int iA = (int)b * 16 + F.wave;
                CONV_DESC(dA, iA); tr_load(dA, vA, F.lane); CONV_DESC(dB, iA + 8); tr_load(dB, vB, F.lane);
                tr_finish(dA, vA, scr, F.lane); tr_finish(dB, vB, scr, F.lane);
                if (F.tid == 0) tk[par] = nt; __syncthreads(); b = tk[par]; par ^= 1; }
        }
#undef CONV_DESC
#undef TR_RUN
#undef TR_ID

#undef TR_DECODE
    }
    SEAM(1);
    PHASE(2) { REPBAR();
        if (F.G < EARLY_PLAIN_MIN_G) {
        for (int i = gt; i < 2 * 2048 * 128; i += NGT) { const int b = i >> 18, n = (i >> 7) & 2047, c = i & 127;
            const u32x4 w = *(const u32x4*)(WOUT + (size_t)D * D + (size_t)n * D + c * 8); u32x4 o;
            u32x2 o8; o8.x = pk4_fp8(bflo(w.x) * WO_S, bfhi(w.x) * WO_S, bflo(w.y) * WO_S, bfhi(w.y) * WO_S); o8.y = pk4_fp8(bflo(w.z) * WO_S, bfhi(w.z) * WO_S, bflo(w.w) * WO_S, bfhi(w.w) * WO_S);
            *(u32x2*)((unsigned char*)(BTO + (size_t)(2 + b) * (2048 * 1536) + (size_t)n * 1536) + 1024 + c * 8) = o8; }
        { SchedFold S{F.G, F.bid, (const char*)WOUT, (const char*)KVN, (const char*)GRPW, (char*)BTO, (const char*)WQN, (char*)WINQ, 0};
          EpiPlain E{0, F_S};
          pg8::gemm_phase<EpiPlain, SchedFold, false>(F.lds, F.scr, 256, 4096u, 4096u, (size_t)128 * 4096, S, E); }
        { SchedFold S{F.G, F.bid, (const char*)WOUT, (const char*)KVN, (const char*)GRPW, (char*)BTO, (const char*)WQN, (char*)WINQ, 1};
          EpiFp8 E{VW_S, 3072, WQ_S, 2048};
          pg8::gemm_phase<EpiFp8, SchedFold, false>(F.lds, F.scr, 256, 4096u, 4096u, (size_t)128 * 4096, S, E); }
        }
    }
    if (F.G < EARLY_PLAIN_MIN_G) SEAM(2);

    layer_phases<0>(args, F, bar, ctl, lo, hi, gw, NGW, gt, NGT);
    layer_phases<1>(args, F, bar, ctl, lo, hi, gw, NGW, gt, NGT);
    PHASE(23) { REPBAR();
        f32x4 gv[4][2];
#pragma unroll
        for (int j = 0; j < 4; ++j) { gv[j][0] = ((const f32x4*)final_norm_g)[F.lane * 2 + 128 * j]; gv[j][1] = ((const f32x4*)final_norm_g)[F.lane * 2 + 128 * j + 1]; }
        for (int m0 = gw; m0 < T; m0 += 2 * NGW) {
            u32x4 xw[2][4]; u32x2 ya[2][4], yb[2][4]; const int m1 = m0 + NGW; const bool has1 = m1 < T;
#pragma unroll
            for (int rr = 0; rr < 2; ++rr) { const int m = (rr == 0 || has1) ? (rr ? m1 : m0) : m0;
                const u32x4* xr = (const u32x4*)(XB + (size_t)m * D) + F.lane; const u32x2* y0r = (const u32x2*)(YB0 + (size_t)m * D) + F.lane; const u32x2* y1r = (const u32x2*)(YB1 + (size_t)m * D) + F.lane;
#pragma unroll
                for (int j = 0; j < 4; ++j) { xw[rr][j] = xr[64 * j]; ya[rr][j] = y0r[64 * j]; yb[rr][j] = y1r[64 * j]; } }
#pragma unroll
            for (int rr = 0; rr < 2; ++rr) { if (rr == 1 && !has1) break; const int m = rr ? m1 : m0;
                float xv[4][8]; float s = 0.f;
#pragma unroll
                for (int j = 0; j < 4; ++j) { const u32x4 v = xw[rr][j]; float fa[8], fb[8]; fp8x8_to_f32(ya[rr][j], fa); fp8x8_to_f32(yb[rr][j], fb);
                    const float xx[8] = {bflo(v.x), bfhi(v.x), bflo(v.y), bfhi(v.y), bflo(v.z), bfhi(v.z), bflo(v.w), bfhi(v.w)};
#pragma unroll
                    for (int e = 0; e < 8; ++e) { xv[j][e] = xx[e] + (fa[e] + fb[e]) * (1.0f / Y_S); s += xv[j][e] * xv[j][e]; } }
                const float rstd = __builtin_amdgcn_rsqf(wave_sum(s) * (1.0f / D) + EPS);
                f32x4* o = (f32x4*)(args.out + (size_t)m * D) + F.lane * 2;
#pragma unroll
                for (int j = 0; j < 4; ++j) { const f32x4 ga = gv[j][0], gb = gv[j][1];
                    o[128 * j] = (f32x4){xv[j][0] * rstd * ga[0], xv[j][1] * rstd * ga[1], xv[j][2] * rstd * ga[2], xv[j][3] * rstd * ga[3]};
                    o[128 * j + 1] = (f32x4){xv[j][4] * rstd * gb[0], xv[j][5] * rstd * gb[1], xv[j][6] * rstd * gb[2], xv[j][7] * rstd * gb[3]}; } }
        }
    }
#undef IN
#undef SEAM
}

extern "C" void kernel_launch(void* const* d_in, const int* in_sizes, int n_in, void* d_out, int out_size, void* d_ws, size_t ws_size, hipStream_t stream) {
    static int grid = 0;
    if (grid == 0) {
        if (n_in != 22 || out_size != T * D || ws_size < WS_END) { fprintf(stderr, "kernel_launch: unexpected shapes (n_in %d, out %d, ws %zu)\n", n_in, out_size, ws_size); grid = -1; return; }
        int dev = 0, cus = 0, per_cu = 0;
        if (hipGetDevice(&dev) != hipSuccess || hipDeviceGetAttribute(&cus, hipDeviceAttributeMultiprocessorCount, dev) != hipSuccess) { grid = -1; return; }
        if (hipFuncSetAttribute((const void*)fwd, hipFuncAttributeMaxDynamicSharedMemorySize, LDS_BYTES) != hipSuccess) { fprintf(stderr, "kernel_launch: hipFuncSetAttribute failed\n"); grid = -1; return; }
        if (hipOccupancyMaxActiveBlocksPerMultiprocessor(&per_cu, (const void*)fwd, NWAVES * 64, LDS_BYTES) != hipSuccess || per_cu < 1) { fprintf(stderr, "kernel_launch: occupancy query says %d\n", per_cu); }
        (void)hipGetLastError();
        grid = cus;
    }
    if (grid < 0) return;
    (void)hipMemsetAsync((char*)d_ws + WS_CTL, 0, CTL_ZERO_BYTES, stream);
    Args a{};
    for (int i = 0; i < 22; ++i) a.in[i] = (const float*)d_in[i];
    a.out = (float*)d_out; a.ws = (unsigned char*)d_ws;
#if MK_PER_PHASE
    for (int p = 0; p < NPHASE; ++p) { a.ph_lo = p; a.ph_hi = p + 1; hipLaunchKernelGGL(fwd, dim3(grid), dim3(NWAVES * 64), LDS_BYTES, stream, a); }
#else
    a.ph_lo = 0; a.ph_hi = NPHASE; hipLaunchKernelGGL(fwd, dim3(grid), dim3(NWAVES * 64), LDS_BYTES, stream, a);
#endif
}
```
